# Optimizing an MI355X kernel written in HIP

```python
import math
import jax
import jax.numpy as jnp
from jax import lax
import numpy as np

D_MODEL = 1024
BATCH = 4
SEQ = 4096
DEPTH = 1
DEC_BATCH = 128
DEC_SEQ = 4
PAST_LEN = 2048
PAGE_SIZE = 128

MIX_WIDTH = D_MODEL
GDN_WIDTH = MIX_WIDTH // 2
GDN_HEADS = 4
GDN_DK = GDN_WIDTH // GDN_HEADS
GDN_DV = GDN_WIDTH // GDN_HEADS
GDN_CONV = 4
GDN_CHUNK = 64
DIFF_WIDTH = MIX_WIDTH - GDN_WIDTH
DIFF_HEADS = 4
DIFF_DV = DIFF_WIDTH // DIFF_HEADS
DIFF_DQK = DIFF_DV // 2
Q_BLOCK = 128
D_FF = 2816
FFN_CONV = 3
EPS = 1e-6

COL_GDN_Z = 3 * GDN_WIDTH
COL_GDN_B = 4 * GDN_WIDTH
COL_GDN_A = COL_GDN_B + GDN_HEADS
COL_DIFF = COL_GDN_A + GDN_HEADS
IN_COLS = COL_DIFF + 3 * DIFF_WIDTH

kernel_name = 'hybrid_gdn_diffattn_step'


def _rmsnorm(x, g):
    xf = x.astype(jnp.float32)
    xf = xf * lax.rsqrt(jnp.mean(xf * xf, axis=-1, keepdims=True) + EPS)
    return xf.astype(x.dtype) * g.astype(x.dtype)


def _l2norm(x):
    xf = x.astype(jnp.float32)
    return (xf * lax.rsqrt(jnp.sum(xf * xf, axis=-1, keepdims=True) + EPS)).astype(x.dtype)


def _causal_dwconv(x, buf, w, b=None):
    width = w.shape[0]
    L = x.shape[1]
    xp = jnp.concatenate([buf.astype(x.dtype), x], axis=1)
    y = xp[:, 0:L] * w[0]
    for j in range(1, width):
        y = y + xp[:, j:j + L] * w[j]
    if b is not None:
        y = y + b
    return y, xp[:, L:]


def _to_chunks(t, n, c):
    t = t.reshape(t.shape[0], n, c, *t.shape[2:])
    return jnp.moveaxis(t, (1, 3), (0, 2))


def _gated_delta_chunked(q, k, v, g, beta, S0):
    B, L, H, DK = q.shape
    DV = v.shape[-1]
    f32 = jnp.float32
    C = min(GDN_CHUNK, L)
    pad = (-L) % C
    n = (L + pad) // C

    def prep(t):
        t = t.astype(f32)
        return _to_chunks(jnp.pad(t, [(0, 0), (0, pad)] + [(0, 0)] * (t.ndim - 2)), n, C)

    qc, kc, vc, gc, bc = prep(q), prep(k), prep(v), prep(g), prep(beta)
    gcum = jnp.cumsum(gc, axis=-1)
    idx = jnp.arange(C)
    causal = idx[:, None] >= idx[None, :]
    decay = jnp.exp(jnp.where(causal, gcum[..., :, None] - gcum[..., None, :], -jnp.inf))
    kb = kc * bc[..., None]
    m = jnp.einsum('nbhik,nbhjk->nbhij', kb, kc) * decay
    a = jnp.where(idx[:, None] > idx[None, :], m, 0.0) + jnp.eye(C, dtype=f32)
    rhs = jnp.concatenate([vc * bc[..., None], kb * jnp.exp(gcum)[..., None]], axis=-1)
    sol = lax.linalg.triangular_solve(a, rhs, left_side=True, lower=True, unit_diagonal=True)
    u, w = sol[..., :DV], sol[..., DV:]

    def step(S, inp):
        q_i, k_i, u_i, w_i, g_i, d_i = inp
        v_new = u_i - jnp.einsum('bhck,bhkv->bhcv', w_i, S)
        intra = jnp.einsum('bhik,bhjk->bhij', q_i, k_i) * d_i
        o_i = (jnp.einsum('bhck,bhkv->bhcv', q_i * jnp.exp(g_i)[..., None], S)
               + jnp.einsum('bhij,bhjv->bhiv', intra, v_new))
        g_last = g_i[..., -1]
        S = (S * jnp.exp(g_last)[..., None, None]
             + jnp.einsum('bhck,bhcv->bhkv', k_i * jnp.exp(g_last[..., None] - g_i)[..., None], v_new))
        return S, o_i

    S_final, o = lax.scan(step, S0.astype(f32), (qc, kc, u, w, gcum, decay))
    o = jnp.transpose(o, (1, 0, 3, 2, 4)).reshape(B, n * C, H, DV)[:, :L]
    return o, S_final


def _diff_attention(q, k, v, lam, past_len):
    B, L = q.shape[0], q.shape[1]
    T = k.shape[1]
    H, DV = v.shape[2], v.shape[3]
    k_pos = jnp.arange(T)
    scale = DIFF_DQK ** -0.5

    def attend(qb, q_pos):
        s = jnp.einsum('bqhcd,bthcd->bhcqt', qb, k).astype(jnp.float32) * scale
        s = jnp.where(k_pos[None, :] <= q_pos[:, None], s, -jnp.inf)
        p = jax.nn.softmax(s, axis=-1)
        amap = p[:, :, 0] - lam * p[:, :, 1]
        return jnp.einsum('bhqt,bthv->bqhv', amap.astype(v.dtype), v)

    q_pos = past_len + jnp.arange(L)
    if L % Q_BLOCK == 0 and L > Q_BLOCK:
        nb = L // Q_BLOCK
        qb = jnp.moveaxis(q.reshape(B, nb, Q_BLOCK, H, 2, DIFF_DQK), 1, 0)
        pb = q_pos.reshape(nb, Q_BLOCK)
        o = lax.map(lambda xs: attend(xs[0], xs[1]), (qb, pb))
        return jnp.moveaxis(o, 0, 1).reshape(B, L, H, DV)
    return attend(q, q_pos)


def _hybrid_layer(x, gdn_conv_buf, gdn_S0, past_k, past_v, ffn_buf, wl, lam_init):
    (attn_norm_g, w_in, gdn_conv_w, gdn_A_log, gdn_dt_bias, gdn_out_norm_g,
     diff_q_norm_g, diff_k_norm_g, lq1, lk1, lq2, lk2, diff_subln_g, w_out,
     ffn_norm_g, w_up, ffn_conv_w, ffn_conv_b, w_down) = wl
    f32 = jnp.float32
    B, L, _ = x.shape
    P = past_k.shape[1]
    xn = _rmsnorm(x, attn_norm_g)
    proj = xn @ w_in

    qkv, new_gdn_conv = _causal_dwconv(proj[..., :COL_GDN_Z], gdn_conv_buf, gdn_conv_w)
    qkv = jax.nn.silu(qkv)
    gq = _l2norm(qkv[..., :GDN_WIDTH].reshape(B, L, GDN_HEADS, GDN_DK)) * (GDN_DK ** -0.5)
    gk = _l2norm(qkv[..., GDN_WIDTH:2 * GDN_WIDTH].reshape(B, L, GDN_HEADS, GDN_DK))
    gv = qkv[..., 2 * GDN_WIDTH:].reshape(B, L, GDN_HEADS, GDN_DV)
    z = proj[..., COL_GDN_Z:COL_GDN_B].reshape(B, L, GDN_HEADS, GDN_DV)
    beta = jax.nn.sigmoid(proj[..., COL_GDN_B:COL_GDN_A].astype(f32))
    g = -jnp.exp(gdn_A_log.astype(f32)) * jax.nn.softplus(
        proj[..., COL_GDN_A:COL_DIFF].astype(f32) + gdn_dt_bias.astype(f32))
    o_g, new_S = _gated_delta_chunked(gq, gk, gv, g, beta, gdn_S0)
    o_g = (_rmsnorm(o_g.astype(x.dtype), gdn_out_norm_g) * jax.nn.silu(z)).reshape(B, L, GDN_WIDTH)

    d = proj[..., COL_DIFF:]
    dq = _rmsnorm(d[..., :DIFF_WIDTH].reshape(B, L, DIFF_HEADS, 2, DIFF_DQK), diff_q_norm_g)
    dk = _rmsnorm(d[..., DIFF_WIDTH:2 * DIFF_WIDTH].reshape(B, L, DIFF_HEADS, 2, DIFF_DQK), diff_k_norm_g)
    dv = d[..., 2 * DIFF_WIDTH:].reshape(B, L, DIFF_HEADS, DIFF_DV)
    new_k = dk.reshape(B, L, DIFF_HEADS, 2 * DIFF_DQK)
    keys = jnp.concatenate([past_k.astype(x.dtype), new_k], axis=1).reshape(B, P + L, DIFF_HEADS, 2, DIFF_DQK)
    vals = jnp.concatenate([past_v.astype(x.dtype), dv], axis=1)
    lam = (jnp.exp(jnp.sum(lq1.astype(f32) * lk1.astype(f32)))
           - jnp.exp(jnp.sum(lq2.astype(f32) * lk2.astype(f32))) + lam_init)
    o_d = _diff_attention(dq, keys, vals, lam, P)
    o_d = (_rmsnorm(o_d, diff_subln_g) * (1.0 - lam_init)).reshape(B, L, DIFF_WIDTH)

    h = x + jnp.concatenate([o_g, o_d], axis=-1) @ w_out

    hn = _rmsnorm(h, ffn_norm_g)
    u, new_ffn = _causal_dwconv(hn @ w_up, ffn_buf, ffn_conv_w, ffn_conv_b)
    y = h + (jax.nn.silu(u[..., :D_FF]) * u[..., D_FF:]) @ w_down
    return y, new_gdn_conv, new_S, new_k, dv, new_ffn


def setup_inputs(seed: int = 0) -> dict:
    key = jax.random.key(seed)
    ks = jax.random.split(key, 32)
    f32 = jnp.float32
    n_pages = PAST_LEN // PAGE_SIZE
    n_pool = (DEC_BATCH * n_pages * 5) // 4

    def nrm(k, shape, scale):
        return jax.random.normal(k, shape, f32) * scale

    dt = jnp.exp(jax.random.uniform(ks[12], (DEPTH, GDN_HEADS), f32, math.log(1e-3), math.log(1e-1)))
    return {
        'x_prompt': nrm(ks[0], (BATCH, SEQ, D_MODEL), 1.0),
        'x_sample': nrm(ks[1], (DEC_BATCH, DEC_SEQ, D_MODEL), 1.0),
        'state_gdn_conv': nrm(ks[2], (DEPTH, DEC_BATCH, GDN_CONV - 1, 3 * GDN_WIDTH), 1.0),
        'state_gdn_S': nrm(ks[3], (DEPTH, DEC_BATCH, GDN_HEADS, GDN_DK, GDN_DV), 0.1),
        'cache_k': nrm(ks[4], (DEPTH, n_pool, PAGE_SIZE, DIFF_HEADS, 2 * DIFF_DQK), 1.0),
        'cache_v': nrm(ks[5], (DEPTH, n_pool, PAGE_SIZE, DIFF_HEADS, DIFF_DV), 1.0),
        'page_table': jax.random.permutation(ks[6], n_pool)[:DEC_BATCH * n_pages]
                      .reshape(DEC_BATCH, n_pages).astype(jnp.int32),
        'state_ffn_conv': nrm(ks[7], (DEPTH, DEC_BATCH, FFN_CONV - 1, 2 * D_FF), 1.0),
        'attn_norm_g': 1.0 + nrm(ks[8], (DEPTH, D_MODEL), 0.02),
        'w_in': nrm(ks[9], (DEPTH, D_MODEL, IN_COLS), D_MODEL ** -0.5),
        'gdn_conv_w': nrm(ks[10], (DEPTH, GDN_CONV, 3 * GDN_WIDTH), GDN_CONV ** -0.5),
        'gdn_A_log': jnp.log(jax.random.uniform(ks[11], (DEPTH, GDN_HEADS), f32, 1.0, 16.0)),
        'gdn_dt_bias': dt + jnp.log(-jnp.expm1(-dt)),
        'gdn_out_norm_g': 1.0 + nrm(ks[13], (DEPTH, GDN_DV), 0.02),
        'diff_q_norm_g': 1.0 + nrm(ks[14], (DEPTH, DIFF_DQK), 0.02),
        'diff_k_norm_g': 1.0 + nrm(ks[15], (DEPTH, DIFF_DQK), 0.02),
        'diff_lambda_q1': nrm(ks[16], (DEPTH, DIFF_DQK), 0.1),
        'diff_lambda_k1': nrm(ks[17], (DEPTH, DIFF_DQK), 0.1),
        'diff_lambda_q2': nrm(ks[18], (DEPTH, DIFF_DQK), 0.1),
        'diff_lambda_k2': nrm(ks[19], (DEPTH, DIFF_DQK), 0.1),
        'diff_subln_g': 1.0 + nrm(ks[20], (DEPTH, DIFF_DV), 0.02),
        'w_out': nrm(ks[21], (DEPTH, MIX_WIDTH, D_MODEL), MIX_WIDTH ** -0.5),
        'ffn_norm_g': 1.0 + nrm(ks[22], (DEPTH, D_MODEL), 0.02),
        'w_up': nrm(ks[23], (DEPTH, D_MODEL, 2 * D_FF), D_MODEL ** -0.5),
        'ffn_conv_w': nrm(ks[24], (DEPTH, FFN_CONV, 2 * D_FF), FFN_CONV ** -0.5),
        'ffn_conv_b': nrm(ks[25], (DEPTH, 2 * D_FF), 0.01),
        'w_down': nrm(ks[26], (DEPTH, D_FF, D_MODEL), D_FF ** -0.5),
    }


def reference(x_prompt, x_sample, state_gdn_conv, state_gdn_S, cache_k, cache_v, page_table,
              state_ffn_conv, attn_norm_g, w_in, gdn_conv_w, gdn_A_log, gdn_dt_bias,
              gdn_out_norm_g, diff_q_norm_g, diff_k_norm_g, diff_lambda_q1, diff_lambda_k1,
              diff_lambda_q2, diff_lambda_k2, diff_subln_g, w_out, ffn_norm_g, w_up,
              ffn_conv_w, ffn_conv_b, w_down):
    B = x_prompt.shape[0]
    Bd = x_sample.shape[0]
    dt = x_prompt.dtype
    n_pages = page_table.shape[1]
    past_len = n_pages * cache_k.shape[2]
    hp, hs = x_prompt, x_sample
    pc, pS, pk, pv, pf = [], [], [], [], []
    sc, sS, sk, sv, sf = [], [], [], [], []
    for l in range(DEPTH):
        wl = (attn_norm_g[l], w_in[l], gdn_conv_w[l], gdn_A_log[l], gdn_dt_bias[l],
              gdn_out_norm_g[l], diff_q_norm_g[l], diff_k_norm_g[l], diff_lambda_q1[l],
              diff_lambda_k1[l], diff_lambda_q2[l], diff_lambda_k2[l], diff_subln_g[l],
              w_out[l], ffn_norm_g[l], w_up[l], ffn_conv_w[l], ffn_conv_b[l], w_down[l])
        lam_init = 0.8 - 0.6 * math.exp(-0.3 * l)
        hp, c1, S1, k1, v1, f1 = _hybrid_layer(
            hp,
            jnp.zeros((B, GDN_CONV - 1, 3 * GDN_WIDTH), dt),
            jnp.zeros((B, GDN_HEADS, GDN_DK, GDN_DV), jnp.float32),
            jnp.zeros((B, 0, DIFF_HEADS, 2 * DIFF_DQK), dt),
            jnp.zeros((B, 0, DIFF_HEADS, DIFF_DV), dt),
            jnp.zeros((B, FFN_CONV - 1, 2 * D_FF), dt),
            wl, lam_init)
        past_k = cache_k[l][page_table].reshape(Bd, past_len, DIFF_HEADS, 2 * DIFF_DQK)
        past_v = cache_v[l][page_table].reshape(Bd, past_len, DIFF_HEADS, DIFF_DV)
        hs, c2, S2, k2, v2, f2 = _hybrid_layer(
            hs, state_gdn_conv[l], state_gdn_S[l], past_k, past_v, state_ffn_conv[l], wl, lam_init)
        pc.append(c1); pS.append(S1); pk.append(k1); pv.append(v1); pf.append(f1)
        sc.append(c2); sS.append(S2); sk.append(k2); sv.append(v2); sf.append(f2)
    return (hp, hs, jnp.stack(pc), jnp.stack(pS), jnp.stack(pk), jnp.stack(pv), jnp.stack(pf),
            jnp.stack(sc), jnp.stack(sS), jnp.stack(sk), jnp.stack(sv), jnp.stack(sf))
```

```cpp
#include <hip/hip_runtime.h>
#include <cstdio>
#include <cstdint>
constexpr int DMODEL = 1024;
constexpr int TP = 16384, TSM = 512, MT = TP + TSM;
constexpr int NIN = 3584, INC = 3592, FF = 2816, FF2 = 5632;
constexpr float EPS = 1e-6f;
constexpr float C2 = 0.125f * 1.4426950408889634f;
constexpr size_t O_Y = 0, O_GCP = 17301504, O_SP = 17319936, O_KP = 17582080, O_VP = 25970688, O_FCP = 34359296, O_GCS = 34404352, O_SS = 34994176, O_KS = 43382784, O_VS = 43644928, O_FCS = 43907072, O_END = 45348864;
constexpr size_t MiB = 1u << 20;
constexpr size_t WS_CTL = 0, CTL_ZERO_BYTES = 1 * MiB;
constexpr size_t WS_WIN = 2 * MiB, WS_WOUT = 10 * MiB, WS_WUP = 12 * MiB, WS_WDN = 24 * MiB;
constexpr size_t WS_CWP = 30 * MiB;
constexpr size_t WS_XN = 32 * MiB, WS_GQKV = 66 * MiB, WS_ZB = 116 * MiB, WS_DQ = 134 * MiB, WS_DK = 151 * MiB, WS_DV = 168 * MiB, WS_BA = 186 * MiB;
constexpr size_t WS_O1 = 188 * MiB, WS_O2 = 205 * MiB, WS_OG = 222 * MiB, WS_AO = 256 * MiB, WS_HB = 290 * MiB, WS_A2 = 324 * MiB, WS_BND = 416 * MiB, WS_US = 440 * MiB, WS_GCH = 452 * MiB, WS_END = 548 * MiB;
constexpr size_t GCH_STRIDE = 98304;
constexpr int CW_TMO = 0, CW_CODE = 1, CW_Q = 64, CW_BAR = 4096, CW_ROWSS = 32768;
namespace pg8 {
#define PG8_LAS __attribute__((address_space(3)))
typedef unsigned short bf16_t;
typedef short bf16x8 __attribute__((ext_vector_type(8)));
typedef float f32x4 __attribute__((ext_vector_type(4)));
typedef unsigned u32x4 __attribute__((ext_vector_type(4)));
constexpr int BM = 256, BK = 64, HALF = 128, HTB = HALF * BK * 2  , STAGE_BYTES = 8 * HTB, NXCD = 8, WGM = 8;

__host__ __device__ __forceinline__ int lds_byte(int r, int c) { const int st = (r >> 4) * 2 + (c >> 5), rr = r & 15, cc = c & 31, ob = rr * 64 + cc * 2; return st * 1024 + (ob ^ (((ob >> 9) & 1) << 5)); }
__host__ __device__ __forceinline__ void stage_rc(int b, int& R, int& C) { const int st = b / 1024, sb = b % 1024, swz = sb ^ (((sb >> 9) & 1) << 5); R = (st >> 1) * 16 + swz / 64; C = (st & 1) * 32 + (swz % 64) / 2; }
__host__ __device__ __forceinline__ int perm32(int rho) { const int n = rho >> 4, i = rho & 15; return 8 * (i >> 2) + 4 * n + (i & 3); }

struct Unit { int pm, pn, koff; };
struct Gemm { const bf16_t* A; const bf16_t* Bt; int M, N, K, lda, ldb; };

struct StaticOrder {
    int nM, nN, nwg, G, c;
    __host__ __device__ void init(int M, int N, int G_, int c_) { nM = M / BM; nN = N / BM; nwg = nM * nN; G = G_; c = c_; }
    __host__ __device__ bool next(int i, Unit& u) const {
        const long L = (long)i * G + c; if (L >= nwg) return false;
        int wgid = (int)L; { const int q = nwg / NXCD, r = nwg % NXCD, xcd = wgid % NXCD, off = wgid / NXCD; wgid = (xcd < r ? xcd * (q + 1) : r * (q + 1) + (xcd - r) * q) + off; }
        const int nig = WGM * nN, gid = wgid / nig, fm = gid * WGM, gsz = (nM - fm) < WGM ? (nM - fm) : WGM;
        u.pm = fm + ((wgid % nig) % gsz); u.pn = (wgid % nig) / gsz; u.koff = 0; return true;
    }
    __device__ __forceinline__ void a_ready(const Unit&) const {}
    __device__ __forceinline__ void done(const Unit&) const {}
};
__device__ __forceinline__ unsigned cvt_pk_bf16(float lo, float hi) { unsigned r; asm volatile("v_cvt_pk_bf16_f32 %0, %1, %2" : "=v"(r) : "v"(lo), "v"(hi)); return r; }
typedef float f32x2 __attribute__((ext_vector_type(2)));
typedef unsigned u32x2 __attribute__((ext_vector_type(2)));
template <int CTRL> __device__ __forceinline__ float dppf(float x) { return __builtin_bit_cast(float, __builtin_amdgcn_mov_dpp(__builtin_bit_cast(int, x), CTRL, 0xf, 0xf, true)); }

struct EpiIn {
    static constexpr bool PERM = true, AFTER_DRAIN = false;
    unsigned char* ws; float* out; const float* gq; long gk_off;
    __device__ __forceinline__ void operator()(const f32x4 (&acc)[2][2][4][2], const Unit& u, int wr, int wc, int fr, int fq) const {
        const int type = u.pn >> 1, cb = (u.pn & 1) * 256 + 64 * wc + 8 * fq;
        const int row0 = u.pm * BM + wr * 64 + fr;
        const bool samp = u.pm >= 64;
        if (type <= 3) {
            bf16_t* dst = (bf16_t*)(ws + ((type == 3) ? WS_ZB : WS_GQKV + 1024 * (size_t)type)); const int ld = (type == 3) ? 512 : 1536;
#pragma unroll
            for (int ai = 0; ai < 2; ++ai)
#pragma unroll
                for (int m = 0; m < 4; ++m) { const int row = row0 + ai * HALF + m * 16;
#pragma unroll
                    for (int bj = 0; bj < 2; ++bj) { const f32x4 v0 = acc[ai][bj][m][0], v1 = acc[ai][bj][m][1];
                        u32x4 w; w.x = cvt_pk_bf16(v0[0], v0[1]); w.y = cvt_pk_bf16(v0[2], v0[3]); w.z = cvt_pk_bf16(v1[0], v1[1]); w.w = cvt_pk_bf16(v1[2], v1[3]);
                        *(u32x4*)(dst + (size_t)row * ld + cb + 32 * bj) = w;
                        if (type < 3) {
                            float* cs = nullptr;
                            if (samp) { const int r = row - TP, t = r & 3; if (t >= 1) cs = out + O_GCS + ((size_t)(r >> 2) * 3 + (t - 1)) * 1536; }
                            else { const int t = row & 4095; if (t >= 4093) cs = out + O_GCP + ((size_t)(row >> 12) * 3 + (t - 4093)) * 1536; }
                            if (cs) { float* p = cs + 512 * type + cb + 32 * bj; *(f32x4*)p = v0; *(f32x4*)(p + 4) = v1; }
                        } } }
            return;
        }
        const size_t ooff = (type == 5) ? (samp ? O_KS - (size_t)TP * 512 : O_KP) : (samp ? O_VS - (size_t)TP * 512 : O_VP);
        float* ob = (type == 4) ? nullptr : out + ooff;
        bf16_t* bd = (bf16_t*)(ws + WS_DQ + (size_t)(type - 4) * (WS_DK - WS_DQ));
        f32x4 gv[2][2];
#pragma unroll
        for (int bj = 0; bj < 2; ++bj)
#pragma unroll
            for (int n = 0; n < 2; ++n) { const float* gp = gq + ((type == 5) ? gk_off : 0); gv[bj][n] = (type == 6) ? (f32x4){1.f, 1.f, 1.f, 1.f} : *(const f32x4*)(gp + 32 * bj + 8 * fq + 4 * n); }
#pragma unroll
        for (int ai = 0; ai < 2; ++ai)
#pragma unroll
            for (int m = 0; m < 4; ++m) { const int row = row0 + ai * HALF + m * 16;
                float rs = 1.f;
                if (type != 6) { float ss = 0.f;
#pragma unroll
                    for (int bj = 0; bj < 2; ++bj)
#pragma unroll
                        for (int n = 0; n < 2; ++n) { const f32x4 x = acc[ai][bj][m][n]; ss += (x[0] * x[0] + x[1] * x[1]) + (x[2] * x[2] + x[3] * x[3]); }
                    ss += __shfl_xor(ss, 16); ss += __shfl_xor(ss, 32);
                    rs = 1.0f / sqrtf(ss * (1.0f / 64.0f) + EPS); if (type == 4) rs *= C2; }
#pragma unroll
                for (int bj = 0; bj < 2; ++bj) { const f32x4 v0 = acc[ai][bj][m][0] * rs * gv[bj][0], v1 = acc[ai][bj][m][1] * rs * gv[bj][1];
                    u32x4 w; w.x = cvt_pk_bf16(v0[0], v0[1]); w.y = cvt_pk_bf16(v0[2], v0[3]); w.z = cvt_pk_bf16(v1[0], v1[1]); w.w = cvt_pk_bf16(v1[2], v1[3]);
                    *(u32x4*)(bd + (size_t)row * 512 + cb + 32 * bj) = w;
                    if (ob) { float* p = ob + (size_t)row * 512 + cb + 32 * bj; *(f32x4*)p = v0; *(f32x4*)(p + 4) = v1; } } }
    }
};

struct EpiOut {
    static constexpr bool PERM = true, AFTER_DRAIN = false;
    const float* xp; const float* xs; float* y; bf16_t* hb; float* rowss;
    __device__ __forceinline__ void operator()(const f32x4 (&acc)[2][2][4][2], const Unit& u, int wr, int wc, int fr, int fq) const {
        const int row0 = u.pm * BM + wr * 64 + fr, col0 = u.pn * BM + wc * 32 + 8 * fq;
        const float* xb = (u.pm >= 64) ? xs - (size_t)TP * 1024 : xp;
#pragma unroll
        for (int ai = 0; ai < 2; ++ai)
#pragma unroll
            for (int m = 0; m < 4; ++m) { const int row = row0 + ai * HALF + m * 16; const size_t off = (size_t)row * 1024 + col0; float ss = 0.f;
#pragma unroll
                for (int bj = 0; bj < 2; ++bj) { const f32x4 x0 = *(const f32x4*)(xb + off + bj * HALF), x1 = *(const f32x4*)(xb + off + bj * HALF + 4);
                    const f32x4 v0 = acc[ai][bj][m][0] + x0, v1 = acc[ai][bj][m][1] + x1;
                    *(f32x4*)(y + off + bj * HALF) = v0; *(f32x4*)(y + off + bj * HALF + 4) = v1;
                    u32x4 w; w.x = cvt_pk_bf16(v0[0], v0[1]); w.y = cvt_pk_bf16(v0[2], v0[3]); w.z = cvt_pk_bf16(v1[0], v1[1]); w.w = cvt_pk_bf16(v1[2], v1[3]);
                    *(u32x4*)(hb + off + bj * HALF) = w;
                    ss += (v0[0] * v0[0] + v0[1] * v0[1]) + (v0[2] * v0[2] + v0[3] * v0[3]) + (v1[0] * v1[0] + v1[1] * v1[1]) + (v1[2] * v1[2] + v1[3] * v1[3]); }
                ss += __shfl_xor(ss, 16); ss += __shfl_xor(ss, 32);
                if (fq == 0) atomicAdd(rowss + row, ss); }
    }
};

struct EpiUp {
    static constexpr bool PERM = true, AFTER_DRAIN = false;
    bf16_t* a2; float* bnd; float* us; const float* rowss; const float* cwp;
    __device__ __forceinline__ void operator()(const f32x4 (&acc)[2][2][4][2], const Unit& u, int wr, int wc, int fr, int fq) const {
        const int gc0 = 128 * u.pn + 32 * wc + 8 * fq;
        if (u.pm >= 64) {
#pragma unroll
            for (int ai = 0; ai < 2; ++ai)
#pragma unroll
                for (int m = 0; m < 4; ++m) { const int row = u.pm * BM + ai * HALF + wr * 64 + m * 16 + fr; const float rs = 1.0f / sqrtf(rowss[row] * (1.0f / 1024.0f) + EPS);
                    float* dst = us + (size_t)(row - TP) * FF2 + gc0;
#pragma unroll
                    for (int bj = 0; bj < 2; ++bj)
#pragma unroll
                        for (int n = 0; n < 2; ++n) *(f32x4*)(dst + bj * FF + 4 * n) = acc[ai][bj][m][n] * rs; }
            return;
        }
#pragma unroll
        for (int ai = 0; ai < 2; ++ai) {
            const int rowb = u.pm * BM + ai * HALF + wr * 64, blk = rowb >> 6;
            float rs[4];
#pragma unroll
            for (int m = 0; m < 4; ++m) rs[m] = 1.0f / sqrtf(rowss[rowb + 16 * m + fr] * (1.0f / 1024.0f) + EPS);
            if (fr < 2) {
#pragma unroll
                for (int n = 0; n < 2; ++n) { float* p = bnd + ((size_t)blk * 4 + fr) * FF2 + gc0 + 4 * n; *(f32x4*)p = acc[ai][0][0][n] * rs[0]; *(f32x4*)(p + FF) = acc[ai][1][0][n] * rs[0]; } }
            if (fr >= 14) {
#pragma unroll
                for (int n = 0; n < 2; ++n) { float* p = bnd + ((size_t)blk * 4 + 2 + (fr - 14)) * FF2 + gc0 + 4 * n; *(f32x4*)p = acc[ai][0][3][n] * rs[3]; *(f32x4*)(p + FF) = acc[ai][1][3][n] * rs[3]; } }
            float res[4][8];
#pragma unroll
            for (int n = 0; n < 2; ++n)
#pragma unroll
                for (int eh = 0; eh < 2; ++eh) {
                    const float* wp = cwp + (size_t)gc0 * 8 + (4 * n + 2 * eh) * 8;
                    const f32x4 wa0 = *(const f32x4*)wp, wa1 = *(const f32x4*)(wp + 4), wb0 = *(const f32x4*)(wp + 8), wb1 = *(const f32x4*)(wp + 12);
                    const float g0[2] = {wa0[0], wb0[0]}, g1[2] = {wa0[1], wb0[1]}, g2[2] = {wa0[2], wb0[2]}, gb[2] = {wa0[3], wb0[3]};
                    const float v0[2] = {wa1[0], wb1[0]}, v1[2] = {wa1[1], wb1[1]}, v2[2] = {wa1[2], wb1[2]}, vb[2] = {wa1[3], wb1[3]};
                    float pg[2] = {0.f, 0.f}, pv[2] = {0.f, 0.f};
#pragma unroll
                    for (int m = 0; m < 4; ++m)
#pragma unroll
                        for (int e = 0; e < 2; ++e) { const float ug = acc[ai][0][m][n][2 * eh + e] * rs[m], uv = acc[ai][1][m][n][2 * eh + e] * rs[m];
                            const float a1 = dppf<0x121>(ug), a1p = dppf<0x121>(pg[e]), a2_ = dppf<0x122>(ug), a2p = dppf<0x122>(pg[e]);
                            const float b1 = dppf<0x121>(uv), b1p = dppf<0x121>(pv[e]), b2_ = dppf<0x122>(uv), b2p = dppf<0x122>(pv[e]);
                            const float yg = g0[e] * ((fr < 2) ? a2p : a2_) + g1[e] * ((fr == 0) ? a1p : a1) + g2[e] * ug + gb[e];
                            const float yv = v0[e] * ((fr < 2) ? b2p : b2_) + v1[e] * ((fr == 0) ? b1p : b1) + v2[e] * uv + vb[e];
                            float rr = yg / (1.0f + __expf(-yg)) * yv; asm volatile("" : "+v"(rr));
                            res[m][4 * n + 2 * eh + e] = rr; pg[e] = ug; pv[e] = uv; }
                }
#pragma unroll
            for (int m = 0; m < 4; ++m) if (!(m == 0 && fr < 2)) {
                u32x4 w; w.x = cvt_pk_bf16(res[m][0], res[m][1]); w.y = cvt_pk_bf16(res[m][2], res[m][3]); w.z = cvt_pk_bf16(res[m][4], res[m][5]); w.w = cvt_pk_bf16(res[m][6], res[m][7]);
                *(u32x4*)(a2 + (size_t)(rowb + 16 * m + fr) * FF + gc0) = w; }
            __builtin_amdgcn_sched_barrier(0);
        }
    }
};

struct EpiDown {
    static constexpr bool PERM = true, AFTER_DRAIN = false;
    float* y;
    __device__ __forceinline__ void operator()(const f32x4 (&acc)[2][2][4][2], const Unit& u, int wr, int wc, int fr, int fq) const {
        const int row0 = u.pm * BM + wr * 64 + fr, col0 = u.pn * BM + wc * 32 + 8 * fq;
#pragma unroll
        for (int ai = 0; ai < 2; ++ai)
#pragma unroll
            for (int m = 0; m < 4; ++m) { float* rowp = y + (size_t)(row0 + ai * HALF + m * 16) * 1024 + col0;
#pragma unroll
                for (int bj = 0; bj < 2; ++bj)
#pragma unroll
                    for (int n = 0; n < 2; ++n) { float* p = rowp + bj * HALF + 4 * n; *(f32x4*)p = *(const f32x4*)p + acc[ai][bj][m][n]; } }
    }
};

template <class Epi, class Sched, bool ALIGN_EPI = false, bool SP2 = false>
__device__ __forceinline__ void gemm_phase(PG8_LAS unsigned char* lds, const Gemm g, const Sched& S, const Epi& E) {
    const int tid = threadIdx.x, wid = __builtin_amdgcn_readfirstlane(tid >> 6), lane = tid & 63, wr = wid >> 2, wc = wid & 3, fr = lane & 15, fq = lane >> 4;
    const int K = g.K, nt = K / BK;
    unsigned voffA[2], voffB[2];
#pragma unroll
    for (int i = 0; i < 2; ++i) { int R, C; stage_rc(tid * 16 + i * 8192, R, C); const int Rb = Epi::PERM ? ((R & ~31) + perm32(R & 31)) : R;
        voffA[i] = (unsigned)(R * g.lda + C) * 2u; voffB[i] = (unsigned)(Rb * g.ldb + C) * 2u; }
    const size_t kstep = (size_t)(BK * 2);
    const size_t hstepA = (size_t)HALF * g.lda * 2, hstepB = (size_t)HALF * g.ldb * 2;
    const size_t tstepA = 2 * hstepA, tstepB = 2 * hstepB;
    const unsigned ldsw = (unsigned)wid * 1024u;
    const int aoff = lds_byte(wr * 64 + fr, fq * 8), boff = lds_byte(wc * 32 + fr, fq * 8);
#define PG8_SA(b, h) (((b) * 2 + (h)) * HTB)
#define PG8_SB(b, h) ((4 + (b) * 2 + (h)) * HTB)
#define PG8_STAGE(bufoff, gbase, voff) do { _Pragma("unroll") for (int _i = 0; _i < 2; ++_i) \
        __builtin_amdgcn_global_load_lds((const unsigned*)((const char*)(gbase) + (voff)[_i]), (PG8_LAS unsigned*)(lds + (bufoff) + ldsw + _i * 8192), 16, 0, 0); } while (0)
#define PG8_LDA(dst, b, h) do { _Pragma("unroll") for (int m = 0; m < 4; ++m) _Pragma("unroll") for (int k = 0; k < 2; ++k) dst[m][k] = *(const PG8_LAS bf16x8*)(lds + PG8_SA(b, h) + aoff + m * 2048 + k * 1024); } while (0)
#define PG8_LDB(dst, b, h) do { _Pragma("unroll") for (int n = 0; n < 2; ++n) _Pragma("unroll") for (int k = 0; k < 2; ++k) dst[n][k] = *(const PG8_LAS bf16x8*)(lds + PG8_SB(b, h) + boff + n * 2048 + k * 1024); } while (0)
#define PG8_MMA(ai, bj, At, Bt) do { __builtin_amdgcn_s_setprio(1); _Pragma("unroll") for (int m = 0; m < 4; ++m) _Pragma("unroll") for (int n = 0; n < 2; ++n) _Pragma("unroll") for (int k = 0; k < 2; ++k) \
        acc[ai][bj][m][n] = __builtin_amdgcn_mfma_f32_16x16x32_bf16(Bt[n][k], At[m][k], acc[ai][bj][m][n], 0, 0, 0); __builtin_amdgcn_s_setprio(0); } while (0)
#define PG8_WAIT_V(n) asm volatile("s_waitcnt vmcnt(" #n ")" ::: "memory")
#define PG8_WAIT_L(n) asm volatile("s_waitcnt lgkmcnt(" #n ")" ::: "memory")
#define PG8_BAR __builtin_amdgcn_s_barrier()
#define PG8_SCHED __builtin_amdgcn_sched_barrier(0)
    Unit cur, nxt; int ui = 0;
    if (!S.next(0, cur)) return;
    f32x4 acc[2][2][4][2];
#pragma unroll
    for (int a = 0; a < 2; ++a)
#pragma unroll
        for (int b = 0; b < 2; ++b)
#pragma unroll
            for (int m = 0; m < 4; ++m)
#pragma unroll
                for (int n = 0; n < 2; ++n) acc[a][b][m][n] = (f32x4){0.f, 0.f, 0.f, 0.f};
    bf16x8 At[4][2], B0[2][2], B1[2][2];
    const char* cA = (const char*)g.A + (size_t)cur.pm * tstepA + (size_t)cur.koff * 2; const char* cB = (const char*)g.Bt + (size_t)cur.pn * tstepB + (size_t)cur.koff * 2;
    S.a_ready(cur);
    if constexpr (SP2) {
        PG8_STAGE(PG8_SB(0, 0), cB, voffB); PG8_STAGE(PG8_SB(0, 1), cB + hstepB, voffB); PG8_STAGE(PG8_SA(0, 0), cA, voffA); PG8_STAGE(PG8_SA(0, 1), cA + hstepA, voffA);
        if (wr == 1) PG8_BAR;
        PG8_WAIT_V(2); PG8_BAR;
        PG8_STAGE(PG8_SB(1, 0), cB + kstep, voffB); PG8_STAGE(PG8_SA(1, 0), cA + kstep, voffA); PG8_STAGE(PG8_SB(1, 1), cB + hstepB + kstep, voffB);
        PG8_WAIT_V(6); PG8_BAR;
    } else {
        PG8_STAGE(PG8_SB(0, 0), cB, voffB); PG8_STAGE(PG8_SA(0, 0), cA, voffA); PG8_STAGE(PG8_SB(0, 1), cB + hstepB, voffB); PG8_STAGE(PG8_SA(0, 1), cA + hstepA, voffA);
        if (wr == 1) PG8_BAR;
        PG8_WAIT_V(4); PG8_BAR;
        PG8_STAGE(PG8_SB(1, 0), cB + kstep, voffB); PG8_STAGE(PG8_SA(1, 0), cA + kstep, voffA); PG8_STAGE(PG8_SB(1, 1), cB + hstepB + kstep, voffB);
        PG8_WAIT_V(6); PG8_BAR;
    }
    for (;;) {
        const bool has_next = S.next(ui + 1, nxt);
        const char* nA = has_next ? (const char*)g.A + (size_t)nxt.pm * tstepA + (size_t)nxt.koff * 2 : cA; const char* nB = has_next ? (const char*)g.Bt + (size_t)nxt.pn * tstepB + (size_t)nxt.koff * 2 : cB;
        for (int t = 0; t < nt; t += 2) {
            const bool last = (t == nt - 2);
            const char* a1 = cA + (size_t)(t + 1) * kstep;
            const char* a2 = last ? nA : cA + (size_t)(t + 2) * kstep; const char* b2 = last ? nB : cB + (size_t)(t + 2) * kstep;
            const char* a3 = a2 + kstep; const char* b3 = b2 + kstep;
            if (last && has_next) S.a_ready(nxt);
            if constexpr (SP2) {
            PG8_LDB(B0, 0, 0); PG8_LDB(B1, 0, 1); PG8_SCHED; PG8_LDA(At, 0, 0); PG8_STAGE(PG8_SA(1, 1), a1 + hstepA, voffA);
            PG8_WAIT_V(8); PG8_WAIT_L(0); PG8_BAR; PG8_MMA(0, 0, At, B0); PG8_MMA(0, 1, At, B1); PG8_BAR; PG8_SCHED;
            PG8_LDA(At, 0, 1); PG8_STAGE(PG8_SB(0, 0), b2, voffB); PG8_STAGE(PG8_SB(0, 1), b2 + hstepB, voffB); PG8_STAGE(PG8_SA(0, 0), a2, voffA);
            PG8_WAIT_V(8); PG8_WAIT_L(0); PG8_BAR; PG8_MMA(1, 0, At, B0); PG8_MMA(1, 1, At, B1); PG8_BAR; PG8_SCHED;
            PG8_LDB(B0, 1, 0); PG8_LDB(B1, 1, 1); PG8_SCHED; PG8_LDA(At, 1, 0); PG8_STAGE(PG8_SA(0, 1), a2 + hstepA, voffA);
            PG8_WAIT_V(8); PG8_WAIT_L(0); PG8_BAR; PG8_MMA(0, 0, At, B0); PG8_MMA(0, 1, At, B1); PG8_BAR; PG8_SCHED;
            PG8_LDA(At, 1, 1); PG8_STAGE(PG8_SB(1, 0), b3, voffB); PG8_STAGE(PG8_SB(1, 1), b3 + hstepB, voffB); PG8_STAGE(PG8_SA(1, 0), a3, voffA);
            PG8_WAIT_V(8); PG8_WAIT_L(0); PG8_BAR; PG8_MMA(1, 0, At, B0); PG8_MMA(1, 1, At, B1); PG8_BAR; PG8_SCHED;
            } else {
            PG8_LDB(B0, 0, 0); PG8_SCHED; PG8_LDA(At, 0, 0); PG8_STAGE(PG8_SA(1, 1), a1 + hstepA, voffA);
            PG8_WAIT_L(8); PG8_BAR; PG8_WAIT_L(0); PG8_MMA(0, 0, At, B0); PG8_BAR; PG8_SCHED;
            PG8_LDB(B1, 0, 1); PG8_STAGE(PG8_SB(0, 0), b2, voffB);
            PG8_BAR; PG8_WAIT_L(0); PG8_MMA(0, 1, At, B1); PG8_BAR;
            PG8_LDA(At, 0, 1); PG8_STAGE(PG8_SA(0, 0), a2, voffA);
            PG8_BAR; PG8_WAIT_L(0); PG8_MMA(1, 0, At, B0); PG8_BAR; PG8_SCHED;
            PG8_STAGE(PG8_SB(0, 1), b2 + hstepB, voffB);
            PG8_WAIT_V(6); PG8_BAR; PG8_MMA(1, 1, At, B1); PG8_BAR;
            PG8_LDB(B0, 1, 0); PG8_SCHED; PG8_LDA(At, 1, 0); PG8_STAGE(PG8_SA(0, 1), a2 + hstepA, voffA);
            PG8_WAIT_L(8); PG8_BAR; PG8_WAIT_L(0); PG8_MMA(0, 0, At, B0); PG8_BAR; PG8_SCHED;
            PG8_LDB(B1, 1, 1); PG8_STAGE(PG8_SB(1, 0), b3, voffB);
            PG8_BAR; PG8_WAIT_L(0); PG8_MMA(0, 1, At, B1); PG8_BAR;
            PG8_LDA(At, 1, 1); PG8_STAGE(PG8_SA(1, 0), a3, voffA);
            PG8_BAR; PG8_WAIT_L(0); PG8_MMA(1, 0, At, B0); PG8_BAR; PG8_SCHED;
            PG8_STAGE(PG8_SB(1, 1), b3 + hstepB, voffB);
            PG8_WAIT_V(6); PG8_BAR; PG8_MMA(1, 1, At, B1); PG8_BAR;
            }
        }
        if constexpr (ALIGN_EPI) { if (wr == 0) PG8_BAR; }
        if constexpr (!Epi::AFTER_DRAIN) { E(acc, cur, wr, wc, fr, fq); S.done(cur); }
        if (!has_next) break;
#pragma unroll
        for (int a = 0; a < 2; ++a)
#pragma unroll
            for (int b = 0; b < 2; ++b)
#pragma unroll
                for (int m = 0; m < 4; ++m)
#pragma unroll
                    for (int n = 0; n < 2; ++n) acc[a][b][m][n] = (f32x4){0.f, 0.f, 0.f, 0.f};
        cur = nxt; cA = nA; cB = nB; ++ui;
        if constexpr (ALIGN_EPI) { if (wr == 1) PG8_BAR; }
    }
    PG8_WAIT_V(0);
    if constexpr (!ALIGN_EPI) { if (wr == 0) PG8_BAR; }
    PG8_BAR;
    if constexpr (Epi::AFTER_DRAIN) { E.fused(acc, cur, wr, wc, fr, fq, lds, wid, lane); S.done(cur); }
#undef PG8_SA
#undef PG8_SB
#undef PG8_STAGE
#undef PG8_LDA
#undef PG8_LDB
#undef PG8_MMA
#undef PG8_WAIT_V
#undef PG8_WAIT_L
#undef PG8_BAR
#undef PG8_SCHED
}
}
#include <hip/hip_bf16.h>
#include <cmath>
namespace attn_body {
using bf16=__hip_bfloat16;
using bf16x8=__attribute__((ext_vector_type(8)))short;
using s16x4=__attribute__((ext_vector_type(4)))short;
using f32x16=__attribute__((ext_vector_type(16)))float;
using u32x4=__attribute__((ext_vector_type(4)))unsigned;
constexpr int D=64,DM=512;
constexpr int NW=8,QBLK=32,QB=QBLK*NW,KVBLK=64;
constexpr int ATTN_PITCH=DM, ATTN_UNIT_ROWS=QB;
__device__ __forceinline__ int crow(int r,int hi){return (r&3)+8*(r>>2)+4*hi;}
#define SBAR() __builtin_amdgcn_sched_barrier(0)
__device__ __forceinline__ void cmask(f32x16&p0,f32x16&p1,int jb,int qrel,int hi){
  const float NEG=-INFINITY; int kb=64*jb+4*hi;
  #pragma unroll
  for(int r=0;r<16;++r){int kv=kb+(r&3)+8*(r>>2); if(kv>qrel)p0[r]=NEG; if(kv+32>qrel)p1[r]=NEG;}
}

constexpr int NSLOT=3, SLOTB=8192;
constexpr int LDS_K=0, LDS_V=NSLOT*SLOTB, LDS_WS=2*NSLOT*SLOTB, LDS_OST=LDS_WS+NW*64*4, LDS_BYTES=LDS_OST+NW*4096;
constexpr float C2=0.125f*1.4426950408889634f;
__device__ __forceinline__ void glds16(const void*gsrc,unsigned lds_dst){unsigned keep;
  asm volatile("s_mov_b32 %0, m0\n\ts_mov_b32 m0, %2\n\ts_nop 0\n\tglobal_load_lds_dwordx4 %1, off\n\ts_mov_b32 m0, %0":"=&s"(keep):"v"(gsrc),"s"(lds_dst):"memory");}
__device__ __forceinline__ float max3f(float a,float b,float c){float r;asm("v_max3_f32 %0, %1, %2, %3":"=v"(r):"v"(a),"v"(b),"v"(c));return r;}
__device__ __forceinline__ float max2f(float a,float b){float r;asm("v_max_f32_e32 %0, %1, %2":"=v"(r):"v"(a),"v"(b));return r;}
__device__ __forceinline__ float fadd_s(float a,float b){float r;asm("v_add_f32_e32 %0, %1, %2":"=v"(r):"v"(a),"v"(b));return r;}
__device__ __forceinline__ float fsub_s(float a,float b){float r;asm("v_sub_f32_e32 %0, %1, %2":"=v"(r):"v"(a),"v"(b));return r;}
typedef float f32x2_t __attribute__((ext_vector_type(2))); typedef __bf16 bf16x2_t __attribute__((ext_vector_type(2)));
__device__ __forceinline__ unsigned cvtpk_s(float lo,float hi){f32x2_t v={lo,hi};bf16x2_t b=__builtin_convertvector(v,bf16x2_t);return __builtin_bit_cast(unsigned,b);}
#define WAIT_BAR(N) asm volatile("s_waitcnt vmcnt(" #N ") lgkmcnt(0)\n\ts_barrier":::"memory")

__device__ __forceinline__ void qkt(f32x16&p0,f32x16&p1,const char*Kslot,const bf16x8*qr,const f32x16&negm,int r32,int hi){
  const char*kb=Kslot+hi*1024+r32*16;
  #pragma unroll
  for(int d0=0;d0<4;++d0){
    const bf16x8 b0=*reinterpret_cast<const bf16x8*>(kb+d0*2048);
    const bf16x8 b1=*reinterpret_cast<const bf16x8*>(kb+d0*2048+512);
    if(d0==0){p0=__builtin_amdgcn_mfma_f32_32x32x16_bf16(b0,qr[0],negm,0,0,0);p1=__builtin_amdgcn_mfma_f32_32x32x16_bf16(b1,qr[0],negm,0,0,0);}
    else{p0=__builtin_amdgcn_mfma_f32_32x32x16_bf16(b0,qr[d0],p0,0,0,0);p1=__builtin_amdgcn_mfma_f32_32x32x16_bf16(b1,qr[d0],p1,0,0,0);}}
}
typedef __attribute__((address_space(3))) const char* lds_cptr;
typedef short v4i16_t __attribute__((ext_vector_type(4)));
__device__ __forceinline__ void kload8(bf16x8*kf,lds_cptr kp){
  kf[0]=*(const __attribute__((address_space(3))) bf16x8*)(kp);      kf[1]=*(const __attribute__((address_space(3))) bf16x8*)(kp+512);
  kf[2]=*(const __attribute__((address_space(3))) bf16x8*)(kp+2048); kf[3]=*(const __attribute__((address_space(3))) bf16x8*)(kp+2560);
  kf[4]=*(const __attribute__((address_space(3))) bf16x8*)(kp+4096); kf[5]=*(const __attribute__((address_space(3))) bf16x8*)(kp+4608);
  kf[6]=*(const __attribute__((address_space(3))) bf16x8*)(kp+6144); kf[7]=*(const __attribute__((address_space(3))) bf16x8*)(kp+6656);
}
__device__ __forceinline__ void kload2(bf16x8*kf,lds_cptr kp,int j){ kf[2*j]=*(const __attribute__((address_space(3))) bf16x8*)(kp+j*2048); kf[2*j+1]=*(const __attribute__((address_space(3))) bf16x8*)(kp+j*2048+512); }
__device__ __forceinline__ s16x4 vtr(lds_cptr p){ return __builtin_bit_cast(s16x4,__builtin_amdgcn_ds_read_tr16_b64_v4i16((__attribute__((address_space(3))) v4i16_t*)p)); }
__device__ __forceinline__ float rowmax(const f32x16&p0,const f32x16&p1){
  float a=max3f(p0[0],p0[1],p1[0]),b=max3f(p0[2],p0[3],p1[1]);a=max3f(a,p1[2],p1[3]);
  #pragma unroll
  for(int r=4;r<16;r+=4){a=max3f(a,p0[r],p0[r+1]);b=max3f(b,p0[r+2],p0[r+3]);a=max3f(a,p1[r],p1[r+1]);b=max3f(b,p1[r+2],p1[r+3]);}
  const float m=max2f(a,b);
  auto rr=__builtin_amdgcn_permlane32_swap(__float_as_uint(m),__float_as_uint(m),false,false);
  return max2f(__uint_as_float(rr[0]),__uint_as_float(rr[1]));
}
__device__ __forceinline__ void pv(f32x16*o,int vb,bf16x8 pa0,bf16x8 pa1,bf16x8 pa2,bf16x8 pa3){
  #pragma unroll
  for(int d0=0;d0<2;++d0){s16x4 lo[4],hi[4];
    #pragma unroll
    for(int ks=0;ks<4;++ks){
      asm volatile("ds_read_b64_tr_b16 %0,%1 offset:%c2":"=&v"(lo[ks]):"v"(vb),"i"(d0*4096+ks*1024):"memory");
      asm volatile("ds_read_b64_tr_b16 %0,%1 offset:%c2":"=&v"(hi[ks]):"v"(vb),"i"(d0*4096+ks*1024+512):"memory");}
    asm volatile("s_waitcnt lgkmcnt(0)":::"memory");SBAR();
    #define PK(k) (bf16x8){lo[k][0],lo[k][1],lo[k][2],lo[k][3],hi[k][0],hi[k][1],hi[k][2],hi[k][3]}
    o[d0]=__builtin_amdgcn_mfma_f32_32x32x16_bf16(pa0,PK(0),o[d0],0,0,0);
    o[d0]=__builtin_amdgcn_mfma_f32_32x32x16_bf16(pa1,PK(1),o[d0],0,0,0);
    o[d0]=__builtin_amdgcn_mfma_f32_32x32x16_bf16(pa2,PK(2),o[d0],0,0,0);
    o[d0]=__builtin_amdgcn_mfma_f32_32x32x16_bf16(pa3,PK(3),o[d0],0,0,0);
    #undef PK
  }
}

#ifndef ATTN_STORE16
#define ATTN_STORE16(p,v) (*(u32x4*)(p)=(v))
#endif
template<int THRL> __device__ __forceinline__ void attn_unit(int tid_in,int qb,const bf16*Qb,const bf16*__restrict__ Kh,const bf16*__restrict__ Vh,bf16*Ob,char*shm){
  const int tid=tid_in,lane=tid&63,r32=lane&31,hi=lane>>5; const int wid=__builtin_amdgcn_readfirstlane(tid>>6);
  const int q0=qb*QB;
  const bf16*Qw=Qb+(long)(q0+wid*QBLK)*DM;
  const unsigned lds0=(unsigned)(uintptr_t)shm;
  float*wsf=(float*)(shm+LDS_WS)+wid*64;
  const bf16*ksrc=Kh+(long)lane*DM+wid*8;
  const bf16*vsrc=Vh+(long)(16*(wid&3)+(lane>>2))*DM+(wid>>2)*32+(lane&3)*8;
  const unsigned kdst=lds0+LDS_K+wid*1024, vdst=lds0+LDS_V+wid*1024;
  #define DMA_K(t,slot) glds16(ksrc+(long)(t)*KVBLK*DM,(unsigned)__builtin_amdgcn_readfirstlane(kdst+(slot)))
  #define DMA_V(t,slot) glds16(vsrc+(long)(t)*KVBLK*DM,(unsigned)__builtin_amdgcn_readfirstlane(vdst+(slot)))
  const int vb0=(int)(lds0+LDS_V)+((lane>>4)&1)*32+(lane&3)*8+(4*hi+((lane&15)>>2))*64;
  const char*Kbase=shm+LDS_K; bf16x8 kf[8];
  const lds_cptr shm3=(lds_cptr)shm; const lds_cptr kp0=shm3+LDS_K+hi*1024+r32*16; const lds_cptr vp0=shm3+LDS_V+((lane>>4)&1)*32+(lane&3)*8+(4*hi+((lane&15)>>2))*64;
  const int NT=(q0+QB)/KVBLK;
  DMA_K(0,0);DMA_V(0,0);DMA_K(1,SLOTB);
  bf16x8 qr[4];
  #pragma unroll
  for(int d0=0;d0<4;++d0)qr[d0]=*reinterpret_cast<const bf16x8*>(&Qw[(long)r32*DM+d0*16+hi*8]);
  float mhat=0.f,l_reg=0.f;f32x16 o[2];o[0]=f32x16{};o[1]=f32x16{};f32x16 negm=f32x16{};asm volatile("":"+v"(negm));
  const int qrel=wid*QBLK+r32;
  #define CMASK(P0,P1,t) do{int jb_=(t)-(NT-4); if(jb_>=0)cmask(P0,P1,jb_,qrel,hi);}while(0)
  bool resc=false;
  #define START(P0,P1) do{ const float rm=rowmax(P0,P1); resc=false; \
    { const float dl=rm; mhat=fadd_s(mhat,dl); \
      _Pragma("unroll") for(int r=0;r<16;++r){P0[r]=fsub_s(P0[r],dl);P1[r]=fsub_s(P1[r],dl);} \
      _Pragma("unroll") for(int r=0;r<16;++r)negm[r]=-mhat; asm volatile("":"+v"(negm)); } \
    _Pragma("unroll") for(int r=0;r<16;++r)P0[r]=__builtin_amdgcn_exp2f(P0[r]); }while(0)
  #define RESC() do{ if(resc){ asm volatile("s_waitcnt lgkmcnt(0)":::"memory"); \
      _Pragma("unroll") for(int d_=0;d_<2;++d_) _Pragma("unroll") for(int r=0;r<16;++r)o[d_][r]*=wsf[crow(r,hi)]; } }while(0)
  f32x16 pA0,pA1,pB0,pB1;
  int sl_prev=0,sl_cur=0,sl_next=SLOTB;
  #define ROT() do{sl_prev=sl_cur;sl_cur=sl_next;sl_next=(sl_next==(NSLOT-1)*SLOTB)?0:sl_next+SLOTB;}while(0)
  DMA_K(2,2*SLOTB);
  WAIT_BAR(3);
  qkt(pA0,pA1,Kbase,qr,negm,r32,hi);asm volatile("s_nop 15\n\ts_nop 7":"+v"(pA0),"+v"(pA1));CMASK(pA0,pA1,0);
  START(pA0,pA1);
  _Pragma("unroll") for(int r=0;r<16;++r)pA1[r]=__builtin_amdgcn_exp2f(pA1[r]);
  WAIT_BAR(0);
  DMA_K(3,0);DMA_V(1,SLOTB);
  ROT();
  kload8(kf,kp0+sl_cur);
  WAIT_BAR(2);
  s16x4 vlo[8],vhi[8]; u32x4 pw0,pw1,pw2,pw3;
  #define PKW(P,B) cvtpk_s(P[B],P[B+1])
  #define PAF(k) __builtin_bit_cast(bf16x8,pw##k)
  #define VFR(i) (bf16x8){vlo[i][0],vlo[i][1],vlo[i][2],vlo[i][3],vhi[i][0],vhi[i][1],vhi[i][2],vhi[i][3]}
  #define PIN(x) asm volatile("":"+v"(x))
  #define MX3(a,b,c) __builtin_fmaxf(__builtin_fmaxf((a),(b)),(c))
  #define GAPA(MF,A0,A1,A2,A3,W0,W1,PW) do{ MF; sacc+=A0; sacc+=A1; sacc+=A2; sacc+=A3; PIN(sacc); W0; W1; PIN(PW); SBAR(); }while(0)
  #define EX(v) __builtin_amdgcn_exp2f(v)
  #define GAPB(MF,X,B) do{ MF; X[B]=EX(X[B]); X[B+1]=EX(X[B+1]); X[B+2]=EX(X[B+2]); X[B+3]=EX(X[B+3]); PIN(X); SBAR(); }while(0)
  #define VRD(i) do{ vlo[i]=vtr(vp_+(((i)>>2)*4096+((i)&3)*1024)); vhi[i]=vtr(vp_+(((i)>>2)*4096+((i)&3)*1024+512)); }while(0)
  #define KRD(G,j) do{ if(G){ kload2(kf,kp0+sl_next,j); SBAR(); } }while(0)
  #define STEP(C0,C1,P0,P1,t,GK,GV,GL) do{ SBAR(); \
    const lds_cptr vp_=vp0+sl_prev; \
    VRD(0); SBAR(); float sacc=(P0[0]+P0[1]); \
    GAPA(C0=__builtin_amdgcn_mfma_f32_32x32x16_bf16(kf[0],qr[0],negm,0,0,0), P0[2],P0[3],P0[4],P0[5],     pw0[0]=PKW(P0,0), pw0[1]=PKW(P0,2), pw0); \
    VRD(4); SBAR(); GAPA(C1=__builtin_amdgcn_mfma_f32_32x32x16_bf16(kf[1],qr[0],negm,0,0,0), P0[6],P0[7],P0[8],P0[9],     pw0[2]=PKW(P0,4), pw0[3]=PKW(P0,6), pw0); \
    VRD(1); SBAR(); GAPA(C0=__builtin_amdgcn_mfma_f32_32x32x16_bf16(kf[2],qr[1],C0,0,0,0),   P0[10],P0[11],P0[12],P0[13], pw1[0]=PKW(P0,8), pw1[1]=PKW(P0,10), pw1); \
    VRD(5); SBAR(); GAPA(C1=__builtin_amdgcn_mfma_f32_32x32x16_bf16(kf[3],qr[1],C1,0,0,0),   P0[14],P0[15],P1[0],P1[1],   pw1[2]=PKW(P0,12),pw1[3]=PKW(P0,14), pw1); \
    VRD(2); SBAR(); GAPA(C0=__builtin_amdgcn_mfma_f32_32x32x16_bf16(kf[4],qr[2],C0,0,0,0),   P1[2],P1[3],P1[4],P1[5],     pw2[0]=PKW(P1,0), pw2[1]=PKW(P1,2), pw2); \
    VRD(6); SBAR(); GAPA(C1=__builtin_amdgcn_mfma_f32_32x32x16_bf16(kf[5],qr[2],C1,0,0,0),   P1[6],P1[7],P1[8],P1[9],     pw2[2]=PKW(P1,4), pw2[3]=PKW(P1,6), pw2); \
    VRD(3); SBAR(); GAPA(C0=__builtin_amdgcn_mfma_f32_32x32x16_bf16(kf[6],qr[3],C0,0,0,0),   P1[10],P1[11],P1[12],P1[13], pw3[0]=PKW(P1,8), pw3[1]=PKW(P1,10), pw3); \
    VRD(7); SBAR(); GAPA(C1=__builtin_amdgcn_mfma_f32_32x32x16_bf16(kf[7],qr[3],C1,0,0,0),   P1[14],P1[15],0.f,0.f,       pw3[2]=PKW(P1,12),pw3[3]=PKW(P1,14), pw3); \
    l_reg+=sacc; \
    if(GK){DMA_K((t)+3,sl_cur);} if(GV){DMA_V((t)+1,sl_next);} \
    CMASK(C0,C1,t); \
    { float a=MX3(C0[0],C0[1],C1[0]),b=MX3(C0[2],C0[3],C1[1]); a=MX3(a,C1[2],C1[3]); \
      _Pragma("unroll") for(int r=4;r<16;r+=4){a=MX3(a,C0[r],C0[r+1]);b=MX3(b,C0[r+2],C0[r+3]);a=MX3(a,C1[r],C1[r+1]);b=MX3(b,C1[r+2],C1[r+3]);} \
      float rm=__builtin_fmaxf(a,b); { auto rr=__builtin_amdgcn_permlane32_swap(__float_as_uint(rm),__float_as_uint(rm),false,false); rm=__builtin_fmaxf(__uint_as_float(rr[0]),__uint_as_float(rr[1])); } \
      resc=false; \
      if(__builtin_expect(__any(rm>(float)THRL),0)){ const float dl=__builtin_fmaxf(rm,0.f); mhat+=dl; \
        _Pragma("unroll") for(int r=0;r<16;++r){C0[r]-=dl;C1[r]-=dl;} \
        _Pragma("unroll") for(int r=0;r<16;++r)negm[r]=-mhat; asm volatile("":"+v"(negm)); \
        const float f=__builtin_amdgcn_exp2f(-dl); l_reg*=f; if(hi==0)wsf[r32]=f; resc=true; } } \
    SBAR(); \
    GAPB(o[0]=__builtin_amdgcn_mfma_f32_32x32x16_bf16(PAF(0),VFR(0),o[0],0,0,0), C0,0); \
    GAPB(o[1]=__builtin_amdgcn_mfma_f32_32x32x16_bf16(PAF(0),VFR(4),o[1],0,0,0), C0,4); \
    KRD(GL,0); GAPB(o[0]=__builtin_amdgcn_mfma_f32_32x32x16_bf16(PAF(1),VFR(1),o[0],0,0,0), C0,8); \
    KRD(GL,1); GAPB(o[1]=__builtin_amdgcn_mfma_f32_32x32x16_bf16(PAF(1),VFR(5),o[1],0,0,0), C0,12); \
    KRD(GL,2); GAPB(o[0]=__builtin_amdgcn_mfma_f32_32x32x16_bf16(PAF(2),VFR(2),o[0],0,0,0), C1,0); \
    KRD(GL,3); GAPB(o[1]=__builtin_amdgcn_mfma_f32_32x32x16_bf16(PAF(2),VFR(6),o[1],0,0,0), C1,4); \
    GAPB(o[0]=__builtin_amdgcn_mfma_f32_32x32x16_bf16(PAF(3),VFR(3),o[0],0,0,0), C1,8); \
    GAPB(o[1]=__builtin_amdgcn_mfma_f32_32x32x16_bf16(PAF(3),VFR(7),o[1],0,0,0), C1,12); \
    }while(0)
  int t=1;
  #undef CMASK
  #define CMASK(P0,P1,t) do{}while(0)
  for(;t+5<NT;t+=2){
    STEP(pB0,pB1,pA0,pA1,t,true,true,true);     WAIT_BAR(2); RESC(); ROT();
    STEP(pA0,pA1,pB0,pB1,t+1,true,true,true);   WAIT_BAR(2); RESC(); ROT();
  }
  #undef CMASK
  #define CMASK(P0,P1,t) do{int jb_=(t)-(NT-4); if(jb_>=0)cmask(P0,P1,jb_,qrel,hi);}while(0)
  #define ENDW(tt) do{ if((tt)+3<NT){WAIT_BAR(2);} else if((tt)+2<NT){WAIT_BAR(1);} else {WAIT_BAR(0);} }while(0)
  for(;t+1<NT;t+=2){
    STEP(pB0,pB1,pA0,pA1,t,(t+3<NT),(t+1<NT),(t+1<NT));       ENDW(t);   RESC(); ROT();
    STEP(pA0,pA1,pB0,pB1,t+1,(t+4<NT),(t+2<NT),(t+2<NT));     ENDW(t+1); RESC(); ROT();
  }
  STEP(pB0,pB1,pA0,pA1,NT-1,false,false,false); RESC();
  { float sacc=pB0[0]+pB0[1]; _Pragma("unroll") for(int r=2;r<16;++r)sacc+=pB0[r]; _Pragma("unroll") for(int r=0;r<16;++r)sacc+=pB1[r]; l_reg+=sacc;
    pw0=(u32x4){PKW(pB0,0),PKW(pB0,2),PKW(pB0,4),PKW(pB0,6)};pw1=(u32x4){PKW(pB0,8),PKW(pB0,10),PKW(pB0,12),PKW(pB0,14)};pw2=(u32x4){PKW(pB1,0),PKW(pB1,2),PKW(pB1,4),PKW(pB1,6)};pw3=(u32x4){PKW(pB1,8),PKW(pB1,10),PKW(pB1,12),PKW(pB1,14)};
    SBAR(); pv(o,vb0+sl_cur,PAF(0),PAF(1),PAF(2),PAF(3)); }
  #undef PKW
  #undef PAF
  #undef VFR
  #undef PIN
  #undef MX3
  #undef GAPA
  #undef GAPB
  #undef EX
  #undef VRD
  #undef KRD
  #undef STEP
  #undef ENDW
  {auto rr=__builtin_amdgcn_permlane32_swap(__float_as_uint(l_reg),__float_as_uint(l_reg),false,false);l_reg=__uint_as_float(rr[0])+__uint_as_float(rr[1]);}
  if(hi==0)wsf[32+r32]=l_reg;asm volatile("s_waitcnt lgkmcnt(0)":::"memory");
  float rli[16];
  #pragma unroll
  for(int r=0;r<16;++r)rli[r]=__builtin_amdgcn_rcpf(wsf[32+crow(r,hi)]);
  bf16*Ow=Ob+(long)(q0+wid*QBLK)*DM;
  { bf16*stg=(bf16*)(shm+LDS_OST)+wid*2048;
    #pragma unroll
    for(int r=0;r<16;++r){const int orow=crow(r,hi);
      #pragma unroll
      for(int d0=0;d0<2;++d0)stg[orow*64+d0*32+r32]=__float2bfloat16(o[d0][r]*rli[r]);}
    asm volatile("s_waitcnt lgkmcnt(0)":::"memory");
    #pragma unroll
    for(int i=0;i<4;++i){const int row=i*8+(lane>>3),ch=lane&7; const u32x4 v=*(const u32x4*)(stg+row*64+ch*8); ATTN_STORE16(Ow+(long)row*DM+ch*8,v);} }
  asm volatile("s_waitcnt lgkmcnt(0)\n\ts_barrier":::"memory");
  #undef DMA_K
  #undef DMA_V
  #undef CMASK
  #undef START
  #undef RESC
  #undef ROT
}

#undef SBAR
#undef WAIT_BAR
}
#define GAS __attribute__((address_space(1)))
#define LAS __attribute__((address_space(3)))
typedef unsigned short bf16;
typedef unsigned v4u __attribute__((ext_vector_type(4)));
typedef float f32x4 __attribute__((ext_vector_type(4)));
typedef short bf16x8 __attribute__((ext_vector_type(8)));
typedef GAS unsigned gu32;
typedef GAS unsigned long long gu64;
#define RLX_AGENT __ATOMIC_RELAXED, __HIP_MEMORY_SCOPE_AGENT
#define LDS_WAIT() asm volatile("s_waitcnt lgkmcnt(0)" ::: "memory")
#define VM_WAIT() asm volatile("s_waitcnt vmcnt(0)" ::: "memory")
__device__ __forceinline__ unsigned long long rt() { return __builtin_amdgcn_s_memrealtime(); }
__device__ __forceinline__ unsigned f2bf(float f) { unsigned u = __builtin_bit_cast(unsigned, f); return (u + 0x7fffu + ((u >> 16) & 1u)) >> 16; }
__device__ __forceinline__ unsigned pk2(float lo, float hi) { return f2bf(lo) | (f2bf(hi) << 16); }

#define XB_TMO      128
#define XB_XCNT(j)  (256  + 64 * (j))
#define XB_XSUB(j)  (1280 + 64 * (j))
#define XB_XGEN(j)  (2304 + 64 * (j))
#define XB_TOP      3328
#define XB_TOPGEN   3392
#define XCD_BAR_WORDS 3456
#define XB_SPIN_CAP (1u << 18)

__device__ __forceinline__ unsigned xb_ld(unsigned* p)              { return __hip_atomic_load(p, __ATOMIC_RELAXED, __HIP_MEMORY_SCOPE_AGENT); }
__device__ __forceinline__ unsigned xb_add(unsigned* p, unsigned v) { return __hip_atomic_fetch_add(p, v, __ATOMIC_RELAXED, __HIP_MEMORY_SCOPE_AGENT); }
__device__ __forceinline__ unsigned xb_xcc_id() { return (unsigned)__builtin_amdgcn_s_getreg((3 << 11) | 20) & 0xFu; }
#define XB_SPIN(cond, bar) do { unsigned _sp = 0; while (cond) { __builtin_amdgcn_s_sleep(1); \
    if ((++_sp & 255u) == 0u) { if (xb_ld(&(bar)[XB_TMO])) break; if (_sp > XB_SPIN_CAP) { atomicAdd(&(bar)[XB_TMO], 1u); break; } } } } while (0)

struct XcdBarrier {
    unsigned* bar; unsigned x;
    volatile LAS unsigned* st;
};

__device__ __forceinline__ XcdBarrier xcd_barrier_post(unsigned* bar, volatile LAS unsigned* st) {
    XcdBarrier b; b.bar = bar; b.x = xb_xcc_id(); b.st = st;
    if (threadIdx.x == 0) (void)xb_add(&bar[XB_XCNT(b.x)], 1u);
    return b;
}
__device__ __forceinline__ void xcd_barrier_complete(unsigned* bar, unsigned x, unsigned& nloc, unsigned& nx) {
    const unsigned G = gridDim.x * gridDim.y * gridDim.z;
    unsigned sum, cnt, mine, sp = 0u;
    for (;;) {
        sum = 0u; cnt = 0u; mine = 0u;
#pragma unroll
        for (unsigned j = 0; j < 16; ++j) { const unsigned c = xb_ld(&bar[XB_XCNT(j)]); sum += c; cnt += (c > 0u) ? 1u : 0u; mine = (j == x) ? c : mine; }
        if (sum == G) break;
        __builtin_amdgcn_s_sleep(1);
        if ((++sp & 255u) == 0u) { if (xb_ld(&bar[XB_TMO])) break; if (sp > XB_SPIN_CAP) { atomicAdd(&bar[XB_TMO], 1u); break; } }
    }
    nloc = mine > 0u ? mine : 1u; nx = cnt > 0u ? cnt : 1u;
}

__device__ __forceinline__ void xcd_barrier(const XcdBarrier& b) {
    asm volatile("s_waitcnt vmcnt(0)" ::: "memory");
    __syncthreads();
    if (threadIdx.x == 0) {
        unsigned* bar = b.bar;
        __builtin_amdgcn_s_waitcnt(0);
        unsigned nloc = b.st[0], nx = b.st[1];
        if (nloc == 0u) { xcd_barrier_complete(bar, b.x, nloc, nx); b.st[0] = nloc; b.st[1] = nx; }
        const unsigned old = xb_add(&bar[XB_XSUB(b.x)], 1u);
        const unsigned gen = old / nloc;
        if (old + 1u == (gen + 1u) * nloc) {
            __builtin_amdgcn_fence(__ATOMIC_RELEASE, "agent");
            asm volatile("s_waitcnt vmcnt(0)" ::: "memory");
            const unsigned og = xb_add(&bar[XB_TOP], 1u);
            const unsigned tg = og / nx;
            if (og + 1u == (tg + 1u) * nx) xb_add(&bar[XB_TOPGEN], 1u);
            else XB_SPIN(xb_ld(&bar[XB_TOPGEN]) == tg, bar);
            __builtin_amdgcn_fence(__ATOMIC_ACQUIRE, "agent");
            xb_add(&bar[XB_XGEN(b.x)], 1u);
            asm volatile("s_waitcnt vmcnt(0)" ::: "memory");
        } else {
            XB_SPIN(xb_ld(&bar[XB_XGEN(b.x)]) == gen, bar);
            __builtin_amdgcn_fence(__ATOMIC_ACQUIRE, "agent");
            asm volatile("s_waitcnt vmcnt(0)" ::: "memory");
        }
    }
    __syncthreads();
}
struct Args { const float* in[27]; const int* pt; float* out; unsigned char* ws; int ph_lo, ph_hi, use_bar, pad; };
enum { I_XP = 0, I_XS, I_GCONV, I_GS, I_CK, I_CV, I_PT, I_FCONV, I_ANG, I_WIN, I_GCW, I_ALOG, I_DTB, I_GNG, I_QNG, I_KNG, I_LQ1, I_LK1, I_LQ2, I_LK2, I_SUBG, I_WOUT, I_FNG, I_WUP, I_FCW, I_FCB, I_WDN };
constexpr int NWAVES = 8;
constexpr int RING_BYTES = 131072, LDSCTL_OFF = RING_BYTES, MISC_OFF = LDSCTL_OFF + 320, LDS_BYTES = 147456;
typedef unsigned v2u __attribute__((ext_vector_type(2)));
typedef float f32x2v __attribute__((ext_vector_type(2)));

__device__ __forceinline__ float wave_sum(float v) {
#pragma unroll
    for (int o = 1; o < 64; o <<= 1) v += __shfl_xor(v, o);
    return v;
}
__device__ __forceinline__ float bf2f(bf16 b) { return __uint_as_float(((unsigned)b) << 16); }
__device__ __forceinline__ float bflo(unsigned w) { return __uint_as_float(w << 16); }
__device__ __forceinline__ float bfhi(unsigned w) { return __uint_as_float(w & 0xffff0000u); }
typedef float f32x2_t __attribute__((ext_vector_type(2))); typedef __bf16 bf16x2_t __attribute__((ext_vector_type(2)));
__device__ __forceinline__ unsigned cvtpk(float lo, float hi) { f32x2_t v = {lo, hi}; bf16x2_t b = __builtin_convertvector(v, bf16x2_t); return __builtin_bit_cast(unsigned, b); }
__device__ __forceinline__ bf16x8 pack8(const f32x4& a, const f32x4& b) { v4u w; w.x = cvtpk(a[0], a[1]); w.y = cvtpk(a[2], a[3]); w.z = cvtpk(b[0], b[1]); w.w = cvtpk(b[2], b[3]); return __builtin_bit_cast(bf16x8, w); }
#define MFMA16(a, b, c) __builtin_amdgcn_mfma_f32_16x16x32_bf16((a), (b), (c), 0, 0, 0)
template <int CTRL> __device__ __forceinline__ float dpp_(float x) { return __builtin_bit_cast(float, __builtin_amdgcn_mov_dpp(__builtin_bit_cast(int, x), CTRL, 0xf, 0xf, true)); }
__device__ __forceinline__ float row16_max(float v) { v = fmaxf(v, dpp_<0xB1>(v)); v = fmaxf(v, dpp_<0x4E>(v)); v = fmaxf(v, dpp_<0x124>(v)); v = fmaxf(v, dpp_<0x128>(v)); return v; }
__device__ __forceinline__ float row16_sum(float v) { v += dpp_<0xB1>(v); v += dpp_<0x4E>(v); v += dpp_<0x124>(v); v += dpp_<0x128>(v); return v; }
template <int N> __device__ __forceinline__ float tred(float (&x)[N], int lane) {
    if constexpr (N == 1) return x[0];
    else { float y[N / 2];
#pragma unroll
        for (int j = 0; j < N / 2; ++j) { const bool up = (lane & (N / 2)) != 0; const float keep = up ? x[j + N / 2] : x[j], send = up ? x[j] : x[j + N / 2]; y[j] = keep + __shfl_xor(send, N / 2); }
        return tred<N / 2>(y, lane); }
}

__device__ __forceinline__ void p0_item(const float* W, int ldw, int src_col0, bf16* WT, int K, int dst_row0, int k0, const float* ksc, LAS float* scr, int lane) {
#pragma unroll 8
    for (int i = 0; i < 32; ++i) { const int kk = 2 * i + (lane >> 5); float w = W[(size_t)(k0 + kk) * ldw + src_col0 + (lane & 31)]; if (ksc) w *= ksc[k0 + kk]; scr[kk * 33 + (lane & 31)] = w; }
    LDS_WAIT(); asm volatile("" ::: "memory");
    const int c = lane & 7;
#pragma unroll
    for (int j = 0; j < 4; ++j) { const int n = (lane >> 3) + 8 * j; const LAS float* s = scr + (8 * c) * 33 + n;
        v4u o; o.x = pk2(s[0 * 33], s[1 * 33]); o.y = pk2(s[2 * 33], s[3 * 33]); o.z = pk2(s[4 * 33], s[5 * 33]); o.w = pk2(s[6 * 33], s[7 * 33]);
        *(GAS v4u*)(WT + (size_t)(dst_row0 + n) * K + k0 + 8 * c) = o; }
    LDS_WAIT(); asm volatile("" ::: "memory");
}
__device__ __forceinline__ void p0_prologue(const Args& a, LAS unsigned char* lds, int lane, int wave, int vcu, int G) {
    LAS float* scr = (LAS float*)(lds + wave * 16384);
    const int gw = vcu * NWAVES + wave, NGW = G * NWAVES;
    bf16* WIN = (bf16*)(a.ws + WS_WIN); bf16* WOUT = (bf16*)(a.ws + WS_WOUT); bf16* WUP = (bf16*)(a.ws + WS_WUP); bf16* WDN = (bf16*)(a.ws + WS_WDN);
    constexpr int N1 = 16 * 112, N2 = 16 * 32, N3 = 16 * 176, N4 = 44 * 32;
    for (int it = gw; it < N1 + N2 + N3 + N4; it += NGW) {
        int r = it;
        if (r < N1) { const int kb = r / 112, nb = r % 112, tile = nb >> 3, wi = nb & 7, bj = wi >> 2, wc = wi & 3, nl = 256 * tile + 64 * wc + 32 * bj, src = nl < 2048 ? nl : nl + 8;
            p0_item(a.in[I_WIN], INC, src, WIN, 1024, 32 * nb, 64 * kb, nullptr, scr, lane); continue; } r -= N1;
        if (r < N2) { const int kb = r / 32, nb = r % 32; p0_item(a.in[I_WOUT], 1024, 32 * nb, WOUT, 1024, 32 * nb, 64 * kb, nullptr, scr, lane); continue; } r -= N2;
        if (r < N3) { const int kb = r / 176, nb = r % 176, tile = nb >> 3, wi = nb & 7, bj = wi >> 2, r32 = wi & 3, src = bj * FF + 128 * tile + 32 * r32;
            p0_item(a.in[I_WUP], FF2, src, WUP, 1024, 32 * nb, 64 * kb, a.in[I_FNG], scr, lane); continue; } r -= N3;
        { const int kb = r / 32, nb = r % 32; p0_item(a.in[I_WDN], 1024, 32 * nb, WDN, FF, 32 * nb, 64 * kb, nullptr, scr, lane); }
    }
    { const float* fcw = a.in[I_FCW]; const float* fcb = a.in[I_FCB]; float* CWP = (float*)(a.ws + WS_CWP);
      for (int c = gw * 64 + lane; c < FF; c += NGW * 64) {
          *(f32x4*)(CWP + (size_t)c * 8) = (f32x4){fcw[c], fcw[FF2 + c], fcw[2 * FF2 + c], fcb[c]};
          *(f32x4*)(CWP + (size_t)c * 8 + 4) = (f32x4){fcw[FF + c], fcw[FF2 + FF + c], fcw[2 * FF2 + FF + c], fcb[FF + c]}; } }
    float wl[16][8], gl[16];
    const float* win = a.in[I_WIN]; const float* ang = a.in[I_ANG];
#pragma unroll
    for (int j = 0; j < 4; ++j)
#pragma unroll
        for (int e = 0; e < 4; ++e) { const int k = 256 * j + 4 * lane + e; const float* wp = win + (size_t)k * INC + 2048; const f32x4 w0 = *(const f32x4*)wp, w1 = *(const f32x4*)(wp + 4);
            wl[4 * j + e][0] = w0[0]; wl[4 * j + e][1] = w0[1]; wl[4 * j + e][2] = w0[2]; wl[4 * j + e][3] = w0[3]; wl[4 * j + e][4] = w1[0]; wl[4 * j + e][5] = w1[1]; wl[4 * j + e][6] = w1[2]; wl[4 * j + e][7] = w1[3];
            gl[4 * j + e] = ang[k]; }
    bf16* XN = (bf16*)(a.ws + WS_XN); float* BA = (float*)(a.ws + WS_BA);
    for (int row = gw; row < MT; row += NGW) {
        const float* xr = row < TP ? a.in[I_XP] + (size_t)row * 1024 : a.in[I_XS] + (size_t)(row - TP) * 1024;
        f32x4 v[4]; float ss = 0.f;
#pragma unroll
        for (int j = 0; j < 4; ++j) { v[j] = *(const f32x4*)(xr + 256 * j + 4 * lane); ss += (v[j][0] * v[j][0] + v[j][1] * v[j][1]) + (v[j][2] * v[j][2] + v[j][3] * v[j][3]); }
        const float rstd = 1.0f / sqrtf(wave_sum(ss) * (1.0f / 1024.0f) + EPS);
        float lg[8] = {0.f, 0.f, 0.f, 0.f, 0.f, 0.f, 0.f, 0.f};
#pragma unroll
        for (int j = 0; j < 4; ++j) { f32x4 xn;
#pragma unroll
            for (int e = 0; e < 4; ++e) { xn[e] = v[j][e] * rstd * gl[4 * j + e];
#pragma unroll
                for (int q = 0; q < 8; ++q) lg[q] += xn[e] * wl[4 * j + e][q]; }
            v2u o; o.x = pk2(xn[0], xn[1]); o.y = pk2(xn[2], xn[3]); *(GAS v2u*)(XN + (size_t)row * 1024 + 256 * j + 4 * lane) = o; }
#pragma unroll
        for (int q = 0; q < 8; ++q) lg[q] = wave_sum(lg[q]);
        if (lane == 0) { *(f32x4*)(BA + (size_t)row * 8) = (f32x4){lg[0], lg[1], lg[2], lg[3]}; *(f32x4*)(BA + (size_t)row * 8 + 4) = (f32x4){lg[4], lg[5], lg[6], lg[7]}; }
    }
}

__device__ __forceinline__ void conv_chan64(const bf16* ub  , int c, const float* cw, int col, bool has_prev, float (&o)[64]) {
    const float w0 = cw[col], w1 = cw[1536 + col], w2 = cw[3072 + col], w3 = cw[4608 + col];
    float x0 = 0.f, x1 = 0.f, x2 = 0.f;
    if (has_prev) { x0 = bf2f((ub - 3 * 1536)[c]); x1 = bf2f((ub - 2 * 1536)[c]); x2 = bf2f((ub - 1536)[c]); }
#pragma unroll
    for (int i = 0; i < 64; ++i) { const float x3 = bf2f((ub + (size_t)i * 1536)[c]); const float y = w0 * x0 + w1 * x1 + w2 * x2 + w3 * x3; o[i] = y / (1.0f + __expf(-y)); x0 = x1; x1 = x2; x2 = x3; }
}
#define FRESH(v_, expr_) int v_ = (expr_); asm volatile("" : "+v"(v_))
__device__ __forceinline__ void gdn_prep(const Args& a, LAS unsigned char* lds, int tid, int wave, int vcu, int G) {
    const int half = wave >> 2, hw = wave & 3;
    LAS unsigned char* hp = lds + half * 57344;
    LAS bf16* q_s = (LAS bf16*)hp; LAS bf16* k_s = (LAS bf16*)(hp + 17408); LAS float* M_s = (LAS float*)(hp + 34816);
    LAS float* part_s = (LAS float*)(hp + 52224); LAS float* beta_s = (LAS float*)(hp + 53248); LAS float* gcum_s = (LAS float*)(hp + 53504);
    const bf16* GQKV = (const bf16*)(a.ws + WS_GQKV); const float* BA = (const float*)(a.ws + WS_BA); const float* cw = a.in[I_GCW];
    const bool roleA = hw < 2;
    for (int pair = vcu; pair < 512; pair += G) {
        const int chunk = 2 * pair + half, bh = chunk >> 6, ci = chunk & 63, b = bh >> 2, h = bh & 3;
        const size_t rb = (size_t)b * 4096 + 64 * ci;
        unsigned char* rec = a.ws + WS_GCH + (size_t)chunk * GCH_STRIDE;
        float xa[64], xb[64];
        {   FRESH(t1, tid); const int lane = t1 & 63, c = t1 & 127;
            float mine;
            if (roleA) { conv_chan64(GQKV + rb * 1536 + 128 * h, c, cw, 128 * h + c, ci > 0, xb);
                { float sq[64];
#pragma unroll
                  for (int i = 0; i < 64; ++i) sq[i] = xb[i] * xb[i];
                  mine = tred<64>(sq, lane); }
                asm volatile("" ::: "memory");
                conv_chan64(GQKV + rb * 1536 + 1024 + 128 * h, c, cw, 1024 + 128 * h + c, ci > 0, xa);
            } else { conv_chan64(GQKV + rb * 1536 + 512 + 128 * h, c, cw, 512 + 128 * h + c, ci > 0, xa);
                float sq[64];
#pragma unroll
                for (int i = 0; i < 64; ++i) sq[i] = xa[i] * xa[i];
                mine = tred<64>(sq, lane);
            }
            part_s[hw * 64 + lane] = mine;
            if (hw == 0) { const float* bap = BA + (rb + lane) * 8; const float bl = bap[h], al = bap[4 + h];
                const float beta = 1.0f / (1.0f + __expf(-bl));
                const float xs = al + a.in[I_DTB][h]; const float sp = fmaxf(xs, 0.f) + log1pf(__expf(-fabsf(xs)));
                float cs = -__expf(a.in[I_ALOG][h]) * sp;
#pragma unroll
                for (int o = 1; o < 64; o <<= 1) { const float t = __shfl_up(cs, o); if (lane >= o) cs += t; }
                beta_s[lane] = beta; gcum_s[lane] = cs; }
        }
        __syncthreads();
        {   FRESH(t2, tid); const int c = t2 & 127;
            if (roleA) {
#pragma unroll
                for (int i = 0; i < 64; ++i) { const float r = (1.0f / sqrtf(part_s[i] + part_s[64 + i] + EPS)) * 0.08838834764831845f; xb[i] *= r; q_s[i * 136 + c] = (bf16)f2bf(xb[i]); }
            } else {
#pragma unroll
                for (int i = 0; i < 64; ++i) { const float r = 1.0f / sqrtf(part_s[128 + i] + part_s[192 + i] + EPS); xa[i] *= r; k_s[i * 136 + c] = (bf16)f2bf(xa[i]); }
            }
        }
        __syncthreads();
        {
            FRESH(t3, tid); const int n = t3 & 15, kg = (t3 >> 4) & 3, ti = hw;
            bf16* INTRA = (bf16*)(rec + 81920);
#pragma unroll
            for (int tj = 0; tj < 4; ++tj) {
                f32x4 aK = (f32x4){0.f, 0.f, 0.f, 0.f}, aQ = aK;
                if (tj <= ti) {
#pragma unroll
                    for (int ks = 0; ks < 4; ++ks) {
                        const bf16x8 ak = *(const LAS bf16x8*)(k_s + (16 * ti + n) * 136 + 32 * ks + 8 * kg), aq = *(const LAS bf16x8*)(q_s + (16 * ti + n) * 136 + 32 * ks + 8 * kg);
                        const bf16x8 bk = *(const LAS bf16x8*)(k_s + (16 * tj + n) * 136 + 32 * ks + 8 * kg);
                        aK = MFMA16(ak, bk, aK); aQ = MFMA16(aq, bk, aQ); }
                }
#pragma unroll
                for (int j = 0; j < 4; ++j) { const int i = 16 * ti + 4 * kg + j, jp = 16 * tj + n;
                    const float dec = (i >= jp) ? __expf(fminf(gcum_s[i] - gcum_s[jp], 0.f)) : 0.f;
                    if (tj <= ti) M_s[i * 68 + jp] = (i > jp) ? beta_s[i] * aK[j] * dec : 0.f;
                    INTRA[((ti * 2 + (tj >> 1)) * 64 + (4 * kg + j) + 16 * (n >> 2)) * 8 + 4 * (tj & 1) + (n & 3)] = (bf16)f2bf(aQ[j] * dec); }
            }
        }
        __syncthreads();
        {   FRESH(t4, tid); const int c = t4 & 127;
            if (roleA) {
#pragma unroll
                for (int i = 0; i < 64; ++i) { q_s[i * 136 + c] = (bf16)f2bf(xb[i] * __expf(gcum_s[i])); xa[i] *= beta_s[i]; }
            } else {
                const float gl = gcum_s[63]; const int dt = c >> 4, m = c & 15;
                unsigned char* KDT = rec + 65536;
#pragma unroll
                for (int ks2 = 0; ks2 < 2; ++ks2)
#pragma unroll
                    for (int kgi = 0; kgi < 4; ++kgi)
#pragma unroll
                        for (int hh = 0; hh < 2; ++hh) { const int t0 = 32 * ks2 + 16 * hh + 4 * kgi;
                            v2u w; w.x = pk2(xa[t0] * __expf(gl - gcum_s[t0]), xa[t0 + 1] * __expf(gl - gcum_s[t0 + 1])); w.y = pk2(xa[t0 + 2] * __expf(gl - gcum_s[t0 + 2]), xa[t0 + 3] * __expf(gl - gcum_s[t0 + 3]));
                            *(GAS v2u*)(KDT + ((dt * 2 + ks2) * 64 + m + 16 * kgi) * 16 + hh * 8) = w; }
                if (c == 0) *(float*)(rec + 90112) = __expf(gl);
#pragma unroll
                for (int i = 0; i < 64; ++i) xa[i] *= beta_s[i] * __expf(gcum_s[i]);
            }
        }
#pragma unroll
        for (int i = 1; i < 64; ++i) { float acc = xa[i];
#pragma unroll
            for (int j4 = 0; j4 <= (i - 1) / 4; ++j4) { const f32x4 mr = *(const LAS f32x4*)(M_s + i * 68 + 4 * j4);
                acc -= mr[0] * xa[4 * j4]; if (4 * j4 + 1 < i) acc -= mr[1] * xa[4 * j4 + 1]; if (4 * j4 + 2 < i) acc -= mr[2] * xa[4 * j4 + 2]; if (4 * j4 + 3 < i) acc -= mr[3] * xa[4 * j4 + 3]; }
            xa[i] = acc; }
        {   FRESH(t5, tid); const int c = t5 & 127;
            if (roleA) { float* U = (float*)rec; const int s = c >> 4, n = c & 15;
#pragma unroll
                for (int mt = 0; mt < 4; ++mt)
#pragma unroll
                    for (int kgi = 0; kgi < 4; ++kgi) *(f32x4*)(U + (((s * 4 + mt) * 64 + n + 16 * kgi) * 4)) = (f32x4){xa[16 * mt + 4 * kgi], xa[16 * mt + 4 * kgi + 1], xa[16 * mt + 4 * kgi + 2], xa[16 * mt + 4 * kgi + 3]};
            } else {
#pragma unroll
                for (int i = 0; i < 64; ++i) k_s[i * 136 + c] = (bf16)f2bf(-xa[i]);
            }
        }
        __syncthreads();
        {   FRESH(t6, tid); const int ht = t6 & 255;
#pragma unroll
            for (int rep = 0; rep < 4; ++rep) { const int idx = ht + 256 * rep, mt = idx >> 8, ks = (idx >> 6) & 3, l = idx & 63, m = l & 15, kgi = l >> 4, row = 16 * mt + m;
                const v2u wlo = *(const LAS v2u*)(k_s + row * 136 + 32 * ks + 4 * kgi), whi = *(const LAS v2u*)(k_s + row * 136 + 32 * ks + 16 + 4 * kgi);
                *(GAS v4u*)(rec + 32768 + (size_t)idx * 16) = (v4u){wlo.x, wlo.y, whi.x, whi.y};
                const v2u qlo = *(const LAS v2u*)(q_s + row * 136 + 32 * ks + 4 * kgi), qhi = *(const LAS v2u*)(q_s + row * 136 + 32 * ks + 16 + 4 * kgi);
                *(GAS v4u*)(rec + 49152 + (size_t)idx * 16) = (v4u){qlo.x, qlo.y, qhi.x, qhi.y}; }
        }
    }
    __syncthreads();
}
#undef FRESH
__device__ __forceinline__ void gdn_chain(const Args& a, LAS unsigned char* lds, int lane, int wave, int bh) {
    const int b = bh >> 2, h = bh & 3, s = wave, n = lane & 15, kg = lane >> 4;
    const unsigned char* rec0 = a.ws + WS_GCH + (size_t)(bh * 64) * GCH_STRIDE;
    float* OG = (float*)(a.ws + WS_OG);
    f32x4 S[8];
#pragma unroll
    for (int dt = 0; dt < 8; ++dt) S[dt] = (f32x4){0.f, 0.f, 0.f, 0.f};
#define CH_DMA(ci_, bi_) do { const unsigned char* src_ = rec0 + (size_t)(ci_) * GCH_STRIDE + 32768; _Pragma("unroll") for (int r_ = 0; r_ < 7; ++r_) \
        __builtin_amdgcn_global_load_lds((const unsigned*)(src_ + (r_ * 8 + wave) * 1024 + lane * 16), (LAS unsigned*)(lds + (bi_) * 57344 + (r_ * 8 + wave) * 1024), 16, 0, 0); } while (0)
    f32x4 u[4], un[4]; float egl, egn;
    CH_DMA(0, 0);
#pragma unroll
    for (int mt = 0; mt < 4; ++mt) u[mt] = *(const f32x4*)(rec0 + (size_t)((s * 4 + mt) * 64 + lane) * 16);
    egl = *(const float*)(rec0 + 90112);
    for (int ci = 0; ci < 64; ++ci) {
        VM_WAIT(); __syncthreads();
        if (ci + 1 < 64) { CH_DMA(ci + 1, (ci + 1) & 1); const unsigned char* rn = rec0 + (size_t)(ci + 1) * GCH_STRIDE;
#pragma unroll
            for (int mt = 0; mt < 4; ++mt) un[mt] = *(const f32x4*)(rn + (size_t)((s * 4 + mt) * 64 + lane) * 16);
            egn = *(const float*)(rn + 90112); }
        const LAS unsigned char* bp = lds + (ci & 1) * 57344 + lane * 16;
        bf16x8 Sb[4];
#pragma unroll
        for (int ks = 0; ks < 4; ++ks) Sb[ks] = pack8(S[2 * ks], S[2 * ks + 1]);
        f32x4 vn[4], o[4];
#pragma unroll
        for (int mt = 0; mt < 4; ++mt) { vn[mt] = u[mt]; o[mt] = (f32x4){0.f, 0.f, 0.f, 0.f};
#pragma unroll
            for (int ks = 0; ks < 4; ++ks) { vn[mt] = MFMA16(*(const LAS bf16x8*)(bp + (mt * 4 + ks) * 1024), Sb[ks], vn[mt]); o[mt] = MFMA16(*(const LAS bf16x8*)(bp + 16384 + (mt * 4 + ks) * 1024), Sb[ks], o[mt]); } }
        bf16x8 Vb[2];
        Vb[0] = pack8(vn[0], vn[1]); Vb[1] = pack8(vn[2], vn[3]);
#pragma unroll
        for (int mt = 0; mt < 4; ++mt)
#pragma unroll
            for (int k2 = 0; k2 < 2; ++k2) o[mt] = MFMA16(*(const LAS bf16x8*)(bp + 49152 + (mt * 2 + k2) * 1024), Vb[k2], o[mt]);
#pragma unroll
        for (int dt = 0; dt < 8; ++dt) { S[dt] = S[dt] * egl;
#pragma unroll
            for (int k2 = 0; k2 < 2; ++k2) S[dt] = MFMA16(*(const LAS bf16x8*)(bp + 32768 + (dt * 2 + k2) * 1024), Vb[k2], S[dt]); }
        float* op = OG + ((size_t)b * 4096 + 64 * ci + 4 * kg) * 512 + 128 * h + 16 * s + n;
#pragma unroll
        for (int mt = 0; mt < 4; ++mt)
#pragma unroll
            for (int j = 0; j < 4; ++j) op[(size_t)(16 * mt + j) * 512] = o[mt][j];
#pragma unroll
        for (int mt = 0; mt < 4; ++mt) u[mt] = un[mt];
        egl = egn;
    }
#undef CH_DMA
    float* sp = a.out + O_SP + ((size_t)bh * 128 + 4 * kg) * 128 + 16 * s + n;
#pragma unroll
    for (int dt = 0; dt < 8; ++dt)
#pragma unroll
        for (int j = 0; j < 4; ++j) sp[(size_t)(16 * dt + j) * 128] = S[dt][j];
}

__device__ __forceinline__ void gdn_sample(const Args& a, LAS unsigned char* lds, int tid, int lane, int wave, int item) {
    const int bd = item >> 2, h = item & 3;
    LAS float* raw = (LAS float*)lds;
    LAS float* nrm = raw + 1536;
    LAS float* gbv = nrm + 16;
    LAS float* red = gbv + 16;
    LAS float* red2 = red + 1024;
    const size_t row0 = (size_t)TP + 4 * bd;
    if (tid < 384) { const int part = tid >> 7, c = tid & 127, col = 512 * part + 128 * h + c;
        const float* cw = a.in[I_GCW]; const float w0 = cw[col], w1 = cw[1536 + col], w2 = cw[3072 + col], w3 = cw[4608 + col];
        const float* st = a.in[I_GCONV] + (size_t)bd * 3 * 1536 + col; const bf16* gq = (const bf16*)(a.ws + WS_GQKV) + row0 * 1536 + col;
        float xp[7]; xp[0] = st[0]; xp[1] = st[1536]; xp[2] = st[3072];
#pragma unroll
        for (int t = 0; t < 4; ++t) xp[3 + t] = bf2f(gq[(size_t)t * 1536]);
#pragma unroll
        for (int t = 0; t < 4; ++t) { const float y = w0 * xp[t] + w1 * xp[t + 1] + w2 * xp[t + 2] + w3 * xp[t + 3]; const float v = y / (1.0f + __expf(-y)); raw[(part * 4 + t) * 128 + c] = v;
            if (part < 2) { const float sq = wave_sum(v * v); if (lane == 0) nrm[wave * 4 + t] = sq; } }
    } else if (tid < 388) { const int t = tid - 384; const float* bap = (const float*)(a.ws + WS_BA) + (row0 + t) * 8; const float bl = bap[h], al = bap[4 + h];
        const float xs = al + a.in[I_DTB][h]; const float sp = fmaxf(xs, 0.f) + log1pf(__expf(-fabsf(xs)));
        gbv[t] = 1.0f / (1.0f + __expf(-bl)); gbv[4 + t] = __expf(-__expf(a.in[I_ALOG][h]) * sp); }
    __syncthreads();
    const int rbk = lane >> 5, c4 = lane & 31, r0 = 16 * wave + 8 * rbk;
    f32x4 S[8];
    const float* s0 = a.in[I_GS] + ((size_t)item * 128 + r0) * 128 + 4 * c4;
#pragma unroll
    for (int i = 0; i < 8; ++i) S[i] = *(const f32x4*)(s0 + (size_t)i * 128);
    float* OG = (float*)(a.ws + WS_OG);
    for (int t = 0; t < 4; ++t) {
        const float rq = (1.0f / sqrtf(nrm[t] + nrm[4 + t] + EPS)) * 0.08838834764831845f, rk = 1.0f / sqrtf(nrm[8 + t] + nrm[12 + t] + EPS);
        const float eg = gbv[4 + t], bt = gbv[t];
        float kn[8], qn[8];
#pragma unroll
        for (int i = 0; i < 8; ++i) { kn[i] = raw[(4 + t) * 128 + r0 + i] * rk; qn[i] = raw[t * 128 + r0 + i] * rq; }
        const f32x4 v4 = *(const LAS f32x4*)(raw + (8 + t) * 128 + 4 * c4);
        f32x4 p = (f32x4){0.f, 0.f, 0.f, 0.f};
#pragma unroll
        for (int i = 0; i < 8; ++i) p += S[i] * kn[i];
#pragma unroll
        for (int e = 0; e < 4; ++e) p[e] += __shfl_xor(p[e], 32);
        if (lane < 32) *(LAS f32x4*)(red + wave * 128 + 4 * c4) = p;
        __syncthreads();
        f32x4 ks = (f32x4){0.f, 0.f, 0.f, 0.f};
#pragma unroll
        for (int w = 0; w < 8; ++w) ks += *(const LAS f32x4*)(red + w * 128 + 4 * c4);
        const f32x4 delta = (v4 - ks * eg) * bt;
        p = (f32x4){0.f, 0.f, 0.f, 0.f};
#pragma unroll
        for (int i = 0; i < 8; ++i) { S[i] = S[i] * eg + delta * kn[i]; p += S[i] * qn[i]; }
#pragma unroll
        for (int e = 0; e < 4; ++e) p[e] += __shfl_xor(p[e], 32);
        if (lane < 32) *(LAS f32x4*)(red2 + wave * 128 + 4 * c4) = p;
        __syncthreads();
        if (wave == 0 && lane < 32) { f32x4 o = (f32x4){0.f, 0.f, 0.f, 0.f};
#pragma unroll
            for (int w = 0; w < 8; ++w) o += *(const LAS f32x4*)(red2 + w * 128 + 4 * c4);
            *(f32x4*)(OG + (row0 + t) * 512 + 128 * h + 4 * c4) = o; }
    }
    float* so = a.out + O_SS + ((size_t)item * 128 + r0) * 128 + 4 * c4;
#pragma unroll
    for (int i = 0; i < 8; ++i) *(f32x4*)(so + (size_t)i * 128) = S[i];
}

__device__ __forceinline__ void attn_sample(const Args& a, LAS unsigned char* lds, int tid, int lane, int wave, int item) {
    const int bd = item >> 2, h = item & 3;
    const int n = lane & 15, kg = lane >> 4, ksl = lane >> 5, c4 = lane & 31;
    const size_t row0 = (size_t)TP + 4 * bd;
    const bf16* DQ = (const bf16*)(a.ws + WS_DQ); const bf16* DK = (const bf16*)(a.ws + WS_DK); const bf16* DV = (const bf16*)(a.ws + WS_DV);
    bf16x8 qf[4];
#pragma unroll
    for (int ks = 0; ks < 4; ++ks) { v4u w = (v4u){0u, 0u, 0u, 0u};
        if (n < 8 && (ks >> 1) == (n >> 2)) { const bf16* qp = DQ + (row0 + (n & 3)) * 512 + 128 * h + 32 * ks + 4 * kg; const v2u lo = *(const v2u*)qp, hi = *(const v2u*)(qp + 16); w = (v4u){lo.x, lo.y, hi.x, hi.y}; }
        qf[ks] = __builtin_bit_cast(bf16x8, w); }
    LAS unsigned char* ps = lds + wave * 1024;
    const float NEG_INF = -__builtin_inff();
    f32x4 mrun = (f32x4){NEG_INF, NEG_INF, NEG_INF, NEG_INF}, lrun = (f32x4){0.f, 0.f, 0.f, 0.f};
    f32x4 O1[4], O2[4];
#pragma unroll
    for (int t = 0; t < 4; ++t) { O1[t] = (f32x4){0.f, 0.f, 0.f, 0.f}; O2[t] = O1[t]; }
    const float* CK = a.in[I_CK]; const float* CV = a.in[I_CV];
    f32x4 kN[8], vN[8], vC[8];
#define AS_LOAD(K_, V_, blk_) do { const int pg_ = a.pt[bd * 16 + 2 * wave + ((blk_) >> 3)]; const size_t kb_ = ((size_t)pg_ * 128 + ((blk_) & 7) * 16) * 512 + 128 * h; \
        const float* kp_ = CK + kb_ + (size_t)n * 512 + 4 * kg; const float* vp_ = CV + kb_ + (size_t)ksl * 512 + 4 * c4; \
        _Pragma("unroll") for (int ks_ = 0; ks_ < 4; ++ks_) { K_[2 * ks_] = __builtin_nontemporal_load((const f32x4*)(kp_ + 32 * ks_)); K_[2 * ks_ + 1] = __builtin_nontemporal_load((const f32x4*)(kp_ + 32 * ks_ + 16)); } \
        _Pragma("unroll") for (int kp2_ = 0; kp2_ < 8; ++kp2_) V_[kp2_] = __builtin_nontemporal_load((const f32x4*)(vp_ + (size_t)kp2_ * 1024)); } while (0)
#define AS_BLOCK(kf_, V_, NEWK) do { \
        f32x4 sc_ = (f32x4){0.f, 0.f, 0.f, 0.f}; \
        _Pragma("unroll") for (int ks_ = 0; ks_ < 4; ++ks_) sc_ = MFMA16(qf[ks_], kf_[ks_], sc_); \
        if (NEWK) { _Pragma("unroll") for (int j_ = 0; j_ < 4; ++j_) if (n > j_) sc_[j_] = NEG_INF; } \
        f32x4 mn_, al_, p_; \
        _Pragma("unroll") for (int j_ = 0; j_ < 4; ++j_) { mn_[j_] = fmaxf(mrun[j_], row16_max(sc_[j_])); al_[j_] = __builtin_amdgcn_exp2f(mrun[j_] - mn_[j_]); p_[j_] = __builtin_amdgcn_exp2f(sc_[j_] - mn_[j_]); \
            lrun[j_] = lrun[j_] * al_[j_] + p_[j_]; mrun[j_] = mn_[j_]; } \
        if (kg < 2) { *(LAS f32x4*)(ps + (n * 2 + kg) * 16) = p_; if (n == 0) *(LAS f32x4*)(ps + 512 + kg * 16) = al_; } \
        LDS_WAIT(); \
        { const f32x4 a1_ = *(const LAS f32x4*)(ps + 512), a2_ = *(const LAS f32x4*)(ps + 528); \
          _Pragma("unroll") for (int t_ = 0; t_ < 4; ++t_) { O1[t_] = O1[t_] * a1_[t_]; O2[t_] = O2[t_] * a2_[t_]; } } \
        _Pragma("unroll") for (int kp_ = 0; kp_ < 8; ++kp_) { const f32x4 p1_ = *(const LAS f32x4*)(ps + ((2 * kp_ + ksl) * 2) * 16), p2_ = *(const LAS f32x4*)(ps + ((2 * kp_ + ksl) * 2 + 1) * 16); \
            _Pragma("unroll") for (int t_ = 0; t_ < 4; ++t_) { O1[t_] += V_[kp_] * p1_[t_]; O2[t_] += V_[kp_] * p2_[t_]; } \
            if (kp_ & 1) asm volatile("" ::: "memory"); } \
        LDS_WAIT(); } while (0)
    AS_LOAD(kN, vN, 0);
    for (int blk = 0; blk < 16; ++blk) {
        bf16x8 kf[4];
#pragma unroll
        for (int ks = 0; ks < 4; ++ks) kf[ks] = pack8(kN[2 * ks], kN[2 * ks + 1]);
#pragma unroll
        for (int kp = 0; kp < 8; ++kp) vC[kp] = vN[kp];
        if (blk + 1 < 16) AS_LOAD(kN, vN, blk + 1);
        AS_BLOCK(kf, vC, false);
    }
    if (wave == 0) {
        bf16x8 kf[4];
#pragma unroll
        for (int ks = 0; ks < 4; ++ks) { v4u w = (v4u){0u, 0u, 0u, 0u};
            if (n < 4) { const bf16* kp = DK + (row0 + n) * 512 + 128 * h + 32 * ks + 4 * kg; const v2u lo = *(const v2u*)kp, hi = *(const v2u*)(kp + 16); w = (v4u){lo.x, lo.y, hi.x, hi.y}; }
            kf[ks] = __builtin_bit_cast(bf16x8, w); }
#pragma unroll
        for (int kp = 0; kp < 8; ++kp) { vC[kp] = (f32x4){0.f, 0.f, 0.f, 0.f};
            if (kp < 2) { const v2u w = *(const v2u*)(DV + (row0 + 2 * kp + ksl) * 512 + 128 * h + 4 * c4); vC[kp] = (f32x4){bflo(w.x), bfhi(w.x), bflo(w.y), bfhi(w.y)}; } }
        AS_BLOCK(kf, vC, true);
    }
#undef AS_LOAD
#undef AS_BLOCK
    LAS float* st = (LAS float*)(lds + 8192) + wave * 16;
    f32x4 ls;
#pragma unroll
    for (int j = 0; j < 4; ++j) ls[j] = row16_sum(lrun[j]);
    if (kg < 2 && n == 0) { *(LAS f32x4*)(st + kg * 4) = mrun; *(LAS f32x4*)(st + 8 + kg * 4) = ls; }
    LAS float* ob = (LAS float*)(lds + 16384) + (size_t)(wave * 2 + ksl) * 1024;
#pragma unroll
    for (int t = 0; t < 4; ++t) { *(LAS f32x4*)(ob + t * 128 + 4 * c4) = O1[t]; *(LAS f32x4*)(ob + (4 + t) * 128 + 4 * c4) = O2[t]; }
    __syncthreads();
    { const int ct = tid >> 6, col = 2 * (tid & 63); const LAS float* sta = (const LAS float*)(lds + 8192);
        float M = NEG_INF;
#pragma unroll
        for (int w = 0; w < 8; ++w) M = fmaxf(M, sta[w * 16 + ct]);
        float L = 0.f, x0 = 0.f, x1 = 0.f;
#pragma unroll
        for (int w = 0; w < 8; ++w) { const float f = __builtin_amdgcn_exp2f(sta[w * 16 + ct] - M); L += sta[w * 16 + 8 + ct] * f;
            const LAS float* o0 = (const LAS float*)(lds + 16384) + (size_t)(w * 2) * 1024 + ct * 128 + col;
            x0 += f * (o0[0] + o0[1024]); x1 += f * (o0[1] + o0[1025]); }
        const float inv = 1.0f / L;
        bf16* dst = (bf16*)(a.ws + ((ct >> 2) ? WS_O2 : WS_O1)) + (row0 + (ct & 3)) * 512 + 128 * h + col;
        *(unsigned*)dst = pk2(x0 * inv, x1 * inv); }
}
__device__ __forceinline__ void p4_combine(const Args& a, int lane, int wave, int vcu, int G) {
    const int gw = vcu * NWAVES + wave, NGW = G * NWAVES;
    const float s1 = wave_sum(a.in[I_LQ1][lane] * a.in[I_LK1][lane]), s2 = wave_sum(a.in[I_LQ2][lane] * a.in[I_LK2][lane]);
    const float lam = __expf(s1) - __expf(s2) + 0.2f;
    const int hc = (8 * lane) & 127;
    const f32x4 gn0 = *(const f32x4*)(a.in[I_GNG] + hc), gn1 = *(const f32x4*)(a.in[I_GNG] + hc + 4), sg0 = *(const f32x4*)(a.in[I_SUBG] + hc), sg1 = *(const f32x4*)(a.in[I_SUBG] + hc + 4);
    const float* OG = (const float*)(a.ws + WS_OG); const bf16* ZB = (const bf16*)(a.ws + WS_ZB); const bf16* O1 = (const bf16*)(a.ws + WS_O1); const bf16* O2 = (const bf16*)(a.ws + WS_O2);
    bf16* AO = (bf16*)(a.ws + WS_AO);
    for (int row = gw; row < MT; row += NGW) {
        const f32x4 g0 = *(const f32x4*)(OG + (size_t)row * 512 + 8 * lane), g1 = *(const f32x4*)(OG + (size_t)row * 512 + 8 * lane + 4);
        const v4u zw = *(const v4u*)(ZB + (size_t)row * 512 + 8 * lane), w1 = *(const v4u*)(O1 + (size_t)row * 512 + 8 * lane), w2 = *(const v4u*)(O2 + (size_t)row * 512 + 8 * lane);
        float ss = (g0[0] * g0[0] + g0[1] * g0[1]) + (g0[2] * g0[2] + g0[3] * g0[3]) + (g1[0] * g1[0] + g1[1] * g1[1]) + (g1[2] * g1[2] + g1[3] * g1[3]);
        ss = row16_sum(ss);
        const float rs = 1.0f / sqrtf(ss * (1.0f / 128.0f) + EPS);
        const float z[8] = {bflo(zw.x), bfhi(zw.x), bflo(zw.y), bfhi(zw.y), bflo(zw.z), bfhi(zw.z), bflo(zw.w), bfhi(zw.w)};
        float og[8];
#pragma unroll
        for (int e = 0; e < 4; ++e) { og[e] = g0[e] * rs * gn0[e]; og[4 + e] = g1[e] * rs * gn1[e]; }
#pragma unroll
        for (int e = 0; e < 8; ++e) og[e] *= z[e] / (1.0f + __expf(-z[e]));
        *(GAS v4u*)(AO + (size_t)row * 1024 + 8 * lane) = (v4u){pk2(og[0], og[1]), pk2(og[2], og[3]), pk2(og[4], og[5]), pk2(og[6], og[7])};
        const float p1[8] = {bflo(w1.x), bfhi(w1.x), bflo(w1.y), bfhi(w1.y), bflo(w1.z), bfhi(w1.z), bflo(w1.w), bfhi(w1.w)};
        const float p2[8] = {bflo(w2.x), bfhi(w2.x), bflo(w2.y), bfhi(w2.y), bflo(w2.z), bfhi(w2.z), bflo(w2.w), bfhi(w2.w)};
        float d[8]; float sd = 0.f;
#pragma unroll
        for (int e = 0; e < 8; ++e) { d[e] = p1[e] - lam * p2[e]; sd += d[e] * d[e]; }
        sd = row16_sum(sd);
        const float rd = (1.0f / sqrtf(sd * (1.0f / 128.0f) + EPS)) * 0.8f;
#pragma unroll
        for (int e = 0; e < 4; ++e) { d[e] *= rd * sg0[e]; d[4 + e] *= rd * sg1[e]; }
        *(GAS v4u*)(AO + (size_t)row * 1024 + 512 + 8 * lane) = (v4u){pk2(d[0], d[1]), pk2(d[2], d[3]), pk2(d[4], d[5]), pk2(d[6], d[7])};
    }
}

__device__ __forceinline__ float gate_mix(float yg, float yv) { return yg / (1.0f + __expf(-yg)) * yv; }
__device__ __forceinline__ void p7_fixup(const Args& a, int tid, int vcu, int G) {
    const float* cw = a.in[I_FCW]; const float* cb = a.in[I_FCB];
    const float* BND = (const float*)(a.ws + WS_BND); const float* US = (const float*)(a.ws + WS_US); bf16* A2 = (bf16*)(a.ws + WS_A2);
    const size_t gt = (size_t)vcu * 512 + tid, NT = (size_t)G * 512;
    for (size_t i = gt; i < (size_t)256 * FF; i += NT) { const int blk = (int)(i / FF), c = (int)(i % FF);
        float ug[4], uv[4];
        const bool first = (blk & 63) == 0;
        ug[0] = first ? 0.f : BND[((size_t)(blk - 1) * 4 + 2) * FF2 + c]; ug[1] = first ? 0.f : BND[((size_t)(blk - 1) * 4 + 3) * FF2 + c];
        uv[0] = first ? 0.f : BND[((size_t)(blk - 1) * 4 + 2) * FF2 + FF + c]; uv[1] = first ? 0.f : BND[((size_t)(blk - 1) * 4 + 3) * FF2 + FF + c];
        ug[2] = BND[((size_t)blk * 4 + 0) * FF2 + c]; ug[3] = BND[((size_t)blk * 4 + 1) * FF2 + c]; uv[2] = BND[((size_t)blk * 4 + 0) * FF2 + FF + c]; uv[3] = BND[((size_t)blk * 4 + 1) * FF2 + FF + c];
        const float g0 = cw[c], g1 = cw[FF2 + c], g2 = cw[2 * FF2 + c], gb = cb[c], v0 = cw[FF + c], v1 = cw[FF2 + FF + c], v2 = cw[2 * FF2 + FF + c], vb = cb[FF + c];
#pragma unroll
        for (int r = 0; r < 2; ++r) { const float yg = g0 * ug[r] + g1 * ug[r + 1] + g2 * ug[r + 2] + gb, yv = v0 * uv[r] + v1 * uv[r + 1] + v2 * uv[r + 2] + vb;
            A2[((size_t)blk * 64 + r) * FF + c] = (bf16)f2bf(gate_mix(yg, yv)); } }
    const float* stf = a.in[I_FCONV];
    for (size_t i = gt; i < (size_t)128 * FF; i += NT) { const int bd = (int)(i / FF), c = (int)(i % FF);
        float ug[6], uv[6];
        ug[0] = stf[((size_t)bd * 2 + 0) * FF2 + c]; ug[1] = stf[((size_t)bd * 2 + 1) * FF2 + c]; uv[0] = stf[((size_t)bd * 2 + 0) * FF2 + FF + c]; uv[1] = stf[((size_t)bd * 2 + 1) * FF2 + FF + c];
#pragma unroll
        for (int t = 0; t < 4; ++t) { ug[2 + t] = US[((size_t)bd * 4 + t) * FF2 + c]; uv[2 + t] = US[((size_t)bd * 4 + t) * FF2 + FF + c]; }
        const float g0 = cw[c], g1 = cw[FF2 + c], g2 = cw[2 * FF2 + c], gb = cb[c], v0 = cw[FF + c], v1 = cw[FF2 + FF + c], v2 = cw[2 * FF2 + FF + c], vb = cb[FF + c];
#pragma unroll
        for (int t = 0; t < 4; ++t) { const float yg = g0 * ug[t] + g1 * ug[t + 1] + g2 * ug[t + 2] + gb, yv = v0 * uv[t] + v1 * uv[t + 1] + v2 * uv[t + 2] + vb;
            A2[((size_t)TP + bd * 4 + t) * FF + c] = (bf16)f2bf(gate_mix(yg, yv)); } }
    for (size_t i = gt; i < (size_t)4 * 2 * FF2; i += NT) { const int b = (int)(i / (2 * FF2)), j = (int)((i / FF2) & 1), c = (int)(i % FF2);
        a.out[O_FCP + i] = BND[((size_t)(64 * b + 63) * 4 + 2 + j) * FF2 + c]; }
    for (size_t i = gt; i < (size_t)128 * 2 * FF2; i += NT) { const int bd = (int)(i / (2 * FF2)), j = (int)((i / FF2) & 1), c = (int)(i % FF2);
        a.out[O_FCS + i] = US[((size_t)bd * 4 + 2 + j) * FF2 + c]; }
}
constexpr int N_PHASES = 9;
constexpr int Q_CHAIN = 16, Q_GS = 512, Q_AS = 512, Q_AP = 1024, Q_TOTAL = Q_CHAIN + Q_GS + Q_AS + Q_AP;
__global__ void __launch_bounds__(NWAVES * 64, 2) mega_fwd(Args args) {
    extern __shared__ __attribute__((aligned(16))) unsigned char lds_raw[];
    LAS unsigned char* lds = (LAS unsigned char*)lds_raw;
    volatile LAS unsigned* MISC = (volatile LAS unsigned*)(lds + MISC_OFF);
    const int tid = threadIdx.x, lane = tid & 63, wave = __builtin_amdgcn_readfirstlane(tid >> 6);
    const int G = gridDim.x; const int bx = blockIdx.x; const int vcu = (G % 8 == 0) ? (bx % 8) * (G / 8) + bx / 8 : bx;
    gu32* ctl = (gu32*)(args.ws + WS_CTL);
    for (int u = tid; u < (LDS_BYTES - LDSCTL_OFF) / 4; u += NWAVES * 64) ((LAS unsigned*)(lds + LDSCTL_OFF))[u] = 0u;
    __syncthreads();
    XcdBarrier bar; bar.bar = (unsigned*)(ctl + CW_BAR); bar.x = 0; bar.st = nullptr;
    if (args.use_bar) bar = xcd_barrier_post((unsigned*)(ctl + CW_BAR), MISC + 8);
    const int lo = args.ph_lo, hi = args.ph_hi;
#ifdef ONLY_PHASE
#define IN(k) ((k) == ONLY_PHASE && lo <= (k) && (k) < hi)
#else
#define IN(k) (lo <= (k) && (k) < hi)
#endif
#define SEAM(k) do { if (IN(k) && IN((k) + 1)) xcd_barrier(bar); } while (0)

    if (IN(0)) { p0_prologue(args, lds, lane, wave, vcu, G); }
    SEAM(0);
    if (IN(1)) {
        pg8::Gemm g{(const bf16*)(args.ws + WS_XN), (const bf16*)(args.ws + WS_WIN), MT, NIN, 1024, 1024, 1024}; pg8::StaticOrder S; S.init(MT, NIN, G, bx);
        pg8::EpiIn E{args.ws, args.out, args.in[I_QNG], (long)(args.in[I_KNG] - args.in[I_QNG])};
        pg8::gemm_phase<pg8::EpiIn, pg8::StaticOrder, true, true>(lds, g, S, E);
    }
    SEAM(1);
    if (IN(2)) { gdn_prep(args, lds, tid, wave, vcu, G); }
    SEAM(2);
    if (IN(3)) {
        for (;;) {
            if (tid == 0) MISC[0] = __hip_atomic_fetch_add((unsigned*)(ctl + CW_Q), 1u, __ATOMIC_RELAXED, __HIP_MEMORY_SCOPE_AGENT);
            __syncthreads();
            const int item = (int)MISC[0];
            __syncthreads();
            if (item >= Q_TOTAL) break;
            int tq = threadIdx.x; asm volatile("" : "+v"(tq));
            const int lq = tq & 63;
#ifndef ONLY_ITEM
#define ONLY_ITEM -1
#endif
            if (item < Q_CHAIN) { if (ONLY_ITEM < 0 || ONLY_ITEM == 0) gdn_chain(args, lds, lq, wave, item); }
            else if (item < Q_CHAIN + Q_GS) { if (ONLY_ITEM < 0 || ONLY_ITEM == 1) gdn_sample(args, lds, tq, lq, wave, item - Q_CHAIN); }
            else { const int i2 = item - (Q_CHAIN + Q_GS), g3 = i2 / 3, r3 = i2 % 3;
                if (r3 == 0) { if (ONLY_ITEM < 0 || ONLY_ITEM == 2) attn_sample(args, lds, tq, lq, wave, g3); }
                else if (ONLY_ITEM < 0 || ONLY_ITEM == 3) { const int j = 2 * g3 + r3 - 1, qb = 15 - (j >> 6), r = j & 63, b = r >> 4, hh = (r >> 2) & 3, c = (r >> 1) & 1, vh = r & 1;
                    const size_t base = (size_t)b * 4096 * 512 + hh * 128;
                    const attn_body::bf16* Qb = (const attn_body::bf16*)(args.ws + WS_DQ) + base + c * 64; const attn_body::bf16* Kh = (const attn_body::bf16*)(args.ws + WS_DK) + base + c * 64;
                    const attn_body::bf16* Vh = (const attn_body::bf16*)(args.ws + WS_DV) + base + vh * 64; attn_body::bf16* Ob = (attn_body::bf16*)(args.ws + (c ? WS_O2 : WS_O1)) + base + vh * 64;
                    attn_body::attn_unit<8>(tq, qb, Qb, Kh, Vh, Ob, (char*)lds_raw); } }
            VM_WAIT();
        }
    }
    SEAM(3);
    if (IN(4)) { p4_combine(args, lane, wave, vcu, G); }
    SEAM(4);
    if (IN(5)) {
        pg8::Gemm g{(const bf16*)(args.ws + WS_AO), (const bf16*)(args.ws + WS_WOUT), MT, 1024, 1024, 1024, 1024}; pg8::StaticOrder S; S.init(MT, 1024, G, bx);
        pg8::EpiOut E{args.in[I_XP], args.in[I_XS], args.out + O_Y, (bf16*)(args.ws + WS_HB), (float*)(ctl + CW_ROWSS)};
        pg8::gemm_phase<pg8::EpiOut, pg8::StaticOrder, true, true>(lds, g, S, E);
    }
    SEAM(5);
    if (IN(6)) {
        pg8::Gemm g{(const bf16*)(args.ws + WS_HB), (const bf16*)(args.ws + WS_WUP), MT, FF2, 1024, 1024, 1024}; pg8::StaticOrder S; S.init(MT, FF2, G, bx);
        pg8::EpiUp E{(bf16*)(args.ws + WS_A2), (float*)(args.ws + WS_BND), (float*)(args.ws + WS_US), (const float*)(ctl + CW_ROWSS), (const float*)(args.ws + WS_CWP)};
        pg8::gemm_phase<pg8::EpiUp, pg8::StaticOrder, true, true>(lds, g, S, E);
    }
    SEAM(6);
    if (IN(7)) { p7_fixup(args, tid, vcu, G); }
    SEAM(7);
    if (IN(8)) {
        pg8::Gemm g{(const bf16*)(args.ws + WS_A2), (const bf16*)(args.ws + WS_WDN), MT, 1024, FF, FF, FF}; pg8::StaticOrder S; S.init(MT, 1024, G, bx);
        pg8::EpiDown E{args.out + O_Y};
        pg8::gemm_phase<pg8::EpiDown, pg8::StaticOrder, true, true>(lds, g, S, E);
    }
#undef IN
#undef SEAM
}

#ifndef MK_N_LAUNCHES
#define MK_N_LAUNCHES 9
#endif
extern "C" void kernel_launch(void* const* d_in, const int* in_sizes, int n_in, void* d_out, int out_size, void* d_ws, size_t ws_size, hipStream_t stream) {
    static int grid = 0;
    if (grid == 0) {
        if (n_in != 27 || out_size != (int)O_END || ws_size < WS_END) { fprintf(stderr, "kernel_launch: unexpected shapes (n_in %d, out %d, ws %zu); nothing launched\n", n_in, out_size, ws_size); grid = -1; return; }
        int dev = 0, cus = 0, per_cu = 0;
        if (hipGetDevice(&dev) != hipSuccess || hipDeviceGetAttribute(&cus, hipDeviceAttributeMultiprocessorCount, dev) != hipSuccess) { grid = -1; return; }
        if (hipFuncSetAttribute((const void*)mega_fwd, hipFuncAttributeMaxDynamicSharedMemorySize, LDS_BYTES) != hipSuccess) { fprintf(stderr, "kernel_launch: hipFuncSetAttribute failed\n"); grid = -1; return; }
        if (hipOccupancyMaxActiveBlocksPerMultiprocessor(&per_cu, (const void*)mega_fwd, NWAVES * 64, LDS_BYTES) != hipSuccess || per_cu < 1) { fprintf(stderr, "kernel_launch: occupancy query says %d blocks per CU\n", per_cu); }
        (void)hipGetLastError();
        grid = cus;
    }
    if (grid < 0) return;
    if (hipMemsetAsync((char*)d_ws + WS_CTL, 0, CTL_ZERO_BYTES, stream) != hipSuccess) return;
    Args a{};
    for (int i = 0; i < 27; ++i) a.in[i] = (const float*)d_in[i];
    a.pt = (const int*)d_in[I_PT]; a.out = (float*)d_out; a.ws = (unsigned char*)d_ws;
    constexpr int NL = MK_N_LAUNCHES;
    for (int li = 0; li < NL; ++li) {
        a.ph_lo = (NL == 1) ? 0 : li; a.ph_hi = (NL == 1) ? N_PHASES : li + 1; a.use_bar = (NL == 1) ? 1 : 0; a.pad = 0;
        hipLaunchKernelGGL(mega_fwd, dim3(grid), dim3(NWAVES * 64), LDS_BYTES, stream, a);
    }
}
```

```cpp
#include <hip/hip_runtime.h>
#include <cstdio>
#include <cstdint>
constexpr int DMODEL = 1024;
constexpr int TP = 16384, TSM = 512, MT = TP + TSM;
constexpr int NIN = 3584, INC = 3592, FF = 2816, FF2 = 5632;
constexpr float EPS = 1e-6f;
constexpr float C2 = 0.125f * 1.4426950408889634f;
constexpr size_t O_Y = 0, O_GCP = 17301504, O_SP = 17319936, O_KP = 17582080, O_VP = 25970688, O_FCP = 34359296, O_GCS = 34404352, O_SS = 34994176, O_KS = 43382784, O_VS = 43644928, O_FCS = 43907072, O_END = 45348864;
constexpr size_t MiB = 1u << 20;
constexpr size_t WS_CTL = 0, CTL_ZERO_BYTES = 1 * MiB;
constexpr size_t WS_WIN = 2 * MiB, WS_WOUT = 10 * MiB, WS_WUP = 12 * MiB, WS_WDN = 24 * MiB;
constexpr size_t WS_CWP = 30 * MiB;
constexpr size_t WS_XN = 32 * MiB, WS_GQKV = 66 * MiB, WS_ZB = 116 * MiB, WS_DQ = 134 * MiB, WS_DK = 151 * MiB, WS_DV = 168 * MiB, WS_BA = 186 * MiB;
constexpr size_t WS_O1 = 188 * MiB, WS_O2 = 205 * MiB, WS_OG = 222 * MiB, WS_AO = 256 * MiB, WS_HB = 290 * MiB, WS_A2 = 324 * MiB, WS_BND = 416 * MiB, WS_US = 440 * MiB, WS_GCH = 452 * MiB, WS_END = 548 * MiB;
constexpr size_t GCH_STRIDE = 98304;
constexpr int CW_TMO = 0, CW_CODE = 1, CW_Q = 64, CW_BAR = 4096, CW_ROWSS = 32768;
namespace pg8 {
#define PG8_LAS __attribute__((address_space(3)))
typedef unsigned short bf16_t;
typedef short bf16x8 __attribute__((ext_vector_type(8)));
typedef float f32x4 __attribute__((ext_vector_type(4)));
typedef unsigned u32x4 __attribute__((ext_vector_type(4)));
constexpr int BM = 256, BK = 64, HALF = 128, HTB = HALF * BK * 2  , STAGE_BYTES = 8 * HTB, NXCD = 8, WGM = 8;

__host__ __device__ __forceinline__ int lds_byte(int r, int c) { const int st = (r >> 4) * 2 + (c >> 5), rr = r & 15, cc = c & 31, ob = rr * 64 + cc * 2; return st * 1024 + (ob ^ (((ob >> 9) & 1) << 5)); }
__host__ __device__ __forceinline__ void stage_rc(int b, int& R, int& C) { const int st = b / 1024, sb = b % 1024, swz = sb ^ (((sb >> 9) & 1) << 5); R = (st >> 1) * 16 + swz / 64; C = (st & 1) * 32 + (swz % 64) / 2; }
__host__ __device__ __forceinline__ int perm32(int rho) { const int n = rho >> 4, i = rho & 15; return 8 * (i >> 2) + 4 * n + (i & 3); }

struct Unit { int pm, pn, koff; };
struct Gemm { const bf16_t* A; const bf16_t* Bt; int M, N, K, lda, ldb; };

struct StaticOrder {
    int nM, nN, nwg, G, c;
    __host__ __device__ void init(int M, int N, int G_, int c_) { nM = M / BM; nN = N / BM; nwg = nM * nN; G = G_; c = c_; }
    __host__ __device__ bool next(int i, Unit& u) const {
        const long L = (long)i * G + c; if (L >= nwg) return false;
        int wgid = (int)L; { const int q = nwg / NXCD, r = nwg % NXCD, xcd = wgid % NXCD, off = wgid / NXCD; wgid = (xcd < r ? xcd * (q + 1) : r * (q + 1) + (xcd - r) * q) + off; }
        const int nig = WGM * nN, gid = wgid / nig, fm = gid * WGM, gsz = (nM - fm) < WGM ? (nM - fm) : WGM;
        u.pm = fm + ((wgid % nig) % gsz); u.pn = (wgid % nig) / gsz; u.koff = 0; return true;
    }
    __device__ __forceinline__ void a_ready(const Unit&) const {}
    __device__ __forceinline__ void done(const Unit&) const {}
};
__device__ __forceinline__ unsigned cvt_pk_bf16(float lo, float hi) { unsigned r; asm volatile("v_cvt_pk_bf16_f32 %0, %1, %2" : "=v"(r) : "v"(lo), "v"(hi)); return r; }
typedef float f32x2 __attribute__((ext_vector_type(2)));
typedef unsigned u32x2 __attribute__((ext_vector_type(2)));
template <int CTRL> __device__ __forceinline__ float dppf(float x) { return __builtin_bit_cast(float, __builtin_amdgcn_mov_dpp(__builtin_bit_cast(int, x), CTRL, 0xf, 0xf, true)); }

struct EpiIn {
    static constexpr bool PERM = true, AFTER_DRAIN = false;
    unsigned char* ws; float* out; const float* gq; long gk_off;
    __device__ __forceinline__ void operator()(const f32x4 (&acc)[2][2][4][2], const Unit& u, int wr, int wc, int fr, int fq) const {
        const int type = u.pn >> 1, cb = (u.pn & 1) * 256 + 64 * wc + 8 * fq;
        const int row0 = u.pm * BM + wr * 64 + fr;
        const bool samp = u.pm >= 64;
        if (type <= 3) {
            bf16_t* dst = (bf16_t*)(ws + ((type == 3) ? WS_ZB : WS_GQKV + 1024 * (size_t)type)); const int ld = (type == 3) ? 512 : 1536;
#pragma unroll
            for (int ai = 0; ai < 2; ++ai)
#pragma unroll
                for (int m = 0; m < 4; ++m) { const int row = row0 + ai * HALF + m * 16;
#pragma unroll
                    for (int bj = 0; bj < 2; ++bj) { const f32x4 v0 = acc[ai][bj][m][0], v1 = acc[ai][bj][m][1];
                        u32x4 w; w.x = cvt_pk_bf16(v0[0], v0[1]); w.y = cvt_pk_bf16(v0[2], v0[3]); w.z = cvt_pk_bf16(v1[0], v1[1]); w.w = cvt_pk_bf16(v1[2], v1[3]);
                        *(u32x4*)(dst + (size_t)row * ld + cb + 32 * bj) = w;
                        if (type < 3) {
                            float* cs = nullptr;
                            if (samp) { const int r = row - TP, t = r & 3; if (t >= 1) cs = out + O_GCS + ((size_t)(r >> 2) * 3 + (t - 1)) * 1536; }
                            else { const int t = row & 4095; if (t >= 4093) cs = out + O_GCP + ((size_t)(row >> 12) * 3 + (t - 4093)) * 1536; }
                            if (cs) { float* p = cs + 512 * type + cb + 32 * bj; *(f32x4*)p = v0; *(f32x4*)(p + 4) = v1; }
                        } } }
            return;
        }
        const size_t ooff = (type == 5) ? (samp ? O_KS - (size_t)TP * 512 : O_KP) : (samp ? O_VS - (size_t)TP * 512 : O_VP);
        float* ob = (type == 4) ? nullptr : out + ooff;
        bf16_t* bd = (bf16_t*)(ws + WS_DQ + (size_t)(type - 4) * (WS_DK - WS_DQ));
        f32x4 gv[2][2];
#pragma unroll
        for (int bj = 0; bj < 2; ++bj)
#pragma unroll
            for (int n = 0; n < 2; ++n) { const float* gp = gq + ((type == 5) ? gk_off : 0); gv[bj][n] = (type == 6) ? (f32x4){1.f, 1.f, 1.f, 1.f} : *(const f32x4*)(gp + 32 * bj + 8 * fq + 4 * n); }
#pragma unroll
        for (int ai = 0; ai < 2; ++ai)
#pragma unroll
            for (int m = 0; m < 4; ++m) { const int row = row0 + ai * HALF + m * 16;
                float rs = 1.f;
                if (type != 6) { float ss = 0.f;
#pragma unroll
                    for (int bj = 0; bj < 2; ++bj)
#pragma unroll
                        for (int n = 0; n < 2; ++n) { const f32x4 x = acc[ai][bj][m][n]; ss += (x[0] * x[0] + x[1] * x[1]) + (x[2] * x[2] + x[3] * x[3]); }
                    ss += __shfl_xor(ss, 16); ss += __shfl_xor(ss, 32);
                    rs = 1.0f / sqrtf(ss * (1.0f / 64.0f) + EPS); if (type == 4) rs *= C2; }
#pragma unroll
                for (int bj = 0; bj < 2; ++bj) { const f32x4 v0 = acc[ai][bj][m][0] * rs * gv[bj][0], v1 = acc[ai][bj][m][1] * rs * gv[bj][1];
                    u32x4 w; w.x = cvt_pk_bf16(v0[0], v0[1]); w.y = cvt_pk_bf16(v0[2], v0[3]); w.z = cvt_pk_bf16(v1[0], v1[1]); w.w = cvt_pk_bf16(v1[2], v1[3]);
                    *(u32x4*)(bd + (size_t)row * 512 + cb + 32 * bj) = w;
                    if (ob) { float* p = ob + (size_t)row * 512 + cb + 32 * bj; *(f32x4*)p = v0; *(f32x4*)(p + 4) = v1; } } }
    }
};

struct EpiOut {
    static constexpr bool PERM = true, AFTER_DRAIN = false;
    const float* xp; const float* xs; float* y; bf16_t* hb; float* rowss;
    __device__ __forceinline__ void operator()(const f32x4 (&acc)[2][2][4][2], const Unit& u, int wr, int wc, int fr, int fq) const {
        const int row0 = u.pm * BM + wr * 64 + fr, col0 = u.pn * BM + wc * 32 + 8 * fq;
        const float* xb = (u.pm >= 64) ? xs - (size_t)TP * 1024 : xp;
#pragma unroll
        for (int ai = 0; ai < 2; ++ai)
#pragma unroll
            for (int m = 0; m < 4; ++m) { const int row = row0 + ai * HALF + m * 16; const size_t off = (size_t)row * 1024 + col0; float ss = 0.f;
#pragma unroll
                for (int bj = 0; bj < 2; ++bj) { const f32x4 x0 = *(const f32x4*)(xb + off + bj * HALF), x1 = *(const f32x4*)(xb + off + bj * HALF + 4);
                    const f32x4 v0 = acc[ai][bj][m][0] + x0, v1 = acc[ai][bj][m][1] + x1;
                    *(f32x4*)(y + off + bj * HALF) = v0; *(f32x4*)(y + off + bj * HALF + 4) = v1;
                    u32x4 w; w.x = cvt_pk_bf16(v0[0], v0[1]); w.y = cvt_pk_bf16(v0[2], v0[3]); w.z = cvt_pk_bf16(v1[0], v1[1]); w.w = cvt_pk_bf16(v1[2], v1[3]);
                    *(u32x4*)(hb + off + bj * HALF) = w;
                    ss += (v0[0] * v0[0] + v0[1] * v0[1]) + (v0[2] * v0[2] + v0[3] * v0[3]) + (v1[0] * v1[0] + v1[1] * v1[1]) + (v1[2] * v1[2] + v1[3] * v1[3]); }
                ss += __shfl_xor(ss, 16); ss += __shfl_xor(ss, 32);
                if (fq == 0) atomicAdd(rowss + row, ss); }
    }
};

struct EpiUp {
    static constexpr bool PERM = true, AFTER_DRAIN = false;
    bf16_t* a2; float* bnd; float* us; const float* rowss; const float* cwp;
    __device__ __forceinline__ void operator()(const f32x4 (&acc)[2][2][4][2], const Unit& u, int wr, int wc, int fr, int fq) const {
        const int gc0 = 128 * u.pn + 32 * wc + 8 * fq;
        if (u.pm >= 64) {
#pragma unroll
            for (int ai = 0; ai < 2; ++ai)
#pragma unroll
                for (int m = 0; m < 4; ++m) { const int row = u.pm * BM + ai * HALF + wr * 64 + m * 16 + fr; const float rs = 1.0f / sqrtf(rowss[row] * (1.0f / 1024.0f) + EPS);
                    float* dst = us + (size_t)(row - TP) * FF2 + gc0;
#pragma unroll
                    for (int bj = 0; bj < 2; ++bj)
#pragma unroll
                        for (int n = 0; n < 2; ++n) *(f32x4*)(dst + bj * FF + 4 * n) = acc[ai][bj][m][n] * rs; }
            return;
        }
#pragma unroll
        for (int ai = 0; ai < 2; ++ai) {
            const int rowb = u.pm * BM + ai * HALF + wr * 64, blk = rowb >> 6;
            float rs[4];
#pragma unroll
            for (int m = 0; m < 4; ++m) rs[m] = 1.0f / sqrtf(rowss[rowb + 16 * m + fr] * (1.0f / 1024.0f) + EPS);
            if (fr < 2) {
#pragma unroll
                for (int n = 0; n < 2; ++n) { float* p = bnd + ((size_t)blk * 4 + fr) * FF2 + gc0 + 4 * n; *(f32x4*)p = acc[ai][0][0][n] * rs[0]; *(f32x4*)(p + FF) = acc[ai][1][0][n] * rs[0]; } }
            if (fr >= 14) {
#pragma unroll
                for (int n = 0; n < 2; ++n) { float* p = bnd + ((size_t)blk * 4 + 2 + (fr - 14)) * FF2 + gc0 + 4 * n; *(f32x4*)p = acc[ai][0][3][n] * rs[3]; *(f32x4*)(p + FF) = acc[ai][1][3][n] * rs[3]; } }
            float res[4][8];
#pragma unroll
            for (int n = 0; n < 2; ++n)
#pragma unroll
                for (int eh = 0; eh < 2; ++eh) {
                    const float* wp = cwp + (size_t)gc0 * 8 + (4 * n + 2 * eh) * 8;
                    const f32x4 wa0 = *(const f32x4*)wp, wa1 = *(const f32x4*)(wp + 4), wb0 = *(const f32x4*)(wp + 8), wb1 = *(const f32x4*)(wp + 12);
                    const float g0[2] = {wa0[0], wb0[0]}, g1[2] = {wa0[1], wb0[1]}, g2[2] = {wa0[2], wb0[2]}, gb[2] = {wa0[3], wb0[3]};
                    const float v0[2] = {wa1[0], wb1[0]}, v1[2] = {wa1[1], wb1[1]}, v2[2] = {wa1[2], wb1[2]}, vb[2] = {wa1[3], wb1[3]};
                    float pg[2] = {0.f, 0.f}, pv[2] = {0.f, 0.f};
#pragma unroll
                    for (int m = 0; m < 4; ++m)
#pragma unroll
                        for (int e = 0; e < 2; ++e) { const float ug = acc[ai][0][m][n][2 * eh + e] * rs[m], uv = acc[ai][1][m][n][2 * eh + e] * rs[m];
                            const float a1 = dppf<0x121>(ug), a1p = dppf<0x121>(pg[e]), a2_ = dppf<0x122>(ug), a2p = dppf<0x122>(pg[e]);
                            const float b1 = dppf<0x121>(uv), b1p = dppf<0x121>(pv[e]), b2_ = dppf<0x122>(uv), b2p = dppf<0x122>(pv[e]);
                            const float yg = g0[e] * ((fr < 2) ? a2p : a2_) + g1[e] * ((fr == 0) ? a1p : a1) + g2[e] * ug + gb[e];
                            const float yv = v0[e] * ((fr < 2) ? b2p : b2_) + v1[e] * ((fr == 0) ? b1p : b1) + v2[e] * uv + vb[e];
                            float rr = yg / (1.0f + __expf(-yg)) * yv; asm volatile("" : "+v"(rr));
                            res[m][4 * n + 2 * eh + e] = rr; pg[e] = ug; pv[e] = uv; }
                }
#pragma unroll
            for (int m = 0; m < 4; ++m) if (!(m == 0 && fr < 2)) {
                u32x4 w; w.x = cvt_pk_bf16(res[m][0], res[m][1]); w.y = cvt_pk_bf16(res[m][2], res[m][3]); w.z = cvt_pk_bf16(res[m][4], res[m][5]); w.w = cvt_pk_bf16(res[m][6], res[m][7]);
                *(u32x4*)(a2 + (size_t)(rowb + 16 * m + fr) * FF + gc0) = w; }
            __builtin_amdgcn_sched_barrier(0);
        }
    }
};

struct EpiDown {
    static constexpr bool PERM = true, AFTER_DRAIN = false;
    float* y;
    __device__ __forceinline__ void operator()(const f32x4 (&acc)[2][2][4][2], const Unit& u, int wr, int wc, int fr, int fq) const {
        const int row0 = u.pm * BM + wr * 64 + fr, col0 = u.pn * BM + wc * 32 + 8 * fq;
#pragma unroll
        for (int ai = 0; ai < 2; ++ai)
#pragma unroll
            for (int m = 0; m < 4; ++m) { float* rowp = y + (size_t)(row0 + ai * HALF + m * 16) * 1024 + col0;
#pragma unroll
                for (int bj = 0; bj < 2; ++bj)
#pragma unroll
                    for (int n = 0; n < 2; ++n) { float* p = rowp + bj * HALF + 4 * n; *(f32x4*)p = *(const f32x4*)p + acc[ai][bj][m][n]; } }
    }
};

template <class Epi, class Sched, bool ALIGN_EPI = false, bool SP2 = false>
__device__ __forceinline__ void gemm_phase(PG8_LAS unsigned char* lds, const Gemm g, const Sched& S, const Epi& E) {
    const int tid = threadIdx.x, wid = __builtin_amdgcn_readfirstlane(tid >> 6), lane = tid & 63, wr = wid >> 2, wc = wid & 3, fr = lane & 15, fq = lane >> 4;
    const int K = g.K, nt = K / BK;
    unsigned voffA[2], voffB[2];
#pragma unroll
    for (int i = 0; i < 2; ++i) { int R, C; stage_rc(tid * 16 + i * 8192, R, C); const int Rb = Epi::PERM ? ((R & ~31) + perm32(R & 31)) : R;
        voffA[i] = (unsigned)(R * g.lda + C) * 2u; voffB[i] = (unsigned)(Rb * g.ldb + C) * 2u; }
    const size_t kstep = (size_t)(BK * 2);
    const size_t hstepA = (size_t)HALF * g.lda * 2, hstepB = (size_t)HALF * g.ldb * 2;
    const size_t tstepA = 2 * hstepA, tstepB = 2 * hstepB;
    const unsigned ldsw = (unsigned)wid * 1024u;
    const int aoff = lds_byte(wr * 64 + fr, fq * 8), boff = lds_byte(wc * 32 + fr, fq * 8);
#define PG8_SA(b, h) (((b) * 2 + (h)) * HTB)
#define PG8_SB(b, h) ((4 + (b) * 2 + (h)) * HTB)
#define PG8_STAGE(bufoff, gbase, voff) do { _Pragma("unroll") for (int _i = 0; _i < 2; ++_i) \
        __builtin_amdgcn_global_load_lds((const unsigned*)((const char*)(gbase) + (voff)[_i]), (PG8_LAS unsigned*)(lds + (bufoff) + ldsw + _i * 8192), 16, 0, 0); } while (0)
#define PG8_LDA(dst, b, h) do { _Pragma("unroll") for (int m = 0; m < 4; ++m) _Pragma("unroll") for (int k = 0; k < 2; ++k) dst[m][k] = *(const PG8_LAS bf16x8*)(lds + PG8_SA(b, h) + aoff + m * 2048 + k * 1024); } while (0)
#define PG8_LDB(dst, b, h) do { _Pragma("unroll") for (int n = 0; n < 2; ++n) _Pragma("unroll") for (int k = 0; k < 2; ++k) dst[n][k] = *(const PG8_LAS bf16x8*)(lds + PG8_SB(b, h) + boff + n * 2048 + k * 1024); } while (0)
#define PG8_MMA(ai, bj, At, Bt) do { __builtin_amdgcn_s_setprio(1); _Pragma("unroll") for (int m = 0; m < 4; ++m) _Pragma("unroll") for (int n = 0; n < 2; ++n) _Pragma("unroll") for (int k = 0; k < 2; ++k) \
        acc[ai][bj][m][n] = __builtin_amdgcn_mfma_f32_16x16x32_bf16(Bt[n][k], At[m][k], acc[ai][bj][m][n], 0, 0, 0); __builtin_amdgcn_s_setprio(0); } while (0)
#define PG8_WAIT_V(n) asm volatile("s_waitcnt vmcnt(" #n ")" ::: "memory")
#define PG8_WAIT_L(n) asm volatile("s_waitcnt lgkmcnt(" #n ")" ::: "memory")
#define PG8_BAR __builtin_amdgcn_s_barrier()
#define PG8_SCHED __builtin_amdgcn_sched_barrier(0)
    Unit cur, nxt; int ui = 0;
    if (!S.next(0, cur)) return;
    f32x4 acc[2][2][4][2];
#pragma unroll
    for (int a = 0; a < 2; ++a)
#pragma unroll
        for (int b = 0; b < 2; ++b)
#pragma unroll
            for (int m = 0; m < 4; ++m)
#pragma unroll
                for (int n = 0; n < 2; ++n) acc[a][b][m][n] = (f32x4){0.f, 0.f, 0.f, 0.f};
    bf16x8 At[4][2], B0[2][2], B1[2][2];
    const char* cA = (const char*)g.A + (size_t)cur.pm * tstepA + (size_t)cur.koff * 2; const char* cB = (const char*)g.Bt + (size_t)cur.pn * tstepB + (size_t)cur.koff * 2;
    S.a_ready(cur);
    if constexpr (SP2) {
        PG8_STAGE(PG8_SB(0, 0), cB, voffB); PG8_STAGE(PG8_SB(0, 1), cB + hstepB, voffB); PG8_STAGE(PG8_SA(0, 0), cA, voffA); PG8_STAGE(PG8_SA(0, 1), cA + hstepA, voffA);
        if (wr == 1) PG8_BAR;
        PG8_WAIT_V(2); PG8_BAR;
        PG8_STAGE(PG8_SB(1, 0), cB + kstep, voffB); PG8_STAGE(PG8_SA(1, 0), cA + kstep, voffA); PG8_STAGE(PG8_SB(1, 1), cB + hstepB + kstep, voffB);
        PG8_WAIT_V(6); PG8_BAR;
    } else {
        PG8_STAGE(PG8_SB(0, 0), cB, voffB); PG8_STAGE(PG8_SA(0, 0), cA, voffA); PG8_STAGE(PG8_SB(0, 1), cB + hstepB, voffB); PG8_STAGE(PG8_SA(0, 1), cA + hstepA, voffA);
        if (wr == 1) PG8_BAR;
        PG8_WAIT_V(4); PG8_BAR;
        PG8_STAGE(PG8_SB(1, 0), cB + kstep, voffB); PG8_STAGE(PG8_SA(1, 0), cA + kstep, voffA); PG8_STAGE(PG8_SB(1, 1), cB + hstepB + kstep, voffB);
        PG8_WAIT_V(6); PG8_BAR;
    }
    for (;;) {
        const bool has_next = S.next(ui + 1, nxt);
        const char* nA = has_next ? (const char*)g.A + (size_t)nxt.pm * tstepA + (size_t)nxt.koff * 2 : cA; const char* nB = has_next ? (const char*)g.Bt + (size_t)nxt.pn * tstepB + (size_t)nxt.koff * 2 : cB;
        for (int t = 0; t < nt; t += 2) {
            const bool last = (t == nt - 2);
            const char* a1 = cA + (size_t)(t + 1) * kstep;
            const char* a2 = last ? nA : cA + (size_t)(t + 2) * kstep; const char* b2 = last ? nB : cB + (size_t)(t + 2) * kstep;
            const char* a3 = a2 + kstep; const char* b3 = b2 + kstep;
            if (last && has_next) S.a_ready(nxt);
            if constexpr (SP2) {
            PG8_LDB(B0, 0, 0); PG8_LDB(B1, 0, 1); PG8_SCHED; PG8_LDA(At, 0, 0); PG8_STAGE(PG8_SA(1, 1), a1 + hstepA, voffA);
            PG8_WAIT_V(8); PG8_WAIT_L(0); PG8_BAR; PG8_MMA(0, 0, At, B0); PG8_MMA(0, 1, At, B1); PG8_BAR; PG8_SCHED;
            PG8_LDA(At, 0, 1); PG8_STAGE(PG8_SB(0, 0), b2, voffB); PG8_STAGE(PG8_SB(0, 1), b2 + hstepB, voffB); PG8_STAGE(PG8_SA(0, 0), a2, voffA);
            PG8_WAIT_V(8); PG8_WAIT_L(0); PG8_BAR; PG8_MMA(1, 0, At, B0); PG8_MMA(1, 1, At, B1); PG8_BAR; PG8_SCHED;
            PG8_LDB(B0, 1, 0); PG8_LDB(B1, 1, 1); PG8_SCHED; PG8_LDA(At, 1, 0); PG8_STAGE(PG8_SA(0, 1), a2 + hstepA, voffA);
            PG8_WAIT_V(8); PG8_WAIT_L(0); PG8_BAR; PG8_MMA(0, 0, At, B0); PG8_MMA(0, 1, At, B1); PG8_BAR; PG8_SCHED;
            PG8_LDA(At, 1, 1); PG8_STAGE(PG8_SB(1, 0), b3, voffB); PG8_STAGE(PG8_SB(1, 1), b3 + hstepB, voffB); PG8_STAGE(PG8_SA(1, 0), a3, voffA);
            PG8_WAIT_V(8); PG8_WAIT_L(0); PG8_BAR; PG8_MMA(1, 0, At, B0); PG8_MMA(1, 1, At, B1); PG8_BAR; PG8_SCHED;
            } else {
            PG8_LDB(B0, 0, 0); PG8_SCHED; PG8_LDA(At, 0, 0); PG8_STAGE(PG8_SA(1, 1), a1 + hstepA, voffA);
            PG8_WAIT_L(8); PG8_BAR; PG8_WAIT_L(0); PG8_MMA(0, 0, At, B0); PG8_BAR; PG8_SCHED;
            PG8_LDB(B1, 0, 1); PG8_STAGE(PG8_SB(0, 0), b2, voffB);
            PG8_BAR; PG8_WAIT_L(0); PG8_MMA(0, 1, At, B1); PG8_BAR;
            PG8_LDA(At, 0, 1); PG8_STAGE(PG8_SA(0, 0), a2, voffA);
            PG8_BAR; PG8_WAIT_L(0); PG8_MMA(1, 0, At, B0); PG8_BAR; PG8_SCHED;
            PG8_STAGE(PG8_SB(0, 1), b2 + hstepB, voffB);
            PG8_WAIT_V(6); PG8_BAR; PG8_MMA(1, 1, At, B1); PG8_BAR;
            PG8_LDB(B0, 1, 0); PG8_SCHED; PG8_LDA(At, 1, 0); PG8_STAGE(PG8_SA(0, 1), a2 + hstepA, voffA);
            PG8_WAIT_L(8); PG8_BAR; PG8_WAIT_L(0); PG8_MMA(0, 0, At, B0); PG8_BAR; PG8_SCHED;
            PG8_LDB(B1, 1, 1); PG8_STAGE(PG8_SB(1, 0), b3, voffB);
            PG8_BAR; PG8_WAIT_L(0); PG8_MMA(0, 1, At, B1); PG8_BAR;
            PG8_LDA(At, 1, 1); PG8_STAGE(PG8_SA(1, 0), a3, voffA);
            PG8_BAR; PG8_WAIT_L(0); PG8_MMA(1, 0, At, B0); PG8_BAR; PG8_SCHED;
            PG8_STAGE(PG8_SB(1, 1), b3 + hstepB, voffB);
            PG8_WAIT_V(6); PG8_BAR; PG8_MMA(1, 1, At, B1); PG8_BAR;
            }
        }
        if constexpr (ALIGN_EPI) { if (wr == 0) PG8_BAR; }
        if constexpr (!Epi::AFTER_DRAIN) { E(acc, cur, wr, wc, fr, fq); S.done(cur); }
        if (!has_next) break;
#pragma unroll
        for (int a = 0; a < 2; ++a)
#pragma unroll
            for (int b = 0; b < 2; ++b)
#pragma unroll
                for (int m = 0; m < 4; ++m)
#pragma unroll
                    for (int n = 0; n < 2; ++n) acc[a][b][m][n] = (f32x4){0.f, 0.f, 0.f, 0.f};
        cur = nxt; cA = nA; cB = nB; ++ui;
        if constexpr (ALIGN_EPI) { if (wr == 1) PG8_BAR; }
    }
    PG8_WAIT_V(0);
    if constexpr (!ALIGN_EPI) { if (wr == 0) PG8_BAR; }
    PG8_BAR;
    if constexpr (Epi::AFTER_DRAIN) { E.fused(acc, cur, wr, wc, fr, fq, lds, wid, lane); S.done(cur); }
#undef PG8_SA
#undef PG8_SB
#undef PG8_STAGE
#undef PG8_LDA
#undef PG8_LDB
#undef PG8_MMA
#undef PG8_WAIT_V
#undef PG8_WAIT_L
#undef PG8_BAR
#undef PG8_SCHED
}
}
#include <hip/hip_bf16.h>
#include <cmath>
namespace attn_body {
using bf16=__hip_bfloat16;
using bf16x8=__attribute__((ext_vector_type(8)))short;
using s16x4=__attribute__((ext_vector_type(4)))short;
using f32x16=__attribute__((ext_vector_type(16)))float;
using u32x4=__attribute__((ext_vector_type(4)))unsigned;
constexpr int D=64,DM=512;
constexpr int NW=8,QBLK=32,QB=QBLK*NW,KVBLK=64;
constexpr int ATTN_PITCH=DM, ATTN_UNIT_ROWS=QB;
__device__ __forceinline__ int crow(int r,int hi){return (r&3)+8*(r>>2)+4*hi;}
#define SBAR() __builtin_amdgcn_sched_barrier(0)
__device__ __forceinline__ void cmask(f32x16&p0,f32x16&p1,int jb,int qrel,int hi){
  const float NEG=-INFINITY; int kb=64*jb+4*hi;
  #pragma unroll
  for(int r=0;r<16;++r){int kv=kb+(r&3)+8*(r>>2); if(kv>qrel)p0[r]=NEG; if(kv+32>qrel)p1[r]=NEG;}
}

constexpr int NSLOT=3, SLOTB=8192;
constexpr int LDS_K=0, LDS_V=NSLOT*SLOTB, LDS_WS=2*NSLOT*SLOTB, LDS_OST=LDS_WS+NW*64*4, LDS_BYTES=LDS_OST+NW*4096;
constexpr float C2=0.125f*1.4426950408889634f;
__device__ __forceinline__ void glds16(const void*gsrc,unsigned lds_dst){unsigned keep;
  asm volatile("s_mov_b32 %0, m0\n\ts_mov_b32 m0, %2\n\ts_nop 0\n\tglobal_load_lds_dwordx4 %1, off\n\ts_mov_b32 m0, %0":"=&s"(keep):"v"(gsrc),"s"(lds_dst):"memory");}
__device__ __forceinline__ float max3f(float a,float b,float c){float r;asm("v_max3_f32 %0, %1, %2, %3":"=v"(r):"v"(a),"v"(b),"v"(c));return r;}
__device__ __forceinline__ float max2f(float a,float b){float r;asm("v_max_f32_e32 %0, %1, %2":"=v"(r):"v"(a),"v"(b));return r;}
__device__ __forceinline__ float fadd_s(float a,float b){float r;asm("v_add_f32_e32 %0, %1, %2":"=v"(r):"v"(a),"v"(b));return r;}
__device__ __forceinline__ float fsub_s(float a,float b){float r;asm("v_sub_f32_e32 %0, %1, %2":"=v"(r):"v"(a),"v"(b));return r;}
typedef float f32x2_t __attribute__((ext_vector_type(2))); typedef __bf16 bf16x2_t __attribute__((ext_vector_type(2)));
__device__ __forceinline__ unsigned cvtpk_s(float lo,float hi){f32x2_t v={lo,hi};bf16x2_t b=__builtin_convertvector(v,bf16x2_t);return __builtin_bit_cast(unsigned,b);}
#define WAIT_BAR(N) asm volatile("s_waitcnt vmcnt(" #N ") lgkmcnt(0)\n\ts_barrier":::"memory")

__device__ __forceinline__ void qkt(f32x16&p0,f32x16&p1,const char*Kslot,const bf16x8*qr,const f32x16&negm,int r32,int hi){
  const char*kb=Kslot+hi*1024+r32*16;
  #pragma unroll
  for(int d0=0;d0<4;++d0){
    const bf16x8 b0=*reinterpret_cast<const bf16x8*>(kb+d0*2048);
    const bf16x8 b1=*reinterpret_cast<const bf16x8*>(kb+d0*2048+512);
    if(d0==0){p0=__builtin_amdgcn_mfma_f32_32x32x16_bf16(b0,qr[0],negm,0,0,0);p1=__builtin_amdgcn_mfma_f32_32x32x16_bf16(b1,qr[0],negm,0,0,0);}
    else{p0=__builtin_amdgcn_mfma_f32_32x32x16_bf16(b0,qr[d0],p0,0,0,0);p1=__builtin_amdgcn_mfma_f32_32x32x16_bf16(b1,qr[d0],p1,0,0,0);}}
}
typedef __attribute__((address_space(3))) const char* lds_cptr;
typedef short v4i16_t __attribute__((ext_vector_type(4)));
__device__ __forceinline__ void kload8(bf16x8*kf,lds_cptr kp){
  kf[0]=*(const __attribute__((address_space(3))) bf16x8*)(kp);      kf[1]=*(const __attribute__((address_space(3))) bf16x8*)(kp+512);
  kf[2]=*(const __attribute__((address_space(3))) bf16x8*)(kp+2048); kf[3]=*(const __attribute__((address_space(3))) bf16x8*)(kp+2560);
  kf[4]=*(const __attribute__((address_space(3))) bf16x8*)(kp+4096); kf[5]=*(const __attribute__((address_space(3))) bf16x8*)(kp+4608);
  kf[6]=*(const __attribute__((address_space(3))) bf16x8*)(kp+6144); kf[7]=*(const __attribute__((address_space(3))) bf16x8*)(kp+6656);
}
__device__ __forceinline__ void kload2(bf16x8*kf,lds_cptr kp,int j){ kf[2*j]=*(const __attribute__((address_space(3))) bf16x8*)(kp+j*2048); kf[2*j+1]=*(const __attribute__((address_space(3))) bf16x8*)(kp+j*2048+512); }
__device__ __forceinline__ s16x4 vtr(lds_cptr p){ return __builtin_bit_cast(s16x4,__builtin_amdgcn_ds_read_tr16_b64_v4i16((__attribute__((address_space(3))) v4i16_t*)p)); }
__device__ __forceinline__ float rowmax(const f32x16&p0,const f32x16&p1){
  float a=max3f(p0[0],p0[1],p1[0]),b=max3f(p0[2],p0[3],p1[1]);a=max3f(a,p1[2],p1[3]);
  #pragma unroll
  for(int r=4;r<16;r+=4){a=max3f(a,p0[r],p0[r+1]);b=max3f(b,p0[r+2],p0[r+3]);a=max3f(a,p1[r],p1[r+1]);b=max3f(b,p1[r+2],p1[r+3]);}
  const float m=max2f(a,b);
  auto rr=__builtin_amdgcn_permlane32_swap(__float_as_uint(m),__float_as_uint(m),false,false);
  return max2f(__uint_as_float(rr[0]),__uint_as_float(rr[1]));
}
__device__ __forceinline__ void pv(f32x16*o,int vb,bf16x8 pa0,bf16x8 pa1,bf16x8 pa2,bf16x8 pa3){
  #pragma unroll
  for(int d0=0;d0<2;++d0){s16x4 lo[4],hi[4];
    #pragma unroll
    for(int ks=0;ks<4;++ks){
      asm volatile("ds_read_b64_tr_b16 %0,%1 offset:%c2":"=&v"(lo[ks]):"v"(vb),"i"(d0*4096+ks*1024):"memory");
      asm volatile("ds_read_b64_tr_b16 %0,%1 offset:%c2":"=&v"(hi[ks]):"v"(vb),"i"(d0*4096+ks*1024+512):"memory");}
    asm volatile("s_waitcnt lgkmcnt(0)":::"memory");SBAR();
    #define PK(k) (bf16x8){lo[k][0],lo[k][1],lo[k][2],lo[k][3],hi[k][0],hi[k][1],hi[k][2],hi[k][3]}
    o[d0]=__builtin_amdgcn_mfma_f32_32x32x16_bf16(pa0,PK(0),o[d0],0,0,0);
    o[d0]=__builtin_amdgcn_mfma_f32_32x32x16_bf16(pa1,PK(1),o[d0],0,0,0);
    o[d0]=__builtin_amdgcn_mfma_f32_32x32x16_bf16(pa2,PK(2),o[d0],0,0,0);
    o[d0]=__builtin_amdgcn_mfma_f32_32x32x16_bf16(pa3,PK(3),o[d0],0,0,0);
    #undef PK
  }
}

#ifndef ATTN_STORE16
#define ATTN_STORE16(p,v) (*(u32x4*)(p)=(v))
#endif
template<int THRL> __device__ __forceinline__ void attn_unit(int tid_in,int qb,const bf16*Qb,const bf16*__restrict__ Kh,const bf16*__restrict__ Vh,bf16*Ob,char*shm){
  const int tid=tid_in,lane=tid&63,r32=lane&31,hi=lane>>5; const int wid=__builtin_amdgcn_readfirstlane(tid>>6);
  const int q0=qb*QB;
  const bf16*Qw=Qb+(long)(q0+wid*QBLK)*DM;
  const unsigned lds0=(unsigned)(uintptr_t)shm;
  float*wsf=(float*)(shm+LDS_WS)+wid*64;
  const bf16*ksrc=Kh+(long)lane*DM+wid*8;
  const bf16*vsrc=Vh+(long)(16*(wid&3)+(lane>>2))*DM+(wid>>2)*32+(lane&3)*8;
  const unsigned kdst=lds0+LDS_K+wid*1024, vdst=lds0+LDS_V+wid*1024;
  #define DMA_K(t,slot) glds16(ksrc+(long)(t)*KVBLK*DM,(unsigned)__builtin_amdgcn_readfirstlane(kdst+(slot)))
  #define DMA_V(t,slot) glds16(vsrc+(long)(t)*KVBLK*DM,(unsigned)__builtin_amdgcn_readfirstlane(vdst+(slot)))
  const int vb0=(int)(lds0+LDS_V)+((lane>>4)&1)*32+(lane&3)*8+(4*hi+((lane&15)>>2))*64;
  const char*Kbase=shm+LDS_K; bf16x8 kf[8];
  const lds_cptr shm3=(lds_cptr)shm; const lds_cptr kp0=shm3+LDS_K+hi*1024+r32*16; const lds_cptr vp0=shm3+LDS_V+((lane>>4)&1)*32+(lane&3)*8+(4*hi+((lane&15)>>2))*64;
  const int NT=(q0+QB)/KVBLK;
  DMA_K(0,0);DMA_V(0,0);DMA_K(1,SLOTB);
  bf16x8 qr[4];
  #pragma unroll
  for(int d0=0;d0<4;++d0)qr[d0]=*reinterpret_cast<const bf16x8*>(&Qw[(long)r32*DM+d0*16+hi*8]);
  float mhat=0.f,l_reg=0.f;f32x16 o[2];o[0]=f32x16{};o[1]=f32x16{};f32x16 negm=f32x16{};asm volatile("":"+v"(negm));
  const int qrel=wid*QBLK+r32;
  #define CMASK(P0,P1,t) do{int jb_=(t)-(NT-4); if(jb_>=0)cmask(P0,P1,jb_,qrel,hi);}while(0)
  bool resc=false;
  #define START(P0,P1) do{ const float rm=rowmax(P0,P1); resc=false; \
    { const float dl=rm; mhat=fadd_s(mhat,dl); \
      _Pragma("unroll") for(int r=0;r<16;++r){P0[r]=fsub_s(P0[r],dl);P1[r]=fsub_s(P1[r],dl);} \
      _Pragma("unroll") for(int r=0;r<16;++r)negm[r]=-mhat; asm volatile("":"+v"(negm)); } \
    _Pragma("unroll") for(int r=0;r<16;++r)P0[r]=__builtin_amdgcn_exp2f(P0[r]); }while(0)
  #define RESC() do{ if(resc){ asm volatile("s_waitcnt lgkmcnt(0)":::"memory"); \
      _Pragma("unroll") for(int d_=0;d_<2;++d_) _Pragma("unroll") for(int r=0;r<16;++r)o[d_][r]*=wsf[crow(r,hi)]; } }while(0)
  f32x16 pA0,pA1,pB0,pB1;
  int sl_prev=0,sl_cur=0,sl_next=SLOTB;
  #define ROT() do{sl_prev=sl_cur;sl_cur=sl_next;sl_next=(sl_next==(NSLOT-1)*SLOTB)?0:sl_next+SLOTB;}while(0)
  DMA_K(2,2*SLOTB);
  WAIT_BAR(3);
  qkt(pA0,pA1,Kbase,qr,negm,r32,hi);asm volatile("s_nop 15\n\ts_nop 7":"+v"(pA0),"+v"(pA1));CMASK(pA0,pA1,0);
  START(pA0,pA1);
  _Pragma("unroll") for(int r=0;r<16;++r)pA1[r]=__builtin_amdgcn_exp2f(pA1[r]);
  WAIT_BAR(0);
  DMA_K(3,0);DMA_V(1,SLOTB);
  ROT();
  kload8(kf,kp0+sl_cur);
  WAIT_BAR(2);
  s16x4 vlo[8],vhi[8]; u32x4 pw0,pw1,pw2,pw3;
  #define PKW(P,B) cvtpk_s(P[B],P[B+1])
  #define PAF(k) __builtin_bit_cast(bf16x8,pw##k)
  #define VFR(i) (bf16x8){vlo[i][0],vlo[i][1],vlo[i][2],vlo[i][3],vhi[i][0],vhi[i][1],vhi[i][2],vhi[i][3]}
  #define PIN(x) asm volatile("":"+v"(x))
  #define MX3(a,b,c) __builtin_fmaxf(__builtin_fmaxf((a),(b)),(c))
  #define GAPA(MF,A0,A1,A2,A3,W0,W1,PW) do{ MF; sacc+=A0; sacc+=A1; sacc+=A2; sacc+=A3; PIN(sacc); W0; W1; PIN(PW); SBAR(); }while(0)
  #define EX(v) __builtin_amdgcn_exp2f(v)
  #define GAPB(MF,X,B) do{ MF; X[B]=EX(X[B]); X[B+1]=EX(X[B+1]); X[B+2]=EX(X[B+2]); X[B+3]=EX(X[B+3]); PIN(X); SBAR(); }while(0)
  #define VRD(i) do{ vlo[i]=vtr(vp_+(((i)>>2)*4096+((i)&3)*1024)); vhi[i]=vtr(vp_+(((i)>>2)*4096+((i)&3)*1024+512)); }while(0)
  #define KRD(G,j) do{ if(G){ kload2(kf,kp0+sl_next,j); SBAR(); } }while(0)
  #define STEP(C0,C1,P0,P1,t,GK,GV,GL) do{ SBAR(); \
    const lds_cptr vp_=vp0+sl_prev; \
    VRD(0); SBAR(); float sacc=(P0[0]+P0[1]); \
    GAPA(C0=__builtin_amdgcn_mfma_f32_32x32x16_bf16(kf[0],qr[0],negm,0,0,0), P0[2],P0[3],P0[4],P0[5],     pw0[0]=PKW(P0,0), pw0[1]=PKW(P0,2), pw0); \
    VRD(4); SBAR(); GAPA(C1=__builtin_amdgcn_mfma_f32_32x32x16_bf16(kf[1],qr[0],negm,0,0,0), P0[6],P0[7],P0[8],P0[9],     pw0[2]=PKW(P0,4), pw0[3]=PKW(P0,6), pw0); \
    VRD(1); SBAR(); GAPA(C0=__builtin_amdgcn_mfma_f32_32x32x16_bf16(kf[2],qr[1],C0,0,0,0),   P0[10],P0[11],P0[12],P0[13], pw1[0]=PKW(P0,8), pw1[1]=PKW(P0,10), pw1); \
    VRD(5); SBAR(); GAPA(C1=__builtin_amdgcn_mfma_f32_32x32x16_bf16(kf[3],qr[1],C1,0,0,0),   P0[14],P0[15],P1[0],P1[1],   pw1[2]=PKW(P0,12),pw1[3]=PKW(P0,14), pw1); \
    VRD(2); SBAR(); GAPA(C0=__builtin_amdgcn_mfma_f32_32x32x16_bf16(kf[4],qr[2],C0,0,0,0),   P1[2],P1[3],P1[4],P1[5],     pw2[0]=PKW(P1,0), pw2[1]=PKW(P1,2), pw2); \
    VRD(6); SBAR(); GAPA(C1=__builtin_amdgcn_mfma_f32_32x32x16_bf16(kf[5],qr[2],C1,0,0,0),   P1[6],P1[7],P1[8],P1[9],     pw2[2]=PKW(P1,4), pw2[3]=PKW(P1,6), pw2); \
    VRD(3); SBAR(); GAPA(C0=__builtin_amdgcn_mfma_f32_32x32x16_bf16(kf[6],qr[3],C0,0,0,0),   P1[10],P1[11],P1[12],P1[13], pw3[0]=PKW(P1,8), pw3[1]=PKW(P1,10), pw3); \
    VRD(7); SBAR(); GAPA(C1=__builtin_amdgcn_mfma_f32_32x32x16_bf16(kf[7],qr[3],C1,0,0,0),   P1[14],P1[15],0.f,0.f,       pw3[2]=PKW(P1,12),pw3[3]=PKW(P1,14), pw3); \
    l_reg+=sacc; \
    if(GK){DMA_K((t)+3,sl_cur);} if(GV){DMA_V((t)+1,sl_next);} \
    CMASK(C0,C1,t); \
    { float a=MX3(C0[0],C0[1],C1[0]),b=MX3(C0[2],C0[3],C1[1]); a=MX3(a,C1[2],C1[3]); \
      _Pragma("unroll") for(int r=4;r<16;r+=4){a=MX3(a,C0[r],C0[r+1]);b=MX3(b,C0[r+2],C0[r+3]);a=MX3(a,C1[r],C1[r+1]);b=MX3(b,C1[r+2],C1[r+3]);} \
      float rm=__builtin_fmaxf(a,b); { auto rr=__builtin_amdgcn_permlane32_swap(__float_as_uint(rm),__float_as_uint(rm),false,false); rm=__builtin_fmaxf(__uint_as_float(rr[0]),__uint_as_float(rr[1])); } \
      resc=false; \
      if(__builtin_expect(__any(rm>(float)THRL),0)){ const float dl=__builtin_fmaxf(rm,0.f); mhat+=dl; \
        _Pragma("unroll") for(int r=0;r<16;++r){C0[r]-=dl;C1[r]-=dl;} \
        _Pragma("unroll") for(int r=0;r<16;++r)negm[r]=-mhat; asm volatile("":"+v"(negm)); \
        const float f=__builtin_amdgcn_exp2f(-dl); l_reg*=f; if(hi==0)wsf[r32]=f; resc=true; } } \
    SBAR(); \
    GAPB(o[0]=__builtin_amdgcn_mfma_f32_32x32x16_bf16(PAF(0),VFR(0),o[0],0,0,0), C0,0); \
    GAPB(o[1]=__builtin_amdgcn_mfma_f32_32x32x16_bf16(PAF(0),VFR(4),o[1],0,0,0), C0,4); \
    KRD(GL,0); GAPB(o[0]=__builtin_amdgcn_mfma_f32_32x32x16_bf16(PAF(1),VFR(1),o[0],0,0,0), C0,8); \
    KRD(GL,1); GAPB(o[1]=__builtin_amdgcn_mfma_f32_32x32x16_bf16(PAF(1),VFR(5),o[1],0,0,0), C0,12); \
    KRD(GL,2); GAPB(o[0]=__builtin_amdgcn_mfma_f32_32x32x16_bf16(PAF(2),VFR(2),o[0],0,0,0), C1,0); \
    KRD(GL,3); GAPB(o[1]=__builtin_amdgcn_mfma_f32_32x32x16_bf16(PAF(2),VFR(6),o[1],0,0,0), C1,4); \
    GAPB(o[0]=__builtin_amdgcn_mfma_f32_32x32x16_bf16(PAF(3),VFR(3),o[0],0,0,0), C1,8); \
    GAPB(o[1]=__builtin_amdgcn_mfma_f32_32x32x16_bf16(PAF(3),VFR(7),o[1],0,0,0), C1,12); \
    }while(0)
  int t=1;
  #undef CMASK
  #define CMASK(P0,P1,t) do{}while(0)
  for(;t+5<NT;t+=2){
    STEP(pB0,pB1,pA0,pA1,t,true,true,true);     WAIT_BAR(2); RESC(); ROT();
    STEP(pA0,pA1,pB0,pB1,t+1,true,true,true);   WAIT_BAR(2); RESC(); ROT();
  }
  #undef CMASK
  #define CMASK(P0,P1,t) do{int jb_=(t)-(NT-4); if(jb_>=0)cmask(P0,P1,jb_,qrel,hi);}while(0)
  #define ENDW(tt) do{ if((tt)+3<NT){WAIT_BAR(2);} else if((tt)+2<NT){WAIT_BAR(1);} else {WAIT_BAR(0);} }while(0)
  for(;t+1<NT;t+=2){
    STEP(pB0,pB1,pA0,pA1,t,(t+3<NT),(t+1<NT),(t+1<NT));       ENDW(t);   RESC(); ROT();
    STEP(pA0,pA1,pB0,pB1,t+1,(t+4<NT),(t+2<NT),(t+2<NT));     ENDW(t+1); RESC(); ROT();
  }
  STEP(pB0,pB1,pA0,pA1,NT-1,false,false,false); RESC();
  { float sacc=pB0[0]+pB0[1]; _Pragma("unroll") for(int r=2;r<16;++r)sacc+=pB0[r]; _Pragma("unroll") for(int r=0;r<16;++r)sacc+=pB1[r]; l_reg+=sacc;
    pw0=(u32x4){PKW(pB0,0),PKW(pB0,2),PKW(pB0,4),PKW(pB0,6)};pw1=(u32x4){PKW(pB0,8),PKW(pB0,10),PKW(pB0,12),PKW(pB0,14)};pw2=(u32x4){PKW(pB1,0),PKW(pB1,2),PKW(pB1,4),PKW(pB1,6)};pw3=(u32x4){PKW(pB1,8),PKW(pB1,10),PKW(pB1,12),PKW(pB1,14)};
    SBAR(); pv(o,vb0+sl_cur,PAF(0),PAF(1),PAF(2),PAF(3)); }
  #undef PKW
  #undef PAF
  #undef VFR
  #undef PIN
  #undef MX3
  #undef GAPA
  #undef GAPB
  #undef EX
  #undef VRD
  #undef KRD
  #undef STEP
  #undef ENDW
  {auto rr=__builtin_amdgcn_permlane32_swap(__float_as_uint(l_reg),__float_as_uint(l_reg),false,false);l_reg=__uint_as_float(rr[0])+__uint_as_float(rr[1]);}
  if(hi==0)wsf[32+r32]=l_reg;asm volatile("s_waitcnt lgkmcnt(0)":::"memory");
  float rli[16];
  #pragma unroll
  for(int r=0;r<16;++r)rli[r]=__builtin_amdgcn_rcpf(wsf[32+crow(r,hi)]);
  bf16*Ow=Ob+(long)(q0+wid*QBLK)*DM;
  { bf16*stg=(bf16*)(shm+LDS_OST)+wid*2048;
    #pragma unroll
    for(int r=0;r<16;++r){const int orow=crow(r,hi);
      #pragma unroll
      for(int d0=0;d0<2;++d0)stg[orow*64+d0*32+r32]=__float2bfloat16(o[d0][r]*rli[r]);}
    asm volatile("s_waitcnt lgkmcnt(0)":::"memory");
    #pragma unroll
    for(int i=0;i<4;++i){const int row=i*8+(lane>>3),ch=lane&7; const u32x4 v=*(const u32x4*)(stg+row*64+ch*8); ATTN_STORE16(Ow+(long)row*DM+ch*8,v);} }
  asm volatile("s_waitcnt lgkmcnt(0)\n\ts_barrier":::"memory");
  #undef DMA_K
  #undef DMA_V
  #undef CMASK
  #undef START
  #undef RESC
  #undef ROT
}

#undef SBAR
#undef WAIT_BAR
}
#define GAS __attribute__((address_space(1)))
#define LAS __attribute__((address_space(3)))
typedef unsigned short bf16;
typedef unsigned v4u __attribute__((ext_vector_type(4)));
typedef float f32x4 __attribute__((ext_vector_type(4)));
typedef short bf16x8 __attribute__((ext_vector_type(8)));
typedef GAS unsigned gu32;
typedef GAS unsigned long long gu64;
#define RLX_AGENT __ATOMIC_RELAXED, __HIP_MEMORY_SCOPE_AGENT
#define LDS_WAIT() asm volatile("s_waitcnt lgkmcnt(0)" ::: "memory")
#define VM_WAIT() asm volatile("s_waitcnt vmcnt(0)" ::: "memory")
__device__ __forceinline__ unsigned long long rt() { return __builtin_amdgcn_s_memrealtime(); }
__device__ __forceinline__ unsigned f2bf(float f) { unsigned u = __builtin_bit_cast(unsigned, f); return (u + 0x7fffu + ((u >> 16) & 1u)) >> 16; }
__device__ __forceinline__ unsigned pk2(float lo, float hi) { return f2bf(lo) | (f2bf(hi) << 16); }

#define XB_TMO      128
#define XB_XCNT(j)  (256  + 64 * (j))
#define XB_XSUB(j)  (1280 + 64 * (j))
#define XB_XGEN(j)  (2304 + 64 * (j))
#define XB_TOP      3328
#define XB_TOPGEN   3392
#define XCD_BAR_WORDS 3456
#define XB_SPIN_CAP (1u << 18)

__device__ __forceinline__ unsigned xb_ld(unsigned* p)              { return __hip_atomic_load(p, __ATOMIC_RELAXED, __HIP_MEMORY_SCOPE_AGENT); }
__device__ __forceinline__ unsigned xb_add(unsigned* p, unsigned v) { return __hip_atomic_fetch_add(p, v, __ATOMIC_RELAXED, __HIP_MEMORY_SCOPE_AGENT); }
__device__ __forceinline__ unsigned xb_xcc_id() { return (unsigned)__builtin_amdgcn_s_getreg((3 << 11) | 20) & 0xFu; }
#define XB_SPIN(cond, bar) do { unsigned _sp = 0; while (cond) { __builtin_amdgcn_s_sleep(1); \
    if ((++_sp & 255u) == 0u) { if (xb_ld(&(bar)[XB_TMO])) break; if (_sp > XB_SPIN_CAP) { atomicAdd(&(bar)[XB_TMO], 1u); break; } } } } while (0)

struct XcdBarrier {
    unsigned* bar; unsigned x;
    volatile LAS unsigned* st;
};

__device__ __forceinline__ XcdBarrier xcd_barrier_post(unsigned* bar, volatile LAS unsigned* st) {
    XcdBarrier b; b.bar = bar; b.x = xb_xcc_id(); b.st = st;
    if (threadIdx.x == 0) (void)xb_add(&bar[XB_XCNT(b.x)], 1u);
    return b;
}
__device__ __forceinline__ void xcd_barrier_complete(unsigned* bar, unsigned x, unsigned& nloc, unsigned& nx) {
    const unsigned G = gridDim.x * gridDim.y * gridDim.z;
    unsigned sum, cnt, mine, sp = 0u;
    for (;;) {
        sum = 0u; cnt = 0u; mine = 0u;
#pragma unroll
        for (unsigned j = 0; j < 16; ++j) { const unsigned c = xb_ld(&bar[XB_XCNT(j)]); sum += c; cnt += (c > 0u) ? 1u : 0u; mine = (j == x) ? c : mine; }
        if (sum == G) break;
        __builtin_amdgcn_s_sleep(1);
        if ((++sp & 255u) == 0u) { if (xb_ld(&bar[XB_TMO])) break; if (sp > XB_SPIN_CAP) { atomicAdd(&bar[XB_TMO], 1u); break; } }
    }
    nloc = mine > 0u ? mine : 1u; nx = cnt > 0u ? cnt : 1u;
}

__device__ __forceinline__ void xcd_barrier(const XcdBarrier& b) {
    asm volatile("s_waitcnt vmcnt(0)" ::: "memory");
    __syncthreads();
    if (threadIdx.x == 0) {
        unsigned* bar = b.bar;
        __builtin_amdgcn_s_waitcnt(0);
        unsigned nloc = b.st[0], nx = b.st[1];
        if (nloc == 0u) { xcd_barrier_complete(bar, b.x, nloc, nx); b.st[0] = nloc; b.st[1] = nx; }
        const unsigned old = xb_add(&bar[XB_XSUB(b.x)], 1u);
        const unsigned gen = old / nloc;
        if (old + 1u == (gen + 1u) * nloc) {
            __builtin_amdgcn_fence(__ATOMIC_RELEASE, "agent");
            asm volatile("s_waitcnt vmcnt(0)" ::: "memory");
            const unsigned og = xb_add(&bar[XB_TOP], 1u);
            const unsigned tg = og / nx;
            if (og + 1u == (tg + 1u) * nx) xb_add(&bar[XB_TOPGEN], 1u);
            else XB_SPIN(xb_ld(&bar[XB_TOPGEN]) == tg, bar);
            __builtin_amdgcn_fence(__ATOMIC_ACQUIRE, "agent");
            xb_add(&bar[XB_XGEN(b.x)], 1u);
            asm volatile("s_waitcnt vmcnt(0)" ::: "memory");
        } else {
            XB_SPIN(xb_ld(&bar[XB_XGEN(b.x)]) == gen, bar);
            __builtin_amdgcn_fence(__ATOMIC_ACQUIRE, "agent");
            asm volatile("s_waitcnt vmcnt(0)" ::: "memory");
        }
    }
    __syncthreads();
}
struct Args { const float* in[27]; const int* pt; float* out; unsigned char* ws; int ph_lo, ph_hi, use_bar, pad; };
enum { I_XP = 0, I_XS, I_GCONV, I_GS, I_CK, I_CV, I_PT, I_FCONV, I_ANG, I_WIN, I_GCW, I_ALOG, I_DTB, I_GNG, I_QNG, I_KNG, I_LQ1, I_LK1, I_LQ2, I_LK2, I_SUBG, I_WOUT, I_FNG, I_WUP, I_FCW, I_FCB, I_WDN };
constexpr int NWAVES = 8;
constexpr int RING_BYTES = 131072, LDSCTL_OFF = RING_BYTES, MISC_OFF = LDSCTL_OFF + 320, LDS_BYTES = 147456;
typedef unsigned v2u __attribute__((ext_vector_type(2)));
typedef float f32x2v __attribute__((ext_vector_type(2)));

__device__ __forceinline__ float wave_sum(float v) {
#pragma unroll
    for (int o = 1; o < 64; o <<= 1) v += __shfl_xor(v, o);
    return v;
}
__device__ __forceinline__ float bf2f(bf16 b) { return __uint_as_float(((unsigned)b) << 16); }
__device__ __forceinline__ float bflo(unsigned w) { return __uint_as_float(w << 16); }
__device__ __forceinline__ float bfhi(unsigned w) { return __uint_as_float(w & 0xffff0000u); }
typedef float f32x2_t __attribute__((ext_vector_type(2))); typedef __bf16 bf16x2_t __attribute__((ext_vector_type(2)));
__device__ __forceinline__ unsigned cvtpk(float lo, float hi) { f32x2_t v = {lo, hi}; bf16x2_t b = __builtin_convertvector(v, bf16x2_t); return __builtin_bit_cast(unsigned, b); }
__device__ __forceinline__ bf16x8 pack8(const f32x4& a, const f32x4& b) { v4u w; w.x = cvtpk(a[0], a[1]); w.y = cvtpk(a[2], a[3]); w.z = cvtpk(b[0], b[1]); w.w = cvtpk(b[2], b[3]); return __builtin_bit_cast(bf16x8, w); }
#define MFMA16(a, b, c) __builtin_amdgcn_mfma_f32_16x16x32_bf16((a), (b), (c), 0, 0, 0)
template <int CTRL> __device__ __forceinline__ float dpp_(float x) { return __builtin_bit_cast(float, __builtin_amdgcn_mov_dpp(__builtin_bit_cast(int, x), CTRL, 0xf, 0xf, true)); }
__device__ __forceinline__ float row16_max(float v) { v = fmaxf(v, dpp_<0xB1>(v)); v = fmaxf(v, dpp_<0x4E>(v)); v = fmaxf(v, dpp_<0x124>(v)); v = fmaxf(v, dpp_<0x128>(v)); return v; }
__device__ __forceinline__ float row16_sum(float v) { v += dpp_<0xB1>(v); v += dpp_<0x4E>(v); v += dpp_<0x124>(v); v += dpp_<0x128>(v); return v; }
template <int N> __device__ __forceinline__ float tred(float (&x)[N], int lane) {
    if constexpr (N == 1) return x[0];
    else { float y[N / 2];
#pragma unroll
        for (int j = 0; j < N / 2; ++j) { const bool up = (lane & (N / 2)) != 0; const float keep = up ? x[j + N / 2] : x[j], send = up ? x[j] : x[j + N / 2]; y[j] = keep + __shfl_xor(send, N / 2); }
        return tred<N / 2>(y, lane); }
}

__device__ __forceinline__ void p0_item(const float* W, int ldw, int src_col0, bf16* WT, int K, int dst_row0, int k0, const float* ksc, LAS float* scr, int lane) {
#pragma unroll 8
    for (int i = 0; i < 32; ++i) { const int kk = 2 * i + (lane >> 5); float w = W[(size_t)(k0 + kk) * ldw + src_col0 + (lane & 31)]; if (ksc) w *= ksc[k0 + kk]; scr[kk * 33 + (lane & 31)] = w; }
    LDS_WAIT(); asm volatile("" ::: "memory");
    const int c = lane & 7;
#pragma unroll
    for (int j = 0; j < 4; ++j) { const int n = (lane >> 3) + 8 * j; const LAS float* s = scr + (8 * c) * 33 + n;
        v4u o; o.x = pk2(s[0 * 33], s[1 * 33]); o.y = pk2(s[2 * 33], s[3 * 33]); o.z = pk2(s[4 * 33], s[5 * 33]); o.w = pk2(s[6 * 33], s[7 * 33]);
        *(GAS v4u*)(WT + (size_t)(dst_row0 + n) * K + k0 + 8 * c) = o; }
    LDS_WAIT(); asm volatile("" ::: "memory");
}
__device__ __forceinline__ void p0_prologue(const Args& a, LAS unsigned char* lds, int lane, int wave, int vcu, int G) {
    LAS float* scr = (LAS float*)(lds + wave * 16384);
    const int gw = vcu * NWAVES + wave, NGW = G * NWAVES;
    bf16* WIN = (bf16*)(a.ws + WS_WIN); bf16* WOUT = (bf16*)(a.ws + WS_WOUT); bf16* WUP = (bf16*)(a.ws + WS_WUP); bf16* WDN = (bf16*)(a.ws + WS_WDN);
    constexpr int N1 = 16 * 112, N2 = 16 * 32, N3 = 16 * 176, N4 = 44 * 32;
    for (int it = gw; it < N1 + N2 + N3 + N4; it += NGW) {
        int r = it;
        if (r < N1) { const int kb = r / 112, nb = r % 112, tile = nb >> 3, wi = nb & 7, bj = wi >> 2, wc = wi & 3, nl = 256 * tile + 64 * wc + 32 * bj, src = nl < 2048 ? nl : nl + 8;
            p0_item(a.in[I_WIN], INC, src, WIN, 1024, 32 * nb, 64 * kb, nullptr, scr, lane); continue; } r -= N1;
        if (r < N2) { const int kb = r / 32, nb = r % 32; p0_item(a.in[I_WOUT], 1024, 32 * nb, WOUT, 1024, 32 * nb, 64 * kb, nullptr, scr, lane); continue; } r -= N2;
        if (r < N3) { const int kb = r / 176, nb = r % 176, tile = nb >> 3, wi = nb & 7, bj = wi >> 2, r32 = wi & 3, src = bj * FF + 128 * tile + 32 * r32;
            p0_item(a.in[I_WUP], FF2, src, WUP, 1024, 32 * nb, 64 * kb, a.in[I_FNG], scr, lane); continue; } r -= N3;
        { const int kb = r / 32, nb = r % 32; p0_item(a.in[I_WDN], 1024, 32 * nb, WDN, FF, 32 * nb, 64 * kb, nullptr, scr, lane); }
    }
    { const float* fcw = a.in[I_FCW]; const float* fcb = a.in[I_FCB]; float* CWP = (float*)(a.ws + WS_CWP);
      for (int c = gw * 64 + lane; c < FF; c += NGW * 64) {
          *(f32x4*)(CWP + (size_t)c * 8) = (f32x4){fcw[c], fcw[FF2 + c], fcw[2 * FF2 + c], fcb[c]};
          *(f32x4*)(CWP + (size_t)c * 8 + 4) = (f32x4){fcw[FF + c], fcw[FF2 + FF + c], fcw[2 * FF2 + FF + c], fcb[FF + c]}; } }
    float wl[16][8], gl[16];
    const float* win = a.in[I_WIN]; const float* ang = a.in[I_ANG];
#pragma unroll
    for (int j = 0; j < 4; ++j)
#pragma unroll
        for (int e = 0; e < 4; ++e) { const int k = 256 * j + 4 * lane + e; const float* wp = win + (size_t)k * INC + 2048; const f32x4 w0 = *(const f32x4*)wp, w1 = *(const f32x4*)(wp + 4);
            wl[4 * j + e][0] = w0[0]; wl[4 * j + e][1] = w0[1]; wl[4 * j + e][2] = w0[2]; wl[4 * j + e][3] = w0[3]; wl[4 * j + e][4] = w1[0]; wl[4 * j + e][5] = w1[1]; wl[4 * j + e][6] = w1[2]; wl[4 * j + e][7] = w1[3];
            gl[4 * j + e] = ang[k]; }
    bf16* XN = (bf16*)(a.ws + WS_XN); float* BA = (float*)(a.ws + WS_BA);
    for (int row = gw; row < MT; row += NGW) {
        const float* xr = row < TP ? a.in[I_XP] + (size_t)row * 1024 : a.in[I_XS] + (size_t)(row - TP) * 1024;
        f32x4 v[4]; float ss = 0.f;
#pragma unroll
        for (int j = 0; j < 4; ++j) { v[j] = *(const f32x4*)(xr + 256 * j + 4 * lane); ss += (v[j][0] * v[j][0] + v[j][1] * v[j][1]) + (v[j][2] * v[j][2] + v[j][3] * v[j][3]); }
        const float rstd = 1.0f / sqrtf(wave_sum(ss) * (1.0f / 1024.0f) + EPS);
        float lg[8] = {0.f, 0.f, 0.f, 0.f, 0.f, 0.f, 0.f, 0.f};
#pragma unroll
        for (int j = 0; j < 4; ++j) { f32x4 xn;
#pragma unroll
            for (int e = 0; e < 4; ++e) { xn[e] = v[j][e] * rstd * gl[4 * j + e];
#pragma unroll
                for (int q = 0; q < 8; ++q) lg[q] += xn[e] * wl[4 * j + e][q]; }
            v2u o; o.x = pk2(xn[0], xn[1]); o.y = pk2(xn[2], xn[3]); *(GAS v2u*)(XN + (size_t)row * 1024 + 256 * j + 4 * lane) = o; }
#pragma unroll
        for (int q = 0; q < 8; ++q) lg[q] = wave_sum(lg[q]);
        if (lane == 0) { *(f32x4*)(BA + (size_t)row * 8) = (f32x4){lg[0], lg[1], lg[2], lg[3]}; *(f32x4*)(BA + (size_t)row * 8 + 4) = (f32x4){lg[4], lg[5], lg[6], lg[7]}; }
    }
}

__device__ __forceinline__ void conv_chan64(const bf16* ub  , int c, const float* cw, int col, bool has_prev, float (&o)[64]) {
    const float w0 = cw[col], w1 = cw[1536 + col], w2 = cw[3072 + col], w3 = cw[4608 + col];
    float x0 = 0.f, x1 = 0.f, x2 = 0.f;
    if (has_prev) { x0 = bf2f((ub - 3 * 1536)[c]); x1 = bf2f((ub - 2 * 1536)[c]); x2 = bf2f((ub - 1536)[c]); }
#pragma unroll
    for (int i = 0; i < 64; ++i) { const float x3 = bf2f((ub + (size_t)i * 1536)[c]); const float y = w0 * x0 + w1 * x1 + w2 * x2 + w3 * x3; o[i] = y / (1.0f + __expf(-y)); x0 = x1; x1 = x2; x2 = x3; }
}
#define FRESH(v_, expr_) int v_ = (expr_); asm volatile("" : "+v"(v_))
__device__ __forceinline__ void gdn_prep(const Args& a, LAS unsigned char* lds, int tid, int wave, int vcu, int G) {
    const int half = wave >> 2, hw = wave & 3;
    LAS unsigned char* hp = lds + half * 57344;
    LAS bf16* q_s = (LAS bf16*)hp; LAS bf16* k_s = (LAS bf16*)(hp + 17408); LAS float* M_s = (LAS float*)(hp + 34816);
    LAS float* part_s = (LAS float*)(hp + 52224); LAS float* beta_s = (LAS float*)(hp + 53248); LAS float* gcum_s = (LAS float*)(hp + 53504);
    const bf16* GQKV = (const bf16*)(a.ws + WS_GQKV); const float* BA = (const float*)(a.ws + WS_BA); const float* cw = a.in[I_GCW];
    const bool roleA = hw < 2;
    for (int pair = vcu; pair < 512; pair += G) {
        const int chunk = 2 * pair + half, bh = chunk >> 6, ci = chunk & 63, b = bh >> 2, h = bh & 3;
        const size_t rb = (size_t)b * 4096 + 64 * ci;
        unsigned char* rec = a.ws + WS_GCH + (size_t)chunk * GCH_STRIDE;
        float xa[64], xb[64];
        {   FRESH(t1, tid); const int lane = t1 & 63, c = t1 & 127;
            float mine;
            if (roleA) { conv_chan64(GQKV + rb * 1536 + 128 * h, c, cw, 128 * h + c, ci > 0, xb);
                { float sq[64];
#pragma unroll
                  for (int i = 0; i < 64; ++i) sq[i] = xb[i] * xb[i];
                  mine = tred<64>(sq, lane); }
                asm volatile("" ::: "memory");
                conv_chan64(GQKV + rb * 1536 + 1024 + 128 * h, c, cw, 1024 + 128 * h + c, ci > 0, xa);
            } else { conv_chan64(GQKV + rb * 1536 + 512 + 128 * h, c, cw, 512 + 128 * h + c, ci > 0, xa);
                float sq[64];
#pragma unroll
                for (int i = 0; i < 64; ++i) sq[i] = xa[i] * xa[i];
                mine = tred<64>(sq, lane);
            }
            part_s[hw * 64 + lane] = mine;
            if (hw == 0) { const float* bap = BA + (rb + lane) * 8; const float bl = bap[h], al = bap[4 + h];
                const float beta = 1.0f / (1.0f + __expf(-bl));
                const float xs = al + a.in[I_DTB][h]; const float sp = fmaxf(xs, 0.f) + log1pf(__expf(-fabsf(xs)));
                float cs = -__expf(a.in[I_ALOG][h]) * sp;
#pragma unroll
                for (int o = 1; o < 64; o <<= 1) { const float t = __shfl_up(cs, o); if (lane >= o) cs += t; }
                beta_s[lane] = beta; gcum_s[lane] = cs; }
        }
        __syncthreads();
        {   FRESH(t2, tid); const int c = t2 & 127;
            if (roleA) {
#pragma unroll
                for (int i = 0; i < 64; ++i) { const float r = (1.0f / sqrtf(part_s[i] + part_s[64 + i] + EPS)) * 0.08838834764831845f; xb[i] *= r; q_s[i * 136 + c] = (bf16)f2bf(xb[i]); }
            } else {
#pragma unroll
                for (int i = 0; i < 64; ++i) { const float r = 1.0f / sqrtf(part_s[128 + i] + part_s[192 + i] + EPS); xa[i] *= r; k_s[i * 136 + c] = (bf16)f2bf(xa[i]); }
            }
        }
        __syncthreads();
        {
            FRESH(t3, tid); const int n = t3 & 15, kg = (t3 >> 4) & 3, ti = hw;
            bf16* INTRA = (bf16*)(rec + 81920);
#pragma unroll
            for (int tj = 0; tj < 4; ++tj) {
                f32x4 aK = (f32x4){0.f, 0.f, 0.f, 0.f}, aQ = aK;
                if (tj <= ti) {
#pragma unroll
                    for (int ks = 0; ks < 4; ++ks) {
                        const bf16x8 ak = *(const LAS bf16x8*)(k_s + (16 * ti + n) * 136 + 32 * ks + 8 * kg), aq = *(const LAS bf16x8*)(q_s + (16 * ti + n) * 136 + 32 * ks + 8 * kg);
                        const bf16x8 bk = *(const LAS bf16x8*)(k_s + (16 * tj + n) * 136 + 32 * ks + 8 * kg);
                        aK = MFMA16(ak, bk, aK); aQ = MFMA16(aq, bk, aQ); }
                }
#pragma unroll
                for (int j = 0; j < 4; ++j) { const int i = 16 * ti + 4 * kg + j, jp = 16 * tj + n;
                    const float dec = (i >= jp) ? __expf(fminf(gcum_s[i] - gcum_s[jp], 0.f)) : 0.f;
                    if (tj <= ti) M_s[i * 68 + jp] = (i > jp) ? beta_s[i] * aK[j] * dec : 0.f;
                    INTRA[((ti * 2 + (tj >> 1)) * 64 + (4 * kg + j) + 16 * (n >> 2)) * 8 + 4 * (tj & 1) + (n & 3)] = (bf16)f2bf(aQ[j] * dec); }
            }
        }
        __syncthreads();
        {   FRESH(t4, tid); const int c = t4 & 127;
            if (roleA) {
#pragma unroll
                for (int i = 0; i < 64; ++i) { q_s[i * 136 + c] = (bf16)f2bf(xb[i] * __expf(gcum_s[i])); xa[i] *= beta_s[i]; }
            } else {
                const float gl = gcum_s[63]; const int dt = c >> 4, m = c & 15;
                unsigned char* KDT = rec + 65536;
#pragma unroll
                for (int ks2 = 0; ks2 < 2; ++ks2)
#pragma unroll
                    for (int kgi = 0; kgi < 4; ++kgi)
#pragma unroll
                        for (int hh = 0; hh < 2; ++hh) { const int t0 = 32 * ks2 + 16 * hh + 4 * kgi;
                            v2u w; w.x = pk2(xa[t0] * __expf(gl - gcum_s[t0]), xa[t0 + 1] * __expf(gl - gcum_s[t0 + 1])); w.y = pk2(xa[t0 + 2] * __expf(gl - gcum_s[t0 + 2]), xa[t0 + 3] * __expf(gl - gcum_s[t0 + 3]));
                            *(GAS v2u*)(KDT + ((dt * 2 + ks2) * 64 + m + 16 * kgi) * 16 + hh * 8) = w; }
                if (c == 0) *(float*)(rec + 90112) = __expf(gl);
#pragma unroll
                for (int i = 0; i < 64; ++i) xa[i] *= beta_s[i] * __expf(gcum_s[i]);
            }
        }
#pragma unroll
        for (int i = 1; i < 64; ++i) { float acc = xa[i];
#pragma unroll
            for (int j4 = 0; j4 <= (i - 1) / 4; ++j4) { const f32x4 mr = *(const LAS f32x4*)(M_s + i * 68 + 4 * j4);
                acc -= mr[0] * xa[4 * j4]; if (4 * j4 + 1 < i) acc -= mr[1] * xa[4 * j4 + 1]; if (4 * j4 + 2 < i) acc -= mr[2] * xa[4 * j4 + 2]; if (4 * j4 + 3 < i) acc -= mr[3] * xa[4 * j4 + 3]; }
            xa[i] = acc; }
        {   FRESH(t5, tid); const int c = t5 & 127;
            if (roleA) { float* U = (float*)rec; const int s = c >> 4, n = c & 15;
#pragma unroll
                for (int mt = 0; mt < 4; ++mt)
#pragma unroll
                    for (int kgi = 0; kgi < 4; ++kgi) *(f32x4*)(U + (((s * 4 + mt) * 64 + n + 16 * kgi) * 4)) = (f32x4){xa[16 * mt + 4 * kgi], xa[16 * mt + 4 * kgi + 1], xa[16 * mt + 4 * kgi + 2], xa[16 * mt + 4 * kgi + 3]};
            } else {
#pragma unroll
                for (int i = 0; i < 64; ++i) k_s[i * 136 + c] = (bf16)f2bf(-xa[i]);
            }
        }
        __syncthreads();
        {   FRESH(t6, tid); const int ht = t6 & 255;
#pragma unroll
            for (int rep = 0; rep < 4; ++rep) { const int idx = ht + 256 * rep, mt = idx >> 8, ks = (idx >> 6) & 3, l = idx & 63, m = l & 15, kgi = l >> 4, row = 16 * mt + m;
                const v2u wlo = *(const LAS v2u*)(k_s + row * 136 + 32 * ks + 4 * kgi), whi = *(const LAS v2u*)(k_s + row * 136 + 32 * ks + 16 + 4 * kgi);
                *(GAS v4u*)(rec + 32768 + (size_t)idx * 16) = (v4u){wlo.x, wlo.y, whi.x, whi.y};
                const v2u qlo = *(const LAS v2u*)(q_s + row * 136 + 32 * ks + 4 * kgi), qhi = *(const LAS v2u*)(q_s + row * 136 + 32 * ks + 16 + 4 * kgi);
                *(GAS v4u*)(rec + 49152 + (size_t)idx * 16) = (v4u){qlo.x, qlo.y, qhi.x, qhi.y}; }
        }
    }
    __syncthreads();
}
#undef FRESH
__device__ __forceinline__ void gdn_chain(const Args& a, LAS unsigned char* lds, int lane, int wave, int bh) {
    const int b = bh >> 2, h = bh & 3, s = wave, n = lane & 15, kg = lane >> 4;
    const unsigned char* rec0 = a.ws + WS_GCH + (size_t)(bh * 64) * GCH_STRIDE;
    float* OG = (float*)(a.ws + WS_OG);
    f32x4 S[8];
#pragma unroll
    for (int dt = 0; dt < 8; ++dt) S[dt] = (f32x4){0.f, 0.f, 0.f, 0.f};
#define CH_DMA(ci_, bi_) do { const unsigned char* src_ = rec0 + (size_t)(ci_) * GCH_STRIDE + 32768; _Pragma("unroll") for (int r_ = 0; r_ < 7; ++r_) \
        __builtin_amdgcn_global_load_lds((const unsigned*)(src_ + (r_ * 8 + wave) * 1024 + lane * 16), (LAS unsigned*)(lds + (bi_) * 57344 + (r_ * 8 + wave) * 1024), 16, 0, 0); } while (0)
    f32x4 u[4], un[4]; float egl, egn;
    CH_DMA(0, 0);
#pragma unroll
    for (int mt = 0; mt < 4; ++mt) u[mt] = *(const f32x4*)(rec0 + (size_t)((s * 4 + mt) * 64 + lane) * 16);
    egl = *(const float*)(rec0 + 90112);
    for (int ci = 0; ci < 64; ++ci) {
        VM_WAIT(); __syncthreads();
        if (ci + 1 < 64) { CH_DMA(ci + 1, (ci + 1) & 1); const unsigned char* rn = rec0 + (size_t)(ci + 1) * GCH_STRIDE;
#pragma unroll
            for (int mt = 0; mt < 4; ++mt) un[mt] = *(const f32x4*)(rn + (size_t)((s * 4 + mt) * 64 + lane) * 16);
            egn = *(const float*)(rn + 90112); }
        const LAS unsigned char* bp = lds + (ci & 1) * 57344 + lane * 16;
        bf16x8 Sb[4];
#pragma unroll
        for (int ks = 0; ks < 4; ++ks) Sb[ks] = pack8(S[2 * ks], S[2 * ks + 1]);
        f32x4 vn[4], o[4];
#pragma unroll
        for (int mt = 0; mt < 4; ++mt) { vn[mt] = u[mt]; o[mt] = (f32x4){0.f, 0.f, 0.f, 0.f};
#pragma unroll
            for (int ks = 0; ks < 4; ++ks) { vn[mt] = MFMA16(*(const LAS bf16x8*)(bp + (mt * 4 + ks) * 1024), Sb[ks], vn[mt]); o[mt] = MFMA16(*(const LAS bf16x8*)(bp + 16384 + (mt * 4 + ks) * 1024), Sb[ks], o[mt]); } }
        bf16x8 Vb[2];
        Vb[0] = pack8(vn[0], vn[1]); Vb[1] = pack8(vn[2], vn[3]);
#pragma unroll
        for (int mt = 0; mt < 4; ++mt)
#pragma unroll
            for (int k2 = 0; k2 < 2; ++k2) o[mt] = MFMA16(*(const LAS bf16x8*)(bp + 49152 + (mt * 2 + k2) * 1024), Vb[k2], o[mt]);
#pragma unroll
        for (int dt = 0; dt < 8; ++dt) { S[dt] = S[dt] * egl;
#pragma unroll
            for (int k2 = 0; k2 < 2; ++k2) S[dt] = MFMA16(*(const LAS bf16x8*)(bp + 32768 + (dt * 2 + k2) * 1024), Vb[k2], S[dt]); }
        float* op = OG + ((size_t)b * 4096 + 64 * ci + 4 * kg) * 512 + 128 * h + 16 * s + n;
#pragma unroll
        for (int mt = 0; mt < 4; ++mt)
#pragma unroll
            for (int j = 0; j < 4; ++j) op[(size_t)(16 * mt + j) * 512] = o[mt][j];
#pragma unroll
        for (int mt = 0; mt < 4; ++mt) u[mt] = un[mt];
        egl = egn;
    }
#undef CH_DMA
    float* sp = a.out + O_SP + ((size_t)bh * 128 + 4 * kg) * 128 + 16 * s + n;
#pragma unroll
    for (int dt = 0; dt < 8; ++dt)
#pragma unroll
        for (int j = 0; j < 4; ++j) sp[(size_t)(16 * dt + j) * 128] = S[dt][j];
}

__device__ __forceinline__ void gdn_sample(const Args& a, LAS unsigned char* lds, int tid, int lane, int wave, int item) {
    const int bd = item >> 2, h = item & 3;
    LAS float* raw = (LAS float*)lds;
    LAS float* nrm = raw + 1536;
    LAS float* gbv = nrm + 16;
    LAS float* red = gbv + 16;
    LAS float* red2 = red + 1024;
    const size_t row0 = (size_t)TP + 4 * bd;
    if (tid < 384) { const int part = tid >> 7, c = tid & 127, col = 512 * part + 128 * h + c;
        const float* cw = a.in[I_GCW]; const float w0 = cw[col], w1 = cw[1536 + col], w2 = cw[3072 + col], w3 = cw[4608 + col];
        const float* st = a.in[I_GCONV] + (size_t)bd * 3 * 1536 + col; const bf16* gq = (const bf16*)(a.ws + WS_GQKV) + row0 * 1536 + col;
        float xp[7]; xp[0] = st[0]; xp[1] = st[1536]; xp[2] = st[3072];
#pragma unroll
        for (int t = 0; t < 4; ++t) xp[3 + t] = bf2f(gq[(size_t)t * 1536]);
#pragma unroll
        for (int t = 0; t < 4; ++t) { const float y = w0 * xp[t] + w1 * xp[t + 1] + w2 * xp[t + 2] + w3 * xp[t + 3]; const float v = y / (1.0f + __expf(-y)); raw[(part * 4 + t) * 128 + c] = v;
            if (part < 2) { const float sq = wave_sum(v * v); if (lane == 0) nrm[wave * 4 + t] = sq; } }
    } else if (tid < 388) { const int t = tid - 384; const float* bap = (const float*)(a.ws + WS_BA) + (row0 + t) * 8; const float bl = bap[h], al = bap[4 + h];
        const float xs = al + a.in[I_DTB][h]; const float sp = fmaxf(xs, 0.f) + log1pf(__expf(-fabsf(xs)));
        gbv[t] = 1.0f / (1.0f + __expf(-bl)); gbv[4 + t] = __expf(-__expf(a.in[I_ALOG][h]) * sp); }
    __syncthreads();
    const int rbk = lane >> 5, c4 = lane & 31, r0 = 16 * wave + 8 * rbk;
    f32x4 S[8];
    const float* s0 = a.in[I_GS] + ((size_t)item * 128 + r0) * 128 + 4 * c4;
#pragma unroll
    for (int i = 0; i < 8; ++i) S[i] = *(const f32x4*)(s0 + (size_t)i * 128);
    float* OG = (float*)(a.ws + WS_OG);
    for (int t = 0; t < 4; ++t) {
        const float rq = (1.0f / sqrtf(nrm[t] + nrm[4 + t] + EPS)) * 0.08838834764831845f, rk = 1.0f / sqrtf(nrm[8 + t] + nrm[12 + t] + EPS);
        const float eg = gbv[4 + t], bt = gbv[t];
        float kn[8], qn[8];
#pragma unroll
        for (int i = 0; i < 8; ++i) { kn[i] = raw[(4 + t) * 128 + r0 + i] * rk; qn[i] = raw[t * 128 + r0 + i] * rq; }
        const f32x4 v4 = *(const LAS f32x4*)(raw + (8 + t) * 128 + 4 * c4);
        f32x4 p = (f32x4){0.f, 0.f, 0.f, 0.f};
#pragma unroll
        for (int i = 0; i < 8; ++i) p += S[i] * kn[i];
#pragma unroll
        for (int e = 0; e < 4; ++e) p[e] += __shfl_xor(p[e], 32);
        if (lane < 32) *(LAS f32x4*)(red + wave * 128 + 4 * c4) = p;
        __syncthreads();
        f32x4 ks = (f32x4){0.f, 0.f, 0.f, 0.f};
#pragma unroll
        for (int w = 0; w < 8; ++w) ks += *(const LAS f32x4*)(red + w * 128 + 4 * c4);
        const f32x4 delta = (v4 - ks * eg) * bt;
        p = (f32x4){0.f, 0.f, 0.f, 0.f};
#pragma unroll
        for (int i = 0; i < 8; ++i) { S[i] = S[i] * eg + delta * kn[i]; p += S[i] * qn[i]; }
#pragma unroll
        for (int e = 0; e < 4; ++e) p[e] += __shfl_xor(p[e], 32);
        if (lane < 32) *(LAS f32x4*)(red2 + wave * 128 + 4 * c4) = p;
        __syncthreads();
        if (wave == 0 && lane < 32) { f32x4 o = (f32x4){0.f, 0.f, 0.f, 0.f};
#pragma unroll
            for (int w = 0; w < 8; ++w) o += *(const LAS f32x4*)(red2 + w * 128 + 4 * c4);
            *(f32x4*)(OG + (row0 + t) * 512 + 128 * h + 4 * c4) = o; }
    }
    float* so = a.out + O_SS + ((size_t)item * 128 + r0) * 128 + 4 * c4;
#pragma unroll
    for (int i = 0; i < 8; ++i) *(f32x4*)(so + (size_t)i * 128) = S[i];
}

__device__ __forceinline__ void attn_sample(const Args& a, LAS unsigned char* lds, int tid, int lane, int wave, int item) {
    const int bd = item >> 2, h = item & 3;
    const int n = lane & 15, kg = lane >> 4, ksl = lane >> 5, c4 = lane & 31;
    const size_t row0 = (size_t)TP + 4 * bd;
    const bf16* DQ = (const bf16*)(a.ws + WS_DQ); const bf16* DK = (const bf16*)(a.ws + WS_DK); const bf16* DV = (const bf16*)(a.ws + WS_DV);
    bf16x8 qf[4];
#pragma unroll
    for (int ks = 0; ks < 4; ++ks) { v4u w = (v4u){0u, 0u, 0u, 0u};
        if (n < 8 && (ks >> 1) == (n >> 2)) { const bf16* qp = DQ + (row0 + (n & 3)) * 512 + 128 * h + 32 * ks + 4 * kg; const v2u lo = *(const v2u*)qp, hi = *(const v2u*)(qp + 16); w = (v4u){lo.x, lo.y, hi.x, hi.y}; }
        qf[ks] = __builtin_bit_cast(bf16x8, w); }
    LAS unsigned char* ps = lds + wave * 1024;
    const float NEG_INF = -__builtin_inff();
    f32x4 mrun = (f32x4){NEG_INF, NEG_INF, NEG_INF, NEG_INF}, lrun = (f32x4){0.f, 0.f, 0.f, 0.f};
    f32x4 O1[4], O2[4];
#pragma unroll
    for (int t = 0; t < 4; ++t) { O1[t] = (f32x4){0.f, 0.f, 0.f, 0.f}; O2[t] = O1[t]; }
    const float* CK = a.in[I_CK]; const float* CV = a.in[I_CV];
    f32x4 kN[8], vN[8], vC[8];
#define AS_LOAD(K_, V_, blk_) do { const int pg_ = a.pt[bd * 16 + 2 * wave + ((blk_) >> 3)]; const size_t kb_ = ((size_t)pg_ * 128 + ((blk_) & 7) * 16) * 512 + 128 * h; \
        const float* kp_ = CK + kb_ + (size_t)n * 512 + 4 * kg; const float* vp_ = CV + kb_ + (size_t)ksl * 512 + 4 * c4; \
        _Pragma("unroll") for (int ks_ = 0; ks_ < 4; ++ks_) { K_[2 * ks_] = __builtin_nontemporal_load((const f32x4*)(kp_ + 32 * ks_)); K_[2 * ks_ + 1] = __builtin_nontemporal_load((const f32x4*)(kp_ + 32 * ks_ + 16)); } \
        _Pragma("unroll") for (int kp2_ = 0; kp2_ < 8; ++kp2_) V_[kp2_] = __builtin_nontemporal_load((const f32x4*)(vp_ + (size_t)kp2_ * 1024)); } while (0)
#define AS_BLOCK(kf_, V_, NEWK) do { \
        f32x4 sc_ = (f32x4){0.f, 0.f, 0.f, 0.f}; \
        _Pragma("unroll") for (int ks_ = 0; ks_ < 4; ++ks_) sc_ = MFMA16(qf[ks_], kf_[ks_], sc_); \
        if (NEWK) { _Pragma("unroll") for (int j_ = 0; j_ < 4; ++j_) if (n > j_) sc_[j_] = NEG_INF; } \
        f32x4 mn_, al_, p_; \
        _Pragma("unroll") for (int j_ = 0; j_ < 4; ++j_) { mn_[j_] = fmaxf(mrun[j_], row16_max(sc_[j_])); al_[j_] = __builtin_amdgcn_exp2f(mrun[j_] - mn_[j_]); p_[j_] = __builtin_amdgcn_exp2f(sc_[j_] - mn_[j_]); \
            lrun[j_] = lrun[j_] * al_[j_] + p_[j_]; mrun[j_] = mn_[j_]; } \
        if (kg < 2) { *(LAS f32x4*)(ps + (n * 2 + kg) * 16) = p_; if (n == 0) *(LAS f32x4*)(ps + 512 + kg * 16) = al_; } \
        LDS_WAIT(); \
        { const f32x4 a1_ = *(const LAS f32x4*)(ps + 512), a2_ = *(const LAS f32x4*)(ps + 528); \
          _Pragma("unroll") for (int t_ = 0; t_ < 4; ++t_) { O1[t_] = O1[t_] * a1_[t_]; O2[t_] = O2[t_] * a2_[t_]; } } \
        _Pragma("unroll") for (int kp_ = 0; kp_ < 8; ++kp_) { const f32x4 p1_ = *(const LAS f32x4*)(ps + ((2 * kp_ + ksl) * 2) * 16), p2_ = *(const LAS f32x4*)(ps + ((2 * kp_ + ksl) * 2 + 1) * 16); \
            _Pragma("unroll") for (int t_ = 0; t_ < 4; ++t_) { O1[t_] += V_[kp_] * p1_[t_]; O2[t_] += V_[kp_] * p2_[t_]; } \
            if (kp_ & 1) asm volatile("" ::: "memory"); } \
        LDS_WAIT(); } while (0)
    AS_LOAD(kN, vN, 0);
    for (int blk = 0; blk < 16; ++blk) {
        bf16x8 kf[4];
#pragma unroll
        for (int ks = 0; ks < 4; ++ks) kf[ks] = pack8(kN[2 * ks], kN[2 * ks + 1]);
#pragma unroll
        for (int kp = 0; kp < 8; ++kp) vC[kp] = vN[kp];
        if (blk + 1 < 16) AS_LOAD(kN, vN, blk + 1);
        AS_BLOCK(kf, vC, false);
    }
    if (wave == 0) {
        bf16x8 kf[4];
#pragma unroll
        for (int ks = 0; ks < 4; ++ks) { v4u w = (v4u){0u, 0u, 0u, 0u};
            if (n < 4) { const bf16* kp = DK + (row0 + n) * 512 + 128 * h + 32 * ks + 4 * kg; const v2u lo = *(const v2u*)kp, hi = *(const v2u*)(kp + 16); w = (v4u){lo.x, lo.y, hi.x, hi.y}; }
            kf[ks] = __builtin_bit_cast(bf16x8, w); }
#pragma unroll
        for (int kp = 0; kp < 8; ++kp) { vC[kp] = (f32x4){0.f, 0.f, 0.f, 0.f};
            if (kp < 2) { const v2u w = *(const v2u*)(DV + (row0 + 2 * kp + ksl) * 512 + 128 * h + 4 * c4); vC[kp] = (f32x4){bflo(w.x), bfhi(w.x), bflo(w.y), bfhi(w.y)}; } }
        AS_BLOCK(kf, vC, true);
    }
#undef AS_LOAD
#undef AS_BLOCK
    LAS float* st = (LAS float*)(lds + 8192) + wave * 16;
    f32x4 ls;
#pragma unroll
    for (int j = 0; j < 4; ++j) ls[j] = row16_sum(lrun[j]);
    if (kg < 2 && n == 0) { *(LAS f32x4*)(st + kg * 4) = mrun; *(LAS f32x4*)(st + 8 + kg * 4) = ls; }
    LAS float* ob = (LAS float*)(lds + 16384) + (size_t)(wave * 2 + ksl) * 1024;
#pragma unroll
    for (int t = 0; t < 4; ++t) { *(LAS f32x4*)(ob + t * 128 + 4 * c4) = O1[t]; *(LAS f32x4*)(ob + (4 + t) * 128 + 4 * c4) = O2[t]; }
    __syncthreads();
    { const int ct = tid >> 6, col = 2 * (tid & 63); const LAS float* sta = (const LAS float*)(lds + 8192);
        float M = NEG_INF;
#pragma unroll
        for (int w = 0; w < 8; ++w) M = fmaxf(M, sta[w * 16 + ct]);
        float L = 0.f, x0 = 0.f, x1 = 0.f;
#pragma unroll
        for (int w = 0; w < 8; ++w) { const float f = __builtin_amdgcn_exp2f(sta[w * 16 + ct] - M); L += sta[w * 16 + 8 + ct] * f;
            const LAS float* o0 = (const LAS float*)(lds + 16384) + (size_t)(w * 2) * 1024 + ct * 128 + col;
            x0 += f * (o0[0] + o0[1024]); x1 += f * (o0[1] + o0[1025]); }
        const float inv = 1.0f / L;
        bf16* dst = (bf16*)(a.ws + ((ct >> 2) ? WS_O2 : WS_O1)) + (row0 + (ct & 3)) * 512 + 128 * h + col;
        *(unsigned*)dst = pk2(x0 * inv, x1 * inv); }
}
__device__ __forceinline__ void p4_combine(const Args& a, int lane, int wave, int vcu, int G) {
    const int gw = vcu * NWAVES + wave, NGW = G * NWAVES;
    const float s1 = wave_sum(a.in[I_LQ1][lane] * a.in[I_LK1][lane]), s2 = wave_sum(a.in[I_LQ2][lane] * a.in[I_LK2][lane]);
    const float lam = __expf(s1) - __expf(s2) + 0.2f;
    const int hc = (8 * lane) & 127;
    const f32x4 gn0 = *(const f32x4*)(a.in[I_GNG] + hc), gn1 = *(const f32x4*)(a.in[I_GNG] + hc + 4), sg0 = *(const f32x4*)(a.in[I_SUBG] + hc), sg1 = *(const f32x4*)(a.in[I_SUBG] + hc + 4);
    const float* OG = (const float*)(a.ws + WS_OG); const bf16* ZB = (const bf16*)(a.ws + WS_ZB); const bf16* O1 = (const bf16*)(a.ws + WS_O1); const bf16* O2 = (const bf16*)(a.ws + WS_O2);
    bf16* AO = (bf16*)(a.ws + WS_AO);
    for (int row = gw; row < MT; row += NGW) {
        const f32x4 g0 = *(const f32x4*)(OG + (size_t)row * 512 + 8 * lane), g1 = *(const f32x4*)(OG + (size_t)row * 512 + 8 * lane + 4);
        const v4u zw = *(const v4u*)(ZB + (size_t)row * 512 + 8 * lane), w1 = *(const v4u*)(O1 + (size_t)row * 512 + 8 * lane), w2 = *(const v4u*)(O2 + (size_t)row * 512 + 8 * lane);
        float ss = (g0[0] * g0[0] + g0[1] * g0[1]) + (g0[2] * g0[2] + g0[3] * g0[3]) + (g1[0] * g1[0] + g1[1] * g1[1]) + (g1[2] * g1[2] + g1[3] * g1[3]);
        ss = row16_sum(ss);
        const float rs = 1.0f / sqrtf(ss * (1.0f / 128.0f) + EPS);
        const float z[8] = {bflo(zw.x), bfhi(zw.x), bflo(zw.y), bfhi(zw.y), bflo(zw.z), bfhi(zw.z), bflo(zw.w), bfhi(zw.w)};
        float og[8];
#pragma unroll
        for (int e = 0; e < 4; ++e) { og[e] = g0[e] * rs * gn0[e]; og[4 + e] = g1[e] * rs * gn1[e]; }
#pragma unroll
        for (int e = 0; e < 8; ++e) og[e] *= z[e] / (1.0f + __expf(-z[e]));
        *(GAS v4u*)(AO + (size_t)row * 1024 + 8 * lane) = (v4u){pk2(og[0], og[1]), pk2(og[2], og[3]), pk2(og[4], og[5]), pk2(og[6], og[7])};
        const float p1[8] = {bflo(w1.x), bfhi(w1.x), bflo(w1.y), bfhi(w1.y), bflo(w1.z), bfhi(w1.z), bflo(w1.w), bfhi(w1.w)};
        const float p2[8] = {bflo(w2.x), bfhi(w2.x), bflo(w2.y), bfhi(w2.y), bflo(w2.z), bfhi(w2.z), bflo(w2.w), bfhi(w2.w)};
        float d[8]; float sd = 0.f;
#pragma unroll
        for (int e = 0; e < 8; ++e) { d[e] = p1[e] - lam * p2[e]; sd += d[e] * d[e]; }
        sd = row16_sum(sd);
        const float rd = (1.0f / sqrtf(sd * (1.0f / 128.0f) + EPS)) * 0.8f;
#pragma unroll
        for (int e = 0; e < 4; ++e) { d[e] *= rd * sg0[e]; d[4 + e] *= rd * sg1[e]; }
        *(GAS v4u*)(AO + (size_t)row * 1024 + 512 + 8 * lane) = (v4u){pk2(d[0], d[1]), pk2(d[2], d[3]), pk2(d[4], d[5]), pk2(d[6], d[7])};
    }
}

__device__ __forceinline__ float gate_mix(float yg, float yv) { return yg / (1.0f + __expf(-yg)) * yv; }
__device__ __forceinline__ void p7_fixup(const Args& a, int tid, int vcu, int G) {
    const float* cw = a.in[I_FCW]; const float* cb = a.in[I_FCB];
    const float* BND = (const float*)(a.ws + WS_BND); const float* US = (const float*)(a.ws + WS_US); bf16* A2 = (bf16*)(a.ws + WS_A2);
    const size_t gt = (size_t)vcu * 512 + tid, NT = (size_t)G * 512;
    for (size_t i = gt; i < (size_t)256 * FF; i += NT) { const int blk = (int)(i / FF), c = (int)(i % FF);
        float ug[4], uv[4];
        const bool first = (blk & 63) == 0;
        ug[0] = first ? 0.f : BND[((size_t)(blk - 1) * 4 + 2) * FF2 + c]; ug[1] = first ? 0.f : BND[((size_t)(blk - 1) * 4 + 3) * FF2 + c];
        uv[0] = first ? 0.f : BND[((size_t)(blk - 1) * 4 + 2) * FF2 + FF + c]; uv[1] = first ? 0.f : BND[((size_t)(blk - 1) * 4 + 3) * FF2 + FF + c];
        ug[2] = BND[((size_t)blk * 4 + 0) * FF2 + c]; ug[3] = BND[((size_t)blk * 4 + 1) * FF2 + c]; uv[2] = BND[((size_t)blk * 4 + 0) * FF2 + FF + c]; uv[3] = BND[((size_t)blk * 4 + 1) * FF2 + FF + c];
        const float g0 = cw[c], g1 = cw[FF2 + c], g2 = cw[2 * FF2 + c], gb = cb[c], v0 = cw[FF + c], v1 = cw[FF2 + FF + c], v2 = cw[2 * FF2 + FF + c], vb = cb[FF + c];
#pragma unroll
        for (int r = 0; r < 2; ++r) { const float yg = g0 * ug[r] + g1 * ug[r + 1] + g2 * ug[r + 2] + gb, yv = v0 * uv[r] + v1 * uv[r + 1] + v2 * uv[r + 2] + vb;
            A2[((size_t)blk * 64 + r) * FF + c] = (bf16)f2bf(gate_mix(yg, yv)); } }
    const float* stf = a.in[I_FCONV];
    for (size_t i = gt; i < (size_t)128 * FF; i += NT) { const int bd = (int)(i / FF), c = (int)(i % FF);
        float ug[6], uv[6];
        ug[0] = stf[((size_t)bd * 2 + 0) * FF2 + c]; ug[1] = stf[((size_t)bd * 2 + 1) * FF2 + c]; uv[0] = stf[((size_t)bd * 2 + 0) * FF2 + FF + c]; uv[1] = stf[((size_t)bd * 2 + 1) * FF2 + FF + c];
#pragma unroll
        for (int t = 0; t < 4; ++t) { ug[2 + t] = US[((size_t)bd * 4 + t) * FF2 + c]; uv[2 + t] = US[((size_t)bd * 4 + t) * FF2 + FF + c]; }
        const float g0 = cw[c], g1 = cw[FF2 + c], g2 = cw[2 * FF2 + c], gb = cb[c], v0 = cw[FF + c], v1 = cw[FF2 + FF + c], v2 = cw[2 * FF2 + FF + c], vb = cb[FF + c];
#pragma unroll
        for (int t = 0; t < 4; ++t) { const float yg = g0 * ug[t] + g1 * ug[t + 1] + g2 * ug[t + 2] + gb, yv = v0 * uv[t] + v1 * uv[t + 1] + v2 * uv[t + 2] + vb;
            A2[((size_t)TP + bd * 4 + t) * FF + c] = (bf16)f2bf(gate_mix(yg, yv)); } }
    for (size_t i = gt; i < (size_t)4 * 2 * FF2; i += NT) { const int b = (int)(i / (2 * FF2)), j = (int)((i / FF2) & 1), c = (int)(i % FF2);
        a.out[O_FCP + i] = BND[((size_t)(64 * b + 63) * 4 + 2 + j) * FF2 + c]; }
    for (size_t i = gt; i < (size_t)128 * 2 * FF2; i += NT) { const int bd = (int)(i / (2 * FF2)), j = (int)((i / FF2) & 1), c = (int)(i % FF2);
        a.out[O_FCS + i] = US[((size_t)bd * 4 + 2 + j) * FF2 + c]; }
}
constexpr int N_PHASES = 9;
constexpr int Q_CHAIN = 16, Q_GS = 512, Q_AS = 512, Q_AP = 1024, Q_TOTAL = Q_CHAIN + Q_GS + Q_AS + Q_AP;
__global__ void __launch_bounds__(NWAVES * 64, 2) mega_fwd(Args args) {
    extern __shared__ __attribute__((aligned(16))) unsigned char lds_raw[];
    LAS unsigned char* lds = (LAS unsigned char*)lds_raw;
    volatile LAS unsigned* MISC = (volatile LAS unsigned*)(lds + MISC_OFF);
    const int tid = threadIdx.x, lane = tid & 63, wave = __builtin_amdgcn_readfirstlane(tid >> 6);
    const int G = gridDim.x; const int bx = blockIdx.x; const int vcu = (G % 8 == 0) ? (bx % 8) * (G / 8) + bx / 8 : bx;
    gu32* ctl = (gu32*)(args.ws + WS_CTL);
    for (int u = tid; u < (LDS_BYTES - LDSCTL_OFF) / 4; u += NWAVES * 64) ((LAS unsigned*)(lds + LDSCTL_OFF))[u] = 0u;
    __syncthreads();
    XcdBarrier bar; bar.bar = (unsigned*)(ctl + CW_BAR); bar.x = 0; bar.st = nullptr;
    if (args.use_bar) bar = xcd_barrier_post((unsigned*)(ctl + CW_BAR), MISC + 8);
    const int lo = args.ph_lo, hi = args.ph_hi;
#ifdef ONLY_PHASE
#define IN(k) ((k) == ONLY_PHASE && lo <= (k) && (k) < hi)
#else
#define IN(k) (lo <= (k) && (k) < hi)
#endif
#define SEAM(k) do { if (IN(k) && IN((k) + 1)) xcd_barrier(bar); } while (0)

    if (IN(0)) { p0_prologue(args, lds, lane, wave, vcu, G); }
    SEAM(0);
    if (IN(1)) {
        pg8::Gemm g{(const bf16*)(args.ws + WS_XN), (const bf16*)(args.ws + WS_WIN), MT, NIN, 1024, 1024, 1024}; pg8::StaticOrder S; S.init(MT, NIN, G, bx);
        pg8::EpiIn E{args.ws, args.out, args.in[I_QNG], (long)(args.in[I_KNG] - args.in[I_QNG])};
        pg8::gemm_phase<pg8::EpiIn, pg8::StaticOrder, true, true>(lds, g, S, E);
    }
    SEAM(1);
    if (IN(2)) { gdn_prep(args, lds, tid, wave, vcu, G); }
    SEAM(2);
    if (IN(3)) {
        for (;;) {
            if (tid == 0) MISC[0] = __hip_atomic_fetch_add((unsigned*)(ctl + CW_Q), 1u, __ATOMIC_RELAXED, __HIP_MEMORY_SCOPE_AGENT);
            __syncthreads();
            const int item = (int)MISC[0];
            __syncthreads();
            if (item >= Q_TOTAL) break;
            int tq = threadIdx.x; asm volatile("" : "+v"(tq));
            const int lq = tq & 63;
#ifndef ONLY_ITEM
#define ONLY_ITEM -1
#endif
            if (item < Q_CHAIN) { if (ONLY_ITEM < 0 || ONLY_ITEM == 0) gdn_chain(args, lds, lq, wave, item); }
            else if (item < Q_CHAIN + Q_GS) { if (ONLY_ITEM < 0 || ONLY_ITEM == 1) gdn_sample(args, lds, tq, lq, wave, item - Q_CHAIN); }
            else { const int i2 = item - (Q_CHAIN + Q_GS), g3 = i2 / 3, r3 = i2 % 3;
                if (r3 == 0) { if (ONLY_ITEM < 0 || ONLY_ITEM == 2) attn_sample(args, lds, tq, lq, wave, g3); }
                else if (ONLY_ITEM < 0 || ONLY_ITEM == 3) { const int j = 2 * g3 + r3 - 1, qb = 15 - (j >> 6), r = j & 63, b = r >> 4, hh = (r >> 2) & 3, c = (r >> 1) & 1, vh = r & 1;
                    const size_t base = (size_t)b * 4096 * 512 + hh * 128;
                    const attn_body::bf16* Qb = (const attn_body::bf16*)(args.ws + WS_DQ) + base + c * 64; const attn_body::bf16* Kh = (const attn_body::bf16*)(args.ws + WS_DK) + base + c * 64;
                    const attn_body::bf16* Vh = (const attn_body::bf16*)(args.ws + WS_DV) + base + vh * 64; attn_body::bf16* Ob = (attn_body::bf16*)(args.ws + (c ? WS_O2 : WS_O1)) + base + vh * 64;
                    attn_body::attn_unit<8>(tq, qb, Qb, Kh, Vh, Ob, (char*)lds_raw); } }
            VM_WAIT();
        }
    }
    SEAM(3);
    if (IN(4)) { p4_combine(args, lane, wave, vcu, G); }
    SEAM(4);
    if (IN(5)) {
        pg8::Gemm g{(const bf16*)(args.ws + WS_AO), (const bf16*)(args.ws + WS_WOUT), MT, 1024, 1024, 1024, 1024}; pg8::StaticOrder S; S.init(MT, 1024, G, bx);
        pg8::EpiOut E{args.in[I_XP], args.in[I_XS], args.out + O_Y, (bf16*)(args.ws + WS_HB), (float*)(ctl + CW_ROWSS)};
        pg8::gemm_phase<pg8::EpiOut, pg8::StaticOrder, true, true>(lds, g, S, E);
    }
    SEAM(5);
    if (IN(6)) {
        pg8::Gemm g{(const bf16*)(args.ws + WS_HB), (const bf16*)(args.ws + WS_WUP), MT, FF2, 1024, 1024, 1024}; pg8::StaticOrder S; S.init(MT, FF2, G, bx);
        pg8::EpiUp E{(bf16*)(args.ws + WS_A2), (float*)(args.ws + WS_BND), (float*)(args.ws + WS_US), (const float*)(ctl + CW_ROWSS), (const float*)(args.ws + WS_CWP)};
        pg8::gemm_phase<pg8::EpiUp, pg8::StaticOrder, true, true>(lds, g, S, E);
    }
    SEAM(6);
    if (IN(7)) { p7_fixup(args, tid, vcu, G); }
    SEAM(7);
    if (IN(8)) {
        pg8::Gemm g{(const bf16*)(args.ws + WS_A2), (const bf16*)(args.ws + WS_WDN), MT, 1024, FF, FF, FF}; pg8::StaticOrder S; S.init(MT, 1024, G, bx);
        pg8::EpiDown E{args.out + O_Y};
        pg8::gemm_phase<pg8::EpiDown, pg8::StaticOrder, true, true>(lds, g, S, E);
    }
#undef IN
#undef SEAM
}

#ifndef MK_N_LAUNCHES
#define MK_N_LAUNCHES 1
#endif
extern "C" void kernel_launch(void* const* d_in, const int* in_sizes, int n_in, void* d_out, int out_size, void* d_ws, size_t ws_size, hipStream_t stream) {
    static int grid = 0;
    if (grid == 0) {
        if (n_in != 27 || out_size != (int)O_END || ws_size < WS_END) { fprintf(stderr, "kernel_launch: unexpected shapes (n_in %d, out %d, ws %zu); nothing launched\n", n_in, out_size, ws_size); grid = -1; return; }
        int dev = 0, cus = 0, per_cu = 0;
        if (hipGetDevice(&dev) != hipSuccess || hipDeviceGetAttribute(&cus, hipDeviceAttributeMultiprocessorCount, dev) != hipSuccess) { grid = -1; return; }
        if (hipFuncSetAttribute((const void*)mega_fwd, hipFuncAttributeMaxDynamicSharedMemorySize, LDS_BYTES) != hipSuccess) { fprintf(stderr, "kernel_launch: hipFuncSetAttribute failed\n"); grid = -1; return; }
        if (hipOccupancyMaxActiveBlocksPerMultiprocessor(&per_cu, (const void*)mega_fwd, NWAVES * 64, LDS_BYTES) != hipSuccess || per_cu < 1) { fprintf(stderr, "kernel_launch: occupancy query says %d blocks per CU\n", per_cu); }
        (void)hipGetLastError();
        grid = cus;
    }
    if (grid < 0) return;
    if (hipMemsetAsync((char*)d_ws + WS_CTL, 0, CTL_ZERO_BYTES, stream) != hipSuccess) return;
    Args a{};
    for (int i = 0; i < 27; ++i) a.in[i] = (const float*)d_in[i];
    a.pt = (const int*)d_in[I_PT]; a.out = (float*)d_out; a.ws = (unsigned char*)d_ws;
    constexpr int NL = MK_N_LAUNCHES;
    for (int li = 0; li < NL; ++li) {
        a.ph_lo = (NL == 1) ? 0 : li; a.ph_hi = (NL == 1) ? N_PHASES : li + 1; a.use_bar = (NL == 1) ? 1 : 0; a.pad = 0;
        hipLaunchKernelGGL(mega_fwd, dim3(grid), dim3(NWAVES * 64), LDS_BYTES, stream, a);
    }
}
```

```cpp
#include <hip/hip_runtime.h>
#include <cstdio>
#include <cstdint>
constexpr int DMODEL = 1024;
constexpr int TP = 16384, TSM = 512, MT = TP + TSM;
constexpr int NIN = 3584, INC = 3592, FF = 2816, FF2 = 5632;
constexpr float EPS = 1e-6f;
constexpr float C2 = 0.125f * 1.4426950408889634f;
constexpr size_t O_Y = 0, O_GCP = 17301504, O_SP = 17319936, O_KP = 17582080, O_VP = 25970688, O_FCP = 34359296, O_GCS = 34404352, O_SS = 34994176, O_KS = 43382784, O_VS = 43644928, O_FCS = 43907072, O_END = 45348864;
constexpr size_t MiB = 1u << 20;
constexpr size_t WS_CTL = 0, CTL_ZERO_BYTES = 1 * MiB;
constexpr size_t WS_WIN = 2 * MiB, WS_WOUT = 10 * MiB, WS_WUP = 12 * MiB, WS_WDN = 24 * MiB;
constexpr size_t WS_CWP = 30 * MiB;
constexpr size_t WS_XN = 32 * MiB, WS_GQKV = 66 * MiB, WS_ZB = 116 * MiB, WS_DQ = 134 * MiB, WS_DK = 151 * MiB, WS_DV = 168 * MiB, WS_BA = 186 * MiB;
constexpr size_t WS_O1 = 188 * MiB, WS_O2 = 205 * MiB, WS_OG = 222 * MiB, WS_AO = 256 * MiB, WS_HB = 290 * MiB, WS_A2 = 324 * MiB, WS_BND = 416 * MiB, WS_US = 440 * MiB, WS_GCH = 452 * MiB, WS_END = 548 * MiB;
constexpr size_t GCH_STRIDE = 98304;
constexpr int CW_TMO = 0, CW_CODE = 1, CW_Q = 64, CW_BAR = 4096, CW_ROWSS = 32768;
namespace pg8 {
#define PG8_LAS __attribute__((address_space(3)))
typedef unsigned short bf16_t;
typedef short bf16x8 __attribute__((ext_vector_type(8)));
typedef float f32x4 __attribute__((ext_vector_type(4)));
typedef unsigned u32x4 __attribute__((ext_vector_type(4)));
constexpr int BM = 256, BK = 64, HALF = 128, HTB = HALF * BK * 2  , STAGE_BYTES = 8 * HTB, NXCD = 8, WGM = 8;

__host__ __device__ __forceinline__ int lds_byte(int r, int c) { const int st = (r >> 4) * 2 + (c >> 5), rr = r & 15, cc = c & 31, ob = rr * 64 + cc * 2; return st * 1024 + (ob ^ (((ob >> 9) & 1) << 5)); }
__host__ __device__ __forceinline__ void stage_rc(int b, int& R, int& C) { const int st = b / 1024, sb = b % 1024, swz = sb ^ (((sb >> 9) & 1) << 5); R = (st >> 1) * 16 + swz / 64; C = (st & 1) * 32 + (swz % 64) / 2; }
__host__ __device__ __forceinline__ int perm32(int rho) { const int n = rho >> 4, i = rho & 15; return 8 * (i >> 2) + 4 * n + (i & 3); }

struct Unit { int pm, pn, koff, nt; };
struct Gemm { const bf16_t* A; const bf16_t* Bt; int M, N, K, lda, ldb; };

struct StaticOrder {
    int nM, nN, nwg, G, c, ntk;
    __host__ __device__ void init(int M, int N, int G_, int c_, int K_ = 1024) { nM = M / BM; nN = N / BM; nwg = nM * nN; G = G_; c = c_; ntk = K_ / BK; }
    __host__ __device__ bool next(int i, Unit& u) const {
        const long L = (long)i * G + c; if (L >= nwg) return false;
        int wgid = (int)L; { const int q = nwg / NXCD, r = nwg % NXCD, xcd = wgid % NXCD, off = wgid / NXCD; wgid = (xcd < r ? xcd * (q + 1) : r * (q + 1) + (xcd - r) * q) + off; }
        const int nig = WGM * nN, gid = wgid / nig, fm = gid * WGM, gsz = (nM - fm) < WGM ? (nM - fm) : WGM;
        u.pm = fm + ((wgid % nig) % gsz); u.pn = (wgid % nig) / gsz; u.koff = 0; u.nt = ntk; return true;
    }
    __device__ __forceinline__ void a_ready(const Unit&) const {}
    __device__ __forceinline__ void done(const Unit&) const {}
};
__device__ __forceinline__ unsigned cvt_pk_bf16(float lo, float hi) { unsigned r; asm volatile("v_cvt_pk_bf16_f32 %0, %1, %2" : "=v"(r) : "v"(lo), "v"(hi)); return r; }
typedef float f32x2 __attribute__((ext_vector_type(2)));
typedef unsigned u32x2 __attribute__((ext_vector_type(2)));
template <int CTRL> __device__ __forceinline__ float dppf(float x) { return __builtin_bit_cast(float, __builtin_amdgcn_mov_dpp(__builtin_bit_cast(int, x), CTRL, 0xf, 0xf, true)); }

struct EpiIn {
    static constexpr bool PERM = true, AFTER_DRAIN = false;
    unsigned char* ws; float* out; const float* gq; long gk_off;
    __device__ __forceinline__ void operator()(const f32x4 (&acc)[2][2][4][2], const Unit& u, int wr, int wc, int fr0, int fq0) const {
        int fr = fr0, fq = fq0; asm volatile("" : "+v"(fr), "+v"(fq));
        const int type = u.pn >> 1, cb = (u.pn & 1) * 256 + 64 * wc + 8 * fq;
        const int row0 = u.pm * BM + wr * 64 + fr;
        const bool samp = u.pm >= 64;
        if (type <= 3) {
            bf16_t* dst = (bf16_t*)(ws + ((type == 3) ? WS_ZB : WS_GQKV + 1024 * (size_t)type)); const int ld = (type == 3) ? 512 : 1536;
#pragma unroll
            for (int ai = 0; ai < 2; ++ai)
#pragma unroll
                for (int m = 0; m < 4; ++m) { const int row = row0 + ai * HALF + m * 16;
#pragma unroll
                    for (int bj = 0; bj < 2; ++bj) { const f32x4 v0 = acc[ai][bj][m][0], v1 = acc[ai][bj][m][1];
                        u32x4 w; w.x = cvt_pk_bf16(v0[0], v0[1]); w.y = cvt_pk_bf16(v0[2], v0[3]); w.z = cvt_pk_bf16(v1[0], v1[1]); w.w = cvt_pk_bf16(v1[2], v1[3]);
                        *(u32x4*)(dst + (size_t)row * ld + cb + 32 * bj) = w;
                        if (type < 3) {
                            float* cs = nullptr;
                            if (samp) { const int r = row - TP, t = r & 3; if (t >= 1) cs = out + O_GCS + ((size_t)(r >> 2) * 3 + (t - 1)) * 1536; }
                            else { const int t = row & 4095; if (t >= 4093) cs = out + O_GCP + ((size_t)(row >> 12) * 3 + (t - 4093)) * 1536; }
                            if (cs) { float* p = cs + 512 * type + cb + 32 * bj; *(f32x4*)p = v0; *(f32x4*)(p + 4) = v1; }
                        } } }
            return;
        }
        const size_t ooff = (type == 5) ? (samp ? O_KS - (size_t)TP * 512 : O_KP) : (samp ? O_VS - (size_t)TP * 512 : O_VP);
        float* ob = (type == 4) ? nullptr : out + ooff;
        bf16_t* bd = (bf16_t*)(ws + WS_DQ + (size_t)(type - 4) * (WS_DK - WS_DQ));
        f32x4 gv[2][2];
#pragma unroll
        for (int bj = 0; bj < 2; ++bj)
#pragma unroll
            for (int n = 0; n < 2; ++n) { const float* gp = gq + ((type == 5) ? gk_off : 0); gv[bj][n] = (type == 6) ? (f32x4){1.f, 1.f, 1.f, 1.f} : *(const f32x4*)(gp + 32 * bj + 8 * fq + 4 * n); }
#pragma unroll
        for (int ai = 0; ai < 2; ++ai)
#pragma unroll
            for (int m = 0; m < 4; ++m) { const int row = row0 + ai * HALF + m * 16;
                float rs = 1.f;
                if (type != 6) { float ss = 0.f;
#pragma unroll
                    for (int bj = 0; bj < 2; ++bj)
#pragma unroll
                        for (int n = 0; n < 2; ++n) { const f32x4 x = acc[ai][bj][m][n]; ss += (x[0] * x[0] + x[1] * x[1]) + (x[2] * x[2] + x[3] * x[3]); }
                    ss += __shfl_xor(ss, 16); ss += __shfl_xor(ss, 32);
                    rs = 1.0f / sqrtf(ss * (1.0f / 64.0f) + EPS); if (type == 4) rs *= C2; }
#pragma unroll
                for (int bj = 0; bj < 2; ++bj) { const f32x4 v0 = acc[ai][bj][m][0] * rs * gv[bj][0], v1 = acc[ai][bj][m][1] * rs * gv[bj][1];
                    u32x4 w; w.x = cvt_pk_bf16(v0[0], v0[1]); w.y = cvt_pk_bf16(v0[2], v0[3]); w.z = cvt_pk_bf16(v1[0], v1[1]); w.w = cvt_pk_bf16(v1[2], v1[3]);
                    *(u32x4*)(bd + (size_t)row * 512 + cb + 32 * bj) = w;
                    if (ob) { float* p = ob + (size_t)row * 512 + cb + 32 * bj; *(f32x4*)p = v0; *(f32x4*)(p + 4) = v1; } } }
    }
};

struct EpiOut {
    static constexpr bool PERM = true, AFTER_DRAIN = false;
    const float* xp; const float* xs; float* y; bf16_t* hb; float* rowss;
    __device__ __forceinline__ void operator()(const f32x4 (&acc)[2][2][4][2], const Unit& u, int wr, int wc, int fr0, int fq0) const {
        int fr = fr0, fq = fq0; asm volatile("" : "+v"(fr), "+v"(fq));
        const int row0 = u.pm * BM + wr * 64 + fr, col0 = u.pn * BM + wc * 32 + 8 * fq;
        const float* xb = (u.pm >= 64) ? xs - (size_t)TP * 1024 : xp;
#pragma unroll
        for (int ai = 0; ai < 2; ++ai)
#pragma unroll
            for (int m = 0; m < 4; ++m) { const int row = row0 + ai * HALF + m * 16; const size_t off = (size_t)row * 1024 + col0; float ss = 0.f;
#pragma unroll
                for (int bj = 0; bj < 2; ++bj) { const f32x4 x0 = *(const f32x4*)(xb + off + bj * HALF), x1 = *(const f32x4*)(xb + off + bj * HALF + 4);
                    const f32x4 v0 = acc[ai][bj][m][0] + x0, v1 = acc[ai][bj][m][1] + x1;
                    *(f32x4*)(y + off + bj * HALF) = v0; *(f32x4*)(y + off + bj * HALF + 4) = v1;
                    u32x4 w; w.x = cvt_pk_bf16(v0[0], v0[1]); w.y = cvt_pk_bf16(v0[2], v0[3]); w.z = cvt_pk_bf16(v1[0], v1[1]); w.w = cvt_pk_bf16(v1[2], v1[3]);
                    *(u32x4*)(hb + off + bj * HALF) = w;
                    ss += (v0[0] * v0[0] + v0[1] * v0[1]) + (v0[2] * v0[2] + v0[3] * v0[3]) + (v1[0] * v1[0] + v1[1] * v1[1]) + (v1[2] * v1[2] + v1[3] * v1[3]); }
                ss += __shfl_xor(ss, 16); ss += __shfl_xor(ss, 32);
                if (fq == 0) atomicAdd(rowss + row, ss); }
    }
};

struct EpiUp {
    static constexpr bool PERM = true, AFTER_DRAIN = false;
    bf16_t* a2; float* bnd; float* us; const float* rowss; const float* cwp;
    __device__ __forceinline__ void operator()(const f32x4 (&acc)[2][2][4][2], const Unit& u, int wr, int wc, int fr0, int fq0) const {
        int fr = fr0, fq = fq0; asm volatile("" : "+v"(fr), "+v"(fq));
        const int gc0 = 128 * u.pn + 32 * wc + 8 * fq;
        if (u.pm >= 64) {
#pragma unroll
            for (int ai = 0; ai < 2; ++ai)
#pragma unroll
                for (int m = 0; m < 4; ++m) { const int row = u.pm * BM + ai * HALF + wr * 64 + m * 16 + fr; const float rs = 1.0f / sqrtf(rowss[row] * (1.0f / 1024.0f) + EPS);
                    float* dst = us + (size_t)(row - TP) * FF2 + gc0;
#pragma unroll
                    for (int bj = 0; bj < 2; ++bj)
#pragma unroll
                        for (int n = 0; n < 2; ++n) *(f32x4*)(dst + bj * FF + 4 * n) = acc[ai][bj][m][n] * rs; }
            return;
        }
#pragma unroll
        for (int ai = 0; ai < 2; ++ai) {
            const int rowb = u.pm * BM + ai * HALF + wr * 64, blk = rowb >> 6;
            float rs[4];
#pragma unroll
            for (int m = 0; m < 4; ++m) rs[m] = 1.0f / sqrtf(rowss[rowb + 16 * m + fr] * (1.0f / 1024.0f) + EPS);
            if (fr < 2) {
#pragma unroll
                for (int n = 0; n < 2; ++n) { float* p = bnd + ((size_t)blk * 4 + fr) * FF2 + gc0 + 4 * n; *(f32x4*)p = acc[ai][0][0][n] * rs[0]; *(f32x4*)(p + FF) = acc[ai][1][0][n] * rs[0]; } }
            if (fr >= 14) {
#pragma unroll
                for (int n = 0; n < 2; ++n) { float* p = bnd + ((size_t)blk * 4 + 2 + (fr - 14)) * FF2 + gc0 + 4 * n; *(f32x4*)p = acc[ai][0][3][n] * rs[3]; *(f32x4*)(p + FF) = acc[ai][1][3][n] * rs[3]; } }
            float res[4][8];
#pragma unroll
            for (int n = 0; n < 2; ++n)
#pragma unroll
                for (int eh = 0; eh < 2; ++eh) {
                    const float* wp = cwp + (size_t)gc0 * 8 + (4 * n + 2 * eh) * 8;
                    const f32x4 wa0 = *(const f32x4*)wp, wa1 = *(const f32x4*)(wp + 4), wb0 = *(const f32x4*)(wp + 8), wb1 = *(const f32x4*)(wp + 12);
                    const float g0[2] = {wa0[0], wb0[0]}, g1[2] = {wa0[1], wb0[1]}, g2[2] = {wa0[2], wb0[2]}, gb[2] = {wa0[3], wb0[3]};
                    const float v0[2] = {wa1[0], wb1[0]}, v1[2] = {wa1[1], wb1[1]}, v2[2] = {wa1[2], wb1[2]}, vb[2] = {wa1[3], wb1[3]};
                    float pg[2] = {0.f, 0.f}, pv[2] = {0.f, 0.f};
#pragma unroll
                    for (int m = 0; m < 4; ++m)
#pragma unroll
                        for (int e = 0; e < 2; ++e) { const float ug = acc[ai][0][m][n][2 * eh + e] * rs[m], uv = acc[ai][1][m][n][2 * eh + e] * rs[m];
                            const float a1 = dppf<0x121>(ug), a1p = dppf<0x121>(pg[e]), a2_ = dppf<0x122>(ug), a2p = dppf<0x122>(pg[e]);
                            const float b1 = dppf<0x121>(uv), b1p = dppf<0x121>(pv[e]), b2_ = dppf<0x122>(uv), b2p = dppf<0x122>(pv[e]);
                            const float yg = g0[e] * ((fr < 2) ? a2p : a2_) + g1[e] * ((fr == 0) ? a1p : a1) + g2[e] * ug + gb[e];
                            const float yv = v0[e] * ((fr < 2) ? b2p : b2_) + v1[e] * ((fr == 0) ? b1p : b1) + v2[e] * uv + vb[e];
                            float rr = yg * __builtin_amdgcn_rcpf(1.0f + __expf(-yg)) * yv; asm volatile("" : "+v"(rr));
                            res[m][4 * n + 2 * eh + e] = rr; pg[e] = ug; pv[e] = uv; }
                }
#pragma unroll
            for (int m = 0; m < 4; ++m) if (!(m == 0 && fr < 2)) {
                u32x4 w; w.x = cvt_pk_bf16(res[m][0], res[m][1]); w.y = cvt_pk_bf16(res[m][2], res[m][3]); w.z = cvt_pk_bf16(res[m][4], res[m][5]); w.w = cvt_pk_bf16(res[m][6], res[m][7]);
                *(u32x4*)(a2 + (size_t)(rowb + 16 * m + fr) * FF + gc0) = w; }
            __builtin_amdgcn_sched_barrier(0);
        }
    }
};

struct EpiDown {
    static constexpr bool PERM = true, AFTER_DRAIN = false;
    const float* yin; float* y;
    __device__ __forceinline__ void operator()(const f32x4 (&acc)[2][2][4][2], const Unit& u, int wr, int wc, int fr0, int fq0) const {
        int fr = fr0, fq = fq0; asm volatile("" : "+v"(fr), "+v"(fq));
        const int row0 = u.pm * BM + wr * 64 + fr, col0 = u.pn * BM + wc * 32 + 8 * fq;
#pragma unroll
        for (int ai = 0; ai < 2; ++ai)
#pragma unroll
            for (int m = 0; m < 4; ++m) { const size_t ro = (size_t)(row0 + ai * HALF + m * 16) * 1024 + col0;
#pragma unroll
                for (int bj = 0; bj < 2; ++bj)
#pragma unroll
                    for (int n = 0; n < 2; ++n) { const size_t o = ro + bj * HALF + 4 * n; *(f32x4*)(y + o) = *(const f32x4*)(yin + o) + acc[ai][bj][m][n]; } }
    }
};

struct DownOrder : StaticOrder {
    __device__ __forceinline__ bool next(int i, Unit& u) const { const long L = (long)i * G + c; if (L < nwg) return StaticOrder::next(i, u);
        const int l = (int)(L - nwg); if (l >= 88) return false; u.pm = 64 + l / 44; u.pn = (l / 11) & 3; u.koff = (l % 11) * 256; u.nt = 4; return true; }
};
struct EpiDown2 {
    static constexpr bool PERM = true, AFTER_DRAIN = false;
    const float* yin; float* y; float* part;
    __device__ __forceinline__ void operator()(const f32x4 (&acc)[2][2][4][2], const Unit& u, int wr, int wc, int fr0, int fq0) const {
        int fr = fr0, fq = fq0; asm volatile("" : "+v"(fr), "+v"(fq));
        const int row0 = u.pm * BM + wr * 64 + fr, col0 = u.pn * BM + wc * 32 + 8 * fq;
        const bool samp = u.pm >= 64;
        const float* src = samp ? nullptr : yin;
        float* dst = samp ? part + (size_t)(u.koff >> 8) * 512 * 1024 : y; const size_t adj = samp ? (size_t)TP * 1024 : 0;
#pragma unroll
        for (int ai = 0; ai < 2; ++ai)
#pragma unroll
            for (int m = 0; m < 4; ++m) { const size_t ro = (size_t)(row0 + ai * HALF + m * 16) * 1024 + col0;
#pragma unroll
                for (int bj = 0; bj < 2; ++bj)
#pragma unroll
                    for (int n = 0; n < 2; ++n) { const size_t o = ro + bj * HALF + 4 * n; f32x4 v = acc[ai][bj][m][n]; if (src) v += *(const f32x4*)(src + o); *(f32x4*)(dst + (o - adj)) = v; } }
    }
};

template <class Epi, class Sched, bool ALIGN_EPI = false, bool SP2 = false>
__device__ __forceinline__ void gemm_phase(PG8_LAS unsigned char* lds, const Gemm g, const Sched& S, const Epi& E) {
    const int tid = threadIdx.x, wid = __builtin_amdgcn_readfirstlane(tid >> 6), lane = tid & 63, wr = wid >> 2, wc = wid & 3, fr = lane & 15, fq = lane >> 4;
    const int K = g.K, nt = K / BK;
    unsigned voffA[2], voffB[2];
#pragma unroll
    for (int i = 0; i < 2; ++i) { int R, C; stage_rc(tid * 16 + i * 8192, R, C); const int Rb = Epi::PERM ? ((R & ~31) + perm32(R & 31)) : R;
        voffA[i] = (unsigned)(R * g.lda + C) * 2u; voffB[i] = (unsigned)(Rb * g.ldb + C) * 2u; }
    const size_t kstep = (size_t)(BK * 2);
    const size_t hstepA = (size_t)HALF * g.lda * 2, hstepB = (size_t)HALF * g.ldb * 2;
    const size_t tstepA = 2 * hstepA, tstepB = 2 * hstepB;
    const unsigned ldsw = (unsigned)wid * 1024u;
    const int aoff = lds_byte(wr * 64 + fr, fq * 8), boff = lds_byte(wc * 32 + fr, fq * 8);
#define PG8_SA(b, h) (((b) * 2 + (h)) * HTB)
#define PG8_SB(b, h) ((4 + (b) * 2 + (h)) * HTB)
#define PG8_STAGE(bufoff, gbase, voff) do { _Pragma("unroll") for (int _i = 0; _i < 2; ++_i) \
        __builtin_amdgcn_global_load_lds((const unsigned*)((const char*)(gbase) + (voff)[_i]), (PG8_LAS unsigned*)(lds + (bufoff) + ldsw + _i * 8192), 16, 0, 0); } while (0)
#define PG8_LDA(dst, b, h) do { _Pragma("unroll") for (int m = 0; m < 4; ++m) _Pragma("unroll") for (int k = 0; k < 2; ++k) dst[m][k] = *(const PG8_LAS bf16x8*)(lds + PG8_SA(b, h) + aoff + m * 2048 + k * 1024); } while (0)
#define PG8_LDB(dst, b, h) do { _Pragma("unroll") for (int n = 0; n < 2; ++n) _Pragma("unroll") for (int k = 0; k < 2; ++k) dst[n][k] = *(const PG8_LAS bf16x8*)(lds + PG8_SB(b, h) + boff + n * 2048 + k * 1024); } while (0)
#define PG8_MMA(ai, bj, At, Bt) do { __builtin_amdgcn_s_setprio(1); _Pragma("unroll") for (int m = 0; m < 4; ++m) _Pragma("unroll") for (int n = 0; n < 2; ++n) _Pragma("unroll") for (int k = 0; k < 2; ++k) \
        acc[ai][bj][m][n] = __builtin_amdgcn_mfma_f32_16x16x32_bf16(Bt[n][k], At[m][k], acc[ai][bj][m][n], 0, 0, 0); __builtin_amdgcn_s_setprio(0); } while (0)
#define PG8_WAIT_V(n) asm volatile("s_waitcnt vmcnt(" #n ")" ::: "memory")
#define PG8_WAIT_L(n) asm volatile("s_waitcnt lgkmcnt(" #n ")" ::: "memory")
#define PG8_BAR __builtin_amdgcn_s_barrier()
#define PG8_SCHED __builtin_amdgcn_sched_barrier(0)
    Unit cur, nxt; int ui = 0;
    if (!S.next(0, cur)) return;
    f32x4 acc[2][2][4][2];
#pragma unroll
    for (int a = 0; a < 2; ++a)
#pragma unroll
        for (int b = 0; b < 2; ++b)
#pragma unroll
            for (int m = 0; m < 4; ++m)
#pragma unroll
                for (int n = 0; n < 2; ++n) acc[a][b][m][n] = (f32x4){0.f, 0.f, 0.f, 0.f};
    bf16x8 At[4][2], B0[2][2], B1[2][2];
    const char* cA = (const char*)g.A + (size_t)cur.pm * tstepA + (size_t)cur.koff * 2; const char* cB = (const char*)g.Bt + (size_t)cur.pn * tstepB + (size_t)cur.koff * 2;
    S.a_ready(cur);
    if constexpr (SP2) {
        PG8_STAGE(PG8_SB(0, 0), cB, voffB); PG8_STAGE(PG8_SB(0, 1), cB + hstepB, voffB); PG8_STAGE(PG8_SA(0, 0), cA, voffA); PG8_STAGE(PG8_SA(0, 1), cA + hstepA, voffA);
        if (wr == 1) PG8_BAR;
        PG8_WAIT_V(2); PG8_BAR;
        PG8_STAGE(PG8_SB(1, 0), cB + kstep, voffB); PG8_STAGE(PG8_SA(1, 0), cA + kstep, voffA); PG8_STAGE(PG8_SB(1, 1), cB + hstepB + kstep, voffB);
        PG8_WAIT_V(6); PG8_BAR;
    } else {
        PG8_STAGE(PG8_SB(0, 0), cB, voffB); PG8_STAGE(PG8_SA(0, 0), cA, voffA); PG8_STAGE(PG8_SB(0, 1), cB + hstepB, voffB); PG8_STAGE(PG8_SA(0, 1), cA + hstepA, voffA);
        if (wr == 1) PG8_BAR;
        PG8_WAIT_V(4); PG8_BAR;
        PG8_STAGE(PG8_SB(1, 0), cB + kstep, voffB); PG8_STAGE(PG8_SA(1, 0), cA + kstep, voffA); PG8_STAGE(PG8_SB(1, 1), cB + hstepB + kstep, voffB);
        PG8_WAIT_V(6); PG8_BAR;
    }
    for (;;) {
        const bool has_next = S.next(ui + 1, nxt);
        const char* nA = has_next ? (const char*)g.A + (size_t)nxt.pm * tstepA + (size_t)nxt.koff * 2 : cA; const char* nB = has_next ? (const char*)g.Bt + (size_t)nxt.pn * tstepB + (size_t)nxt.koff * 2 : cB;
        const int ntc = cur.nt;
        for (int t = 0; t < ntc; t += 2) {
            const bool last = (t == ntc - 2);
            const char* a1 = cA + (size_t)(t + 1) * kstep;
            const char* a2 = last ? nA : cA + (size_t)(t + 2) * kstep; const char* b2 = last ? nB : cB + (size_t)(t + 2) * kstep;
            const char* a3 = a2 + kstep; const char* b3 = b2 + kstep;
            if (last && has_next) S.a_ready(nxt);
            if constexpr (SP2) {
            PG8_LDB(B0, 0, 0); PG8_LDB(B1, 0, 1); PG8_SCHED; PG8_LDA(At, 0, 0); PG8_STAGE(PG8_SA(1, 1), a1 + hstepA, voffA);
            PG8_WAIT_V(8); PG8_WAIT_L(0); PG8_BAR; PG8_MMA(0, 0, At, B0); PG8_MMA(0, 1, At, B1); PG8_BAR; PG8_SCHED;
            PG8_LDA(At, 0, 1); PG8_STAGE(PG8_SB(0, 0), b2, voffB); PG8_STAGE(PG8_SB(0, 1), b2 + hstepB, voffB); PG8_STAGE(PG8_SA(0, 0), a2, voffA);
            PG8_WAIT_V(8); PG8_WAIT_L(0); PG8_BAR; PG8_MMA(1, 0, At, B0); PG8_MMA(1, 1, At, B1); PG8_BAR; PG8_SCHED;
            PG8_LDB(B0, 1, 0); PG8_LDB(B1, 1, 1); PG8_SCHED; PG8_LDA(At, 1, 0); PG8_STAGE(PG8_SA(0, 1), a2 + hstepA, voffA);
            PG8_WAIT_V(8); PG8_WAIT_L(0); PG8_BAR; PG8_MMA(0, 0, At, B0); PG8_MMA(0, 1, At, B1); PG8_BAR; PG8_SCHED;
            PG8_LDA(At, 1, 1); PG8_STAGE(PG8_SB(1, 0), b3, voffB); PG8_STAGE(PG8_SB(1, 1), b3 + hstepB, voffB); PG8_STAGE(PG8_SA(1, 0), a3, voffA);
            PG8_WAIT_V(8); PG8_WAIT_L(0); PG8_BAR; PG8_MMA(1, 0, At, B0); PG8_MMA(1, 1, At, B1); PG8_BAR; PG8_SCHED;
            } else {
            PG8_LDB(B0, 0, 0); PG8_SCHED; PG8_LDA(At, 0, 0); PG8_STAGE(PG8_SA(1, 1), a1 + hstepA, voffA);
            PG8_WAIT_L(8); PG8_BAR; PG8_WAIT_L(0); PG8_MMA(0, 0, At, B0); PG8_BAR; PG8_SCHED;
            PG8_LDB(B1, 0, 1); PG8_STAGE(PG8_SB(0, 0), b2, voffB);
            PG8_BAR; PG8_WAIT_L(0); PG8_MMA(0, 1, At, B1); PG8_BAR;
            PG8_LDA(At, 0, 1); PG8_STAGE(PG8_SA(0, 0), a2, voffA);
            PG8_BAR; PG8_WAIT_L(0); PG8_MMA(1, 0, At, B0); PG8_BAR; PG8_SCHED;
            PG8_STAGE(PG8_SB(0, 1), b2 + hstepB, voffB);
            PG8_WAIT_V(6); PG8_BAR; PG8_MMA(1, 1, At, B1); PG8_BAR;
            PG8_LDB(B0, 1, 0); PG8_SCHED; PG8_LDA(At, 1, 0); PG8_STAGE(PG8_SA(0, 1), a2 + hstepA, voffA);
            PG8_WAIT_L(8); PG8_BAR; PG8_WAIT_L(0); PG8_MMA(0, 0, At, B0); PG8_BAR; PG8_SCHED;
            PG8_LDB(B1, 1, 1); PG8_STAGE(PG8_SB(1, 0), b3, voffB);
            PG8_BAR; PG8_WAIT_L(0); PG8_MMA(0, 1, At, B1); PG8_BAR;
            PG8_LDA(At, 1, 1); PG8_STAGE(PG8_SA(1, 0), a3, voffA);
            PG8_BAR; PG8_WAIT_L(0); PG8_MMA(1, 0, At, B0); PG8_BAR; PG8_SCHED;
            PG8_STAGE(PG8_SB(1, 1), b3 + hstepB, voffB);
            PG8_WAIT_V(6); PG8_BAR; PG8_MMA(1, 1, At, B1); PG8_BAR;
            }
        }
        if constexpr (ALIGN_EPI) { if (wr == 0) PG8_BAR; }
        if constexpr (!Epi::AFTER_DRAIN) { E(acc, cur, wr, wc, fr, fq); S.done(cur); }
        if (!has_next) break;
#pragma unroll
        for (int a = 0; a < 2; ++a)
#pragma unroll
            for (int b = 0; b < 2; ++b)
#pragma unroll
                for (int m = 0; m < 4; ++m)
#pragma unroll
                    for (int n = 0; n < 2; ++n) acc[a][b][m][n] = (f32x4){0.f, 0.f, 0.f, 0.f};
        cur = nxt; cA = nA; cB = nB; ++ui;
        if constexpr (ALIGN_EPI) { if (wr == 1) PG8_BAR; }
    }
    PG8_WAIT_V(0);
    if constexpr (!ALIGN_EPI) { if (wr == 0) PG8_BAR; }
    PG8_BAR;
    if constexpr (Epi::AFTER_DRAIN) { E.fused(acc, cur, wr, wc, fr, fq, lds, wid, lane); S.done(cur); }
#undef PG8_SA
#undef PG8_SB
#undef PG8_STAGE
#undef PG8_LDA
#undef PG8_LDB
#undef PG8_MMA
#undef PG8_WAIT_V
#undef PG8_WAIT_L
#undef PG8_BAR
#undef PG8_SCHED
}
}
#include <hip/hip_bf16.h>
#include <cmath>
namespace attn_body {
using bf16=__hip_bfloat16;
using bf16x8=__attribute__((ext_vector_type(8)))short;
using s16x4=__attribute__((ext_vector_type(4)))short;
using f32x16=__attribute__((ext_vector_type(16)))float;
using u32x4=__attribute__((ext_vector_type(4)))unsigned;
constexpr int D=64,DM=512;
constexpr int NW=8,QBLK=32,QB=QBLK*NW,KVBLK=64;
constexpr int ATTN_PITCH=DM, ATTN_UNIT_ROWS=QB;
__device__ __forceinline__ int crow(int r,int hi){return (r&3)+8*(r>>2)+4*hi;}
#define SBAR() __builtin_amdgcn_sched_barrier(0)
__device__ __forceinline__ void cmask(f32x16&p0,f32x16&p1,int jb,int qrel,int hi){
  const float NEG=-INFINITY; int kb=64*jb+4*hi;
  #pragma unroll
  for(int r=0;r<16;++r){int kv=kb+(r&3)+8*(r>>2); if(kv>qrel)p0[r]=NEG; if(kv+32>qrel)p1[r]=NEG;}
}

constexpr int NSLOT=3, SLOTB=8192;
constexpr int LDS_K=0, LDS_V=NSLOT*SLOTB, LDS_WS=2*NSLOT*SLOTB, LDS_OST=LDS_WS+NW*64*4, LDS_BYTES=LDS_OST+NW*4096;
constexpr float C2=0.125f*1.4426950408889634f;
__device__ __forceinline__ void glds16(const void*gsrc,unsigned lds_dst){unsigned keep;
  asm volatile("s_mov_b32 %0, m0\n\ts_mov_b32 m0, %2\n\ts_nop 0\n\tglobal_load_lds_dwordx4 %1, off\n\ts_mov_b32 m0, %0":"=&s"(keep):"v"(gsrc),"s"(lds_dst):"memory");}
__device__ __forceinline__ float max3f(float a,float b,float c){float r;asm("v_max3_f32 %0, %1, %2, %3":"=v"(r):"v"(a),"v"(b),"v"(c));return r;}
__device__ __forceinline__ float max2f(float a,float b){float r;asm("v_max_f32_e32 %0, %1, %2":"=v"(r):"v"(a),"v"(b));return r;}
__device__ __forceinline__ float fadd_s(float a,float b){float r;asm("v_add_f32_e32 %0, %1, %2":"=v"(r):"v"(a),"v"(b));return r;}
__device__ __forceinline__ float fsub_s(float a,float b){float r;asm("v_sub_f32_e32 %0, %1, %2":"=v"(r):"v"(a),"v"(b));return r;}
typedef float f32x2_t __attribute__((ext_vector_type(2))); typedef __bf16 bf16x2_t __attribute__((ext_vector_type(2)));
__device__ __forceinline__ unsigned cvtpk_s(float lo,float hi){f32x2_t v={lo,hi};bf16x2_t b=__builtin_convertvector(v,bf16x2_t);return __builtin_bit_cast(unsigned,b);}
#define WAIT_BAR(N) asm volatile("s_waitcnt vmcnt(" #N ") lgkmcnt(0)\n\ts_barrier":::"memory")

__device__ __forceinline__ void qkt(f32x16&p0,f32x16&p1,const char*Kslot,const bf16x8*qr,const f32x16&negm,int r32,int hi){
  const char*kb=Kslot+hi*1024+r32*16;
  #pragma unroll
  for(int d0=0;d0<4;++d0){
    const bf16x8 b0=*reinterpret_cast<const bf16x8*>(kb+d0*2048);
    const bf16x8 b1=*reinterpret_cast<const bf16x8*>(kb+d0*2048+512);
    if(d0==0){p0=__builtin_amdgcn_mfma_f32_32x32x16_bf16(b0,qr[0],negm,0,0,0);p1=__builtin_amdgcn_mfma_f32_32x32x16_bf16(b1,qr[0],negm,0,0,0);}
    else{p0=__builtin_amdgcn_mfma_f32_32x32x16_bf16(b0,qr[d0],p0,0,0,0);p1=__builtin_amdgcn_mfma_f32_32x32x16_bf16(b1,qr[d0],p1,0,0,0);}}
}
typedef __attribute__((address_space(3))) const char* lds_cptr;
typedef short v4i16_t __attribute__((ext_vector_type(4)));
__device__ __forceinline__ void kload8(bf16x8*kf,lds_cptr kp){
  kf[0]=*(const __attribute__((address_space(3))) bf16x8*)(kp);      kf[1]=*(const __attribute__((address_space(3))) bf16x8*)(kp+512);
  kf[2]=*(const __attribute__((address_space(3))) bf16x8*)(kp+2048); kf[3]=*(const __attribute__((address_space(3))) bf16x8*)(kp+2560);
  kf[4]=*(const __attribute__((address_space(3))) bf16x8*)(kp+4096); kf[5]=*(const __attribute__((address_space(3))) bf16x8*)(kp+4608);
  kf[6]=*(const __attribute__((address_space(3))) bf16x8*)(kp+6144); kf[7]=*(const __attribute__((address_space(3))) bf16x8*)(kp+6656);
}
__device__ __forceinline__ void kload2(bf16x8*kf,lds_cptr kp,int j){ kf[2*j]=*(const __attribute__((address_space(3))) bf16x8*)(kp+j*2048); kf[2*j+1]=*(const __attribute__((address_space(3))) bf16x8*)(kp+j*2048+512); }
__device__ __forceinline__ s16x4 vtr(lds_cptr p){ return __builtin_bit_cast(s16x4,__builtin_amdgcn_ds_read_tr16_b64_v4i16((__attribute__((address_space(3))) v4i16_t*)p)); }
__device__ __forceinline__ float rowmax(const f32x16&p0,const f32x16&p1){
  float a=max3f(p0[0],p0[1],p1[0]),b=max3f(p0[2],p0[3],p1[1]);a=max3f(a,p1[2],p1[3]);
  #pragma unroll
  for(int r=4;r<16;r+=4){a=max3f(a,p0[r],p0[r+1]);b=max3f(b,p0[r+2],p0[r+3]);a=max3f(a,p1[r],p1[r+1]);b=max3f(b,p1[r+2],p1[r+3]);}
  const float m=max2f(a,b);
  auto rr=__builtin_amdgcn_permlane32_swap(__float_as_uint(m),__float_as_uint(m),false,false);
  return max2f(__uint_as_float(rr[0]),__uint_as_float(rr[1]));
}
__device__ __forceinline__ void pv(f32x16*o,int vb,bf16x8 pa0,bf16x8 pa1,bf16x8 pa2,bf16x8 pa3){
  #pragma unroll
  for(int d0=0;d0<2;++d0){s16x4 lo[4],hi[4];
    #pragma unroll
    for(int ks=0;ks<4;++ks){
      asm volatile("ds_read_b64_tr_b16 %0,%1 offset:%c2":"=&v"(lo[ks]):"v"(vb),"i"(d0*4096+ks*1024):"memory");
      asm volatile("ds_read_b64_tr_b16 %0,%1 offset:%c2":"=&v"(hi[ks]):"v"(vb),"i"(d0*4096+ks*1024+512):"memory");}
    asm volatile("s_waitcnt lgkmcnt(0)":::"memory");SBAR();
    #define PK(k) (bf16x8){lo[k][0],lo[k][1],lo[k][2],lo[k][3],hi[k][0],hi[k][1],hi[k][2],hi[k][3]}
    o[d0]=__builtin_amdgcn_mfma_f32_32x32x16_bf16(pa0,PK(0),o[d0],0,0,0);
    o[d0]=__builtin_amdgcn_mfma_f32_32x32x16_bf16(pa1,PK(1),o[d0],0,0,0);
    o[d0]=__builtin_amdgcn_mfma_f32_32x32x16_bf16(pa2,PK(2),o[d0],0,0,0);
    o[d0]=__builtin_amdgcn_mfma_f32_32x32x16_bf16(pa3,PK(3),o[d0],0,0,0);
    #undef PK
  }
}

#ifndef ATTN_STORE16
#define ATTN_STORE16(p,v) (*(u32x4*)(p)=(v))
#endif
template<int THRL> __device__ __forceinline__ void attn_unit(int tid_in,int qb,const bf16*Qb,const bf16*__restrict__ Kh,const bf16*__restrict__ Vh,bf16*Ob,char*shm){
  const int tid=tid_in,lane=tid&63,r32=lane&31,hi=lane>>5; const int wid=__builtin_amdgcn_readfirstlane(tid>>6);
  const int q0=qb*QB;
  const bf16*Qw=Qb+(long)(q0+wid*QBLK)*DM;
  const unsigned lds0=(unsigned)(uintptr_t)shm;
  float*wsf=(float*)(shm+LDS_WS)+wid*64;
  const bf16*ksrc=Kh+(long)lane*DM+wid*8;
  const bf16*vsrc=Vh+(long)(16*(wid&3)+(lane>>2))*DM+(wid>>2)*32+(lane&3)*8;
  const unsigned kdst=lds0+LDS_K+wid*1024, vdst=lds0+LDS_V+wid*1024;
  #define DMA_K(t,slot) glds16(ksrc+(long)(t)*KVBLK*DM,(unsigned)__builtin_amdgcn_readfirstlane(kdst+(slot)))
  #define DMA_V(t,slot) glds16(vsrc+(long)(t)*KVBLK*DM,(unsigned)__builtin_amdgcn_readfirstlane(vdst+(slot)))
  const int vb0=(int)(lds0+LDS_V)+((lane>>4)&1)*32+(lane&3)*8+(4*hi+((lane&15)>>2))*64;
  const char*Kbase=shm+LDS_K; bf16x8 kf[8];
  const lds_cptr shm3=(lds_cptr)shm; const lds_cptr kp0=shm3+LDS_K+hi*1024+r32*16; const lds_cptr vp0=shm3+LDS_V+((lane>>4)&1)*32+(lane&3)*8+(4*hi+((lane&15)>>2))*64;
  const int NT=(q0+QB)/KVBLK;
  DMA_K(0,0);DMA_V(0,0);DMA_K(1,SLOTB);
  bf16x8 qr[4];
  #pragma unroll
  for(int d0=0;d0<4;++d0)qr[d0]=*reinterpret_cast<const bf16x8*>(&Qw[(long)r32*DM+d0*16+hi*8]);
  float mhat=0.f,l_reg=0.f;f32x16 o[2];o[0]=f32x16{};o[1]=f32x16{};f32x16 negm=f32x16{};asm volatile("":"+v"(negm));
  const int qrel=wid*QBLK+r32;
  #define CMASK(P0,P1,t) do{int jb_=(t)-(NT-4); if(jb_>=0)cmask(P0,P1,jb_,qrel,hi);}while(0)
  bool resc=false;
  #define START(P0,P1) do{ const float rm=rowmax(P0,P1); resc=false; \
    { const float dl=rm; mhat=fadd_s(mhat,dl); \
      _Pragma("unroll") for(int r=0;r<16;++r){P0[r]=fsub_s(P0[r],dl);P1[r]=fsub_s(P1[r],dl);} \
      _Pragma("unroll") for(int r=0;r<16;++r)negm[r]=-mhat; asm volatile("":"+v"(negm)); } \
    _Pragma("unroll") for(int r=0;r<16;++r)P0[r]=__builtin_amdgcn_exp2f(P0[r]); }while(0)
  #define RESC() do{ if(resc){ asm volatile("s_waitcnt lgkmcnt(0)":::"memory"); \
      _Pragma("unroll") for(int d_=0;d_<2;++d_) _Pragma("unroll") for(int r=0;r<16;++r)o[d_][r]*=wsf[crow(r,hi)]; } }while(0)
  f32x16 pA0,pA1,pB0,pB1;
  int sl_prev=0,sl_cur=0,sl_next=SLOTB;
  #define ROT() do{sl_prev=sl_cur;sl_cur=sl_next;sl_next=(sl_next==(NSLOT-1)*SLOTB)?0:sl_next+SLOTB;}while(0)
  DMA_K(2,2*SLOTB);
  WAIT_BAR(3);
  qkt(pA0,pA1,Kbase,qr,negm,r32,hi);asm volatile("s_nop 15\n\ts_nop 7":"+v"(pA0),"+v"(pA1));CMASK(pA0,pA1,0);
  START(pA0,pA1);
  _Pragma("unroll") for(int r=0;r<16;++r)pA1[r]=__builtin_amdgcn_exp2f(pA1[r]);
  WAIT_BAR(0);
  DMA_K(3,0);DMA_V(1,SLOTB);
  ROT();
  kload8(kf,kp0+sl_cur);
  WAIT_BAR(2);
  s16x4 vlo[8],vhi[8]; u32x4 pw0,pw1,pw2,pw3;
  #define PKW(P,B) cvtpk_s(P[B],P[B+1])
  #define PAF(k) __builtin_bit_cast(bf16x8,pw##k)
  #define VFR(i) (bf16x8){vlo[i][0],vlo[i][1],vlo[i][2],vlo[i][3],vhi[i][0],vhi[i][1],vhi[i][2],vhi[i][3]}
  #define PIN(x) asm volatile("":"+v"(x))
  #define MX3(a,b,c) __builtin_fmaxf(__builtin_fmaxf((a),(b)),(c))
  #define GAPA(MF,A0,A1,A2,A3,W0,W1,PW) do{ MF; sacc+=A0; sacc+=A1; sacc+=A2; sacc+=A3; PIN(sacc); W0; W1; PIN(PW); SBAR(); }while(0)
  #define EX(v) __builtin_amdgcn_exp2f(v)
  #define GAPB(MF,X,B) do{ MF; X[B]=EX(X[B]); X[B+1]=EX(X[B+1]); X[B+2]=EX(X[B+2]); X[B+3]=EX(X[B+3]); PIN(X); SBAR(); }while(0)
  #define VRD(i) do{ vlo[i]=vtr(vp_+(((i)>>2)*4096+((i)&3)*1024)); vhi[i]=vtr(vp_+(((i)>>2)*4096+((i)&3)*1024+512)); }while(0)
  #define KRD(G,j) do{ if(G){ kload2(kf,kp0+sl_next,j); SBAR(); } }while(0)
  #define STEP(C0,C1,P0,P1,t,GK,GV,GL) do{ SBAR(); \
    const lds_cptr vp_=vp0+sl_prev; \
    VRD(0); SBAR(); float sacc=(P0[0]+P0[1]); \
    GAPA(C0=__builtin_amdgcn_mfma_f32_32x32x16_bf16(kf[0],qr[0],negm,0,0,0), P0[2],P0[3],P0[4],P0[5],     pw0[0]=PKW(P0,0), pw0[1]=PKW(P0,2), pw0); \
    VRD(4); SBAR(); GAPA(C1=__builtin_amdgcn_mfma_f32_32x32x16_bf16(kf[1],qr[0],negm,0,0,0), P0[6],P0[7],P0[8],P0[9],     pw0[2]=PKW(P0,4), pw0[3]=PKW(P0,6), pw0); \
    VRD(1); SBAR(); GAPA(C0=__builtin_amdgcn_mfma_f32_32x32x16_bf16(kf[2],qr[1],C0,0,0,0),   P0[10],P0[11],P0[12],P0[13], pw1[0]=PKW(P0,8), pw1[1]=PKW(P0,10), pw1); \
    VRD(5); SBAR(); GAPA(C1=__builtin_amdgcn_mfma_f32_32x32x16_bf16(kf[3],qr[1],C1,0,0,0),   P0[14],P0[15],P1[0],P1[1],   pw1[2]=PKW(P0,12),pw1[3]=PKW(P0,14), pw1); \
    VRD(2); SBAR(); GAPA(C0=__builtin_amdgcn_mfma_f32_32x32x16_bf16(kf[4],qr[2],C0,0,0,0),   P1[2],P1[3],P1[4],P1[5],     pw2[0]=PKW(P1,0), pw2[1]=PKW(P1,2), pw2); \
    VRD(6); SBAR(); GAPA(C1=__builtin_amdgcn_mfma_f32_32x32x16_bf16(kf[5],qr[2],C1,0,0,0),   P1[6],P1[7],P1[8],P1[9],     pw2[2]=PKW(P1,4), pw2[3]=PKW(P1,6), pw2); \
    VRD(3); SBAR(); GAPA(C0=__builtin_amdgcn_mfma_f32_32x32x16_bf16(kf[6],qr[3],C0,0,0,0),   P1[10],P1[11],P1[12],P1[13], pw3[0]=PKW(P1,8), pw3[1]=PKW(P1,10), pw3); \
    VRD(7); SBAR(); GAPA(C1=__builtin_amdgcn_mfma_f32_32x32x16_bf16(kf[7],qr[3],C1,0,0,0),   P1[14],P1[15],0.f,0.f,       pw3[2]=PKW(P1,12),pw3[3]=PKW(P1,14), pw3); \
    l_reg+=sacc; \
    if(GK){DMA_K((t)+3,sl_cur);} if(GV){DMA_V((t)+1,sl_next);} \
    CMASK(C0,C1,t); \
    { float a=MX3(C0[0],C0[1],C1[0]),b=MX3(C0[2],C0[3],C1[1]); a=MX3(a,C1[2],C1[3]); \
      _Pragma("unroll") for(int r=4;r<16;r+=4){a=MX3(a,C0[r],C0[r+1]);b=MX3(b,C0[r+2],C0[r+3]);a=MX3(a,C1[r],C1[r+1]);b=MX3(b,C1[r+2],C1[r+3]);} \
      float rm=__builtin_fmaxf(a,b); { auto rr=__builtin_amdgcn_permlane32_swap(__float_as_uint(rm),__float_as_uint(rm),false,false); rm=__builtin_fmaxf(__uint_as_float(rr[0]),__uint_as_float(rr[1])); } \
      resc=false; \
      if(__builtin_expect(__any(rm>(float)THRL),0)){ const float dl=__builtin_fmaxf(rm,0.f); mhat+=dl; \
        _Pragma("unroll") for(int r=0;r<16;++r){C0[r]-=dl;C1[r]-=dl;} \
        _Pragma("unroll") for(int r=0;r<16;++r)negm[r]=-mhat; asm volatile("":"+v"(negm)); \
        const float f=__builtin_amdgcn_exp2f(-dl); l_reg*=f; if(hi==0)wsf[r32]=f; resc=true; } } \
    SBAR(); \
    GAPB(o[0]=__builtin_amdgcn_mfma_f32_32x32x16_bf16(PAF(0),VFR(0),o[0],0,0,0), C0,0); \
    GAPB(o[1]=__builtin_amdgcn_mfma_f32_32x32x16_bf16(PAF(0),VFR(4),o[1],0,0,0), C0,4); \
    KRD(GL,0); GAPB(o[0]=__builtin_amdgcn_mfma_f32_32x32x16_bf16(PAF(1),VFR(1),o[0],0,0,0), C0,8); \
    KRD(GL,1); GAPB(o[1]=__builtin_amdgcn_mfma_f32_32x32x16_bf16(PAF(1),VFR(5),o[1],0,0,0), C0,12); \
    KRD(GL,2); GAPB(o[0]=__builtin_amdgcn_mfma_f32_32x32x16_bf16(PAF(2),VFR(2),o[0],0,0,0), C1,0); \
    KRD(GL,3); GAPB(o[1]=__builtin_amdgcn_mfma_f32_32x32x16_bf16(PAF(2),VFR(6),o[1],0,0,0), C1,4); \
    GAPB(o[0]=__builtin_amdgcn_mfma_f32_32x32x16_bf16(PAF(3),VFR(3),o[0],0,0,0), C1,8); \
    GAPB(o[1]=__builtin_amdgcn_mfma_f32_32x32x16_bf16(PAF(3),VFR(7),o[1],0,0,0), C1,12); \
    }while(0)
  int t=1;
  #undef CMASK
  #define CMASK(P0,P1,t) do{}while(0)
  for(;t+5<NT;t+=2){
    STEP(pB0,pB1,pA0,pA1,t,true,true,true);     WAIT_BAR(2); RESC(); ROT();
    STEP(pA0,pA1,pB0,pB1,t+1,true,true,true);   WAIT_BAR(2); RESC(); ROT();
  }
  #undef CMASK
  #define CMASK(P0,P1,t) do{int jb_=(t)-(NT-4); if(jb_>=0)cmask(P0,P1,jb_,qrel,hi);}while(0)
  #define ENDW(tt) do{ if((tt)+3<NT){WAIT_BAR(2);} else if((tt)+2<NT){WAIT_BAR(1);} else {WAIT_BAR(0);} }while(0)
  for(;t+1<NT;t+=2){
    STEP(pB0,pB1,pA0,pA1,t,(t+3<NT),(t+1<NT),(t+1<NT));       ENDW(t);   RESC(); ROT();
    STEP(pA0,pA1,pB0,pB1,t+1,(t+4<NT),(t+2<NT),(t+2<NT));     ENDW(t+1); RESC(); ROT();
  }
  STEP(pB0,pB1,pA0,pA1,NT-1,false,false,false); RESC();
  { float sacc=pB0[0]+pB0[1]; _Pragma("unroll") for(int r=2;r<16;++r)sacc+=pB0[r]; _Pragma("unroll") for(int r=0;r<16;++r)sacc+=pB1[r]; l_reg+=sacc;
    pw0=(u32x4){PKW(pB0,0),PKW(pB0,2),PKW(pB0,4),PKW(pB0,6)};pw1=(u32x4){PKW(pB0,8),PKW(pB0,10),PKW(pB0,12),PKW(pB0,14)};pw2=(u32x4){PKW(pB1,0),PKW(pB1,2),PKW(pB1,4),PKW(pB1,6)};pw3=(u32x4){PKW(pB1,8),PKW(pB1,10),PKW(pB1,12),PKW(pB1,14)};
    SBAR(); pv(o,vb0+sl_cur,PAF(0),PAF(1),PAF(2),PAF(3)); }
  #undef PKW
  #undef PAF
  #undef VFR
  #undef PIN
  #undef MX3
  #undef GAPA
  #undef GAPB
  #undef EX
  #undef VRD
  #undef KRD
  #undef STEP
  #undef ENDW
  {auto rr=__builtin_amdgcn_permlane32_swap(__float_as_uint(l_reg),__float_as_uint(l_reg),false,false);l_reg=__uint_as_float(rr[0])+__uint_as_float(rr[1]);}
  if(hi==0)wsf[32+r32]=l_reg;asm volatile("s_waitcnt lgkmcnt(0)":::"memory");
  float rli[16];
  #pragma unroll
  for(int r=0;r<16;++r)rli[r]=__builtin_amdgcn_rcpf(wsf[32+crow(r,hi)]);
  bf16*Ow=Ob+(long)(q0+wid*QBLK)*DM;
  { bf16*stg=(bf16*)(shm+LDS_OST)+wid*2048;
    #pragma unroll
    for(int r=0;r<16;++r){const int orow=crow(r,hi);
      #pragma unroll
      for(int d0=0;d0<2;++d0)stg[orow*64+d0*32+r32]=__float2bfloat16(o[d0][r]*rli[r]);}
    asm volatile("s_waitcnt lgkmcnt(0)":::"memory");
    #pragma unroll
    for(int i=0;i<4;++i){const int row=i*8+(lane>>3),ch=lane&7; const u32x4 v=*(const u32x4*)(stg+row*64+ch*8); ATTN_STORE16(Ow+(long)row*DM+ch*8,v);} }
  asm volatile("s_waitcnt lgkmcnt(0)\n\ts_barrier":::"memory");
  #undef DMA_K
  #undef DMA_V
  #undef CMASK
  #undef START
  #undef RESC
  #undef ROT
}

#undef SBAR
#undef WAIT_BAR
}
#define GAS __attribute__((address_space(1)))
#define LAS __attribute__((address_space(3)))
typedef unsigned short bf16;
typedef unsigned v4u __attribute__((ext_vector_type(4)));
typedef float f32x4 __attribute__((ext_vector_type(4)));
typedef short bf16x8 __attribute__((ext_vector_type(8)));
typedef GAS unsigned gu32;
typedef GAS unsigned long long gu64;
#define RLX_AGENT __ATOMIC_RELAXED, __HIP_MEMORY_SCOPE_AGENT
#define LDS_WAIT() asm volatile("s_waitcnt lgkmcnt(0)" ::: "memory")
#define VM_WAIT() asm volatile("s_waitcnt vmcnt(0)" ::: "memory")
__device__ __forceinline__ unsigned long long rt() { return __builtin_amdgcn_s_memrealtime(); }
__device__ __forceinline__ unsigned f2bf(float f) { unsigned u = __builtin_bit_cast(unsigned, f); return (u + 0x7fffu + ((u >> 16) & 1u)) >> 16; }
__device__ __forceinline__ unsigned pk2(float lo, float hi) { return f2bf(lo) | (f2bf(hi) << 16); }

#define XB_TMO      128
#define XB_XCNT(j)  (256  + 64 * (j))
#define XB_XSUB(j)  (1280 + 64 * (j))
#define XB_XGEN(j)  (2304 + 64 * (j))
#define XB_TOP      3328
#define XB_TOPGEN   3392
#define XCD_BAR_WORDS 3456
#define XB_SPIN_CAP (1u << 18)

__device__ __forceinline__ unsigned xb_ld(unsigned* p)              { return __hip_atomic_load(p, __ATOMIC_RELAXED, __HIP_MEMORY_SCOPE_AGENT); }
__device__ __forceinline__ unsigned xb_add(unsigned* p, unsigned v) { return __hip_atomic_fetch_add(p, v, __ATOMIC_RELAXED, __HIP_MEMORY_SCOPE_AGENT); }
__device__ __forceinline__ unsigned xb_xcc_id() { return (unsigned)__builtin_amdgcn_s_getreg((3 << 11) | 20) & 0xFu; }
#define XB_SPIN(cond, bar) do { unsigned _sp = 0; while (cond) { __builtin_amdgcn_s_sleep(1); \
    if ((++_sp & 255u) == 0u) { if (xb_ld(&(bar)[XB_TMO])) break; if (_sp > XB_SPIN_CAP) { atomicAdd(&(bar)[XB_TMO], 1u); break; } } } } while (0)

struct XcdBarrier {
    unsigned* bar; unsigned x;
    volatile LAS unsigned* st;
};

__device__ __forceinline__ XcdBarrier xcd_barrier_post(unsigned* bar, volatile LAS unsigned* st) {
    XcdBarrier b; b.bar = bar; b.x = xb_xcc_id(); b.st = st;
    if (threadIdx.x == 0) (void)xb_add(&bar[XB_XCNT(b.x)], 1u);
    return b;
}
__device__ __forceinline__ void xcd_barrier_complete(unsigned* bar, unsigned x, unsigned& nloc, unsigned& nx) {
    const unsigned G = gridDim.x * gridDim.y * gridDim.z;
    unsigned sum, cnt, mine, sp = 0u;
    for (;;) {
        sum = 0u; cnt = 0u; mine = 0u;
#pragma unroll
        for (unsigned j = 0; j < 16; ++j) { const unsigned c = xb_ld(&bar[XB_XCNT(j)]); sum += c; cnt += (c > 0u) ? 1u : 0u; mine = (j == x) ? c : mine; }
        if (sum == G) break;
        __builtin_amdgcn_s_sleep(1);
        if ((++sp & 255u) == 0u) { if (xb_ld(&bar[XB_TMO])) break; if (sp > XB_SPIN_CAP) { atomicAdd(&bar[XB_TMO], 1u); break; } }
    }
    nloc = mine > 0u ? mine : 1u; nx = cnt > 0u ? cnt : 1u;
}

__device__ __forceinline__ void xcd_barrier(const XcdBarrier& b) {
    asm volatile("s_waitcnt vmcnt(0)" ::: "memory");
    __syncthreads();
    if (threadIdx.x == 0) {
        unsigned* bar = b.bar;
        __builtin_amdgcn_s_waitcnt(0);
        unsigned nloc = b.st[0], nx = b.st[1];
        if (nloc == 0u) { xcd_barrier_complete(bar, b.x, nloc, nx); b.st[0] = nloc; b.st[1] = nx; }
        const unsigned old = xb_add(&bar[XB_XSUB(b.x)], 1u);
        const unsigned gen = old / nloc;
        if (old + 1u == (gen + 1u) * nloc) {
            __builtin_amdgcn_fence(__ATOMIC_RELEASE, "agent");
            asm volatile("s_waitcnt vmcnt(0)" ::: "memory");
            const unsigned og = xb_add(&bar[XB_TOP], 1u);
            const unsigned tg = og / nx;
            if (og + 1u == (tg + 1u) * nx) xb_add(&bar[XB_TOPGEN], 1u);
            else XB_SPIN(xb_ld(&bar[XB_TOPGEN]) == tg, bar);
            __builtin_amdgcn_fence(__ATOMIC_ACQUIRE, "agent");
            xb_add(&bar[XB_XGEN(b.x)], 1u);
            asm volatile("s_waitcnt vmcnt(0)" ::: "memory");
        } else {
            XB_SPIN(xb_ld(&bar[XB_XGEN(b.x)]) == gen, bar);
            __builtin_amdgcn_fence(__ATOMIC_ACQUIRE, "agent");
            asm volatile("s_waitcnt vmcnt(0)" ::: "memory");
        }
    }
    __syncthreads();
}
struct Args { const float* in[27]; const int* pt; float* out; unsigned char* ws; int ph_lo, ph_hi, use_bar, pad; };
enum { I_XP = 0, I_XS, I_GCONV, I_GS, I_CK, I_CV, I_PT, I_FCONV, I_ANG, I_WIN, I_GCW, I_ALOG, I_DTB, I_GNG, I_QNG, I_KNG, I_LQ1, I_LK1, I_LQ2, I_LK2, I_SUBG, I_WOUT, I_FNG, I_WUP, I_FCW, I_FCB, I_WDN };
constexpr int NWAVES = 8;
constexpr int RING_BYTES = 131072, LDSCTL_OFF = RING_BYTES, MISC_OFF = LDSCTL_OFF + 320, LDS_BYTES = 147456;
typedef unsigned v2u __attribute__((ext_vector_type(2)));
typedef float f32x2v __attribute__((ext_vector_type(2)));

__device__ __forceinline__ float wave_sum(float v) {
#pragma unroll
    for (int o = 1; o < 64; o <<= 1) v += __shfl_xor(v, o);
    return v;
}
__device__ __forceinline__ float bf2f(bf16 b) { return __uint_as_float(((unsigned)b) << 16); }
__device__ __forceinline__ float bflo(unsigned w) { return __uint_as_float(w << 16); }
__device__ __forceinline__ float bfhi(unsigned w) { return __uint_as_float(w & 0xffff0000u); }
typedef float f32x2_t __attribute__((ext_vector_type(2))); typedef __bf16 bf16x2_t __attribute__((ext_vector_type(2)));
__device__ __forceinline__ unsigned cvtpk(float lo, float hi) { f32x2_t v = {lo, hi}; bf16x2_t b = __builtin_convertvector(v, bf16x2_t); return __builtin_bit_cast(unsigned, b); }
__device__ __forceinline__ bf16x8 pack8(const f32x4& a, const f32x4& b) { v4u w; w.x = cvtpk(a[0], a[1]); w.y = cvtpk(a[2], a[3]); w.z = cvtpk(b[0], b[1]); w.w = cvtpk(b[2], b[3]); return __builtin_bit_cast(bf16x8, w); }
#define MFMA16(a, b, c) __builtin_amdgcn_mfma_f32_16x16x32_bf16((a), (b), (c), 0, 0, 0)
template <int CTRL> __device__ __forceinline__ float dpp_(float x) { return __builtin_bit_cast(float, __builtin_amdgcn_mov_dpp(__builtin_bit_cast(int, x), CTRL, 0xf, 0xf, true)); }
__device__ __forceinline__ float row16_max(float v) { v = fmaxf(v, dpp_<0xB1>(v)); v = fmaxf(v, dpp_<0x4E>(v)); v = fmaxf(v, dpp_<0x124>(v)); v = fmaxf(v, dpp_<0x128>(v)); return v; }
__device__ __forceinline__ float row16_sum(float v) { v += dpp_<0xB1>(v); v += dpp_<0x4E>(v); v += dpp_<0x124>(v); v += dpp_<0x128>(v); return v; }
template <int N> __device__ __forceinline__ float tred(float (&x)[N], int lane) {
    if constexpr (N == 1) return x[0];
    else { float y[N / 2];
#pragma unroll
        for (int j = 0; j < N / 2; ++j) { const bool up = (lane & (N / 2)) != 0; const float keep = up ? x[j + N / 2] : x[j], send = up ? x[j] : x[j + N / 2]; y[j] = keep + __shfl_xor(send, N / 2); }
        return tred<N / 2>(y, lane); }
}

__device__ __forceinline__ void p0_item(const float* W, int ldw, int src_col0, bf16* WT, int K, int dst_row0, int k0, const float* ksc, LAS float* scr, int lane) {
#pragma unroll 8
    for (int i = 0; i < 32; ++i) { const int kk = 2 * i + (lane >> 5); float w = W[(size_t)(k0 + kk) * ldw + src_col0 + (lane & 31)]; if (ksc) w *= ksc[k0 + kk]; scr[kk * 33 + (lane & 31)] = w; }
    LDS_WAIT(); asm volatile("" ::: "memory");
    const int c = lane & 7;
#pragma unroll
    for (int j = 0; j < 4; ++j) { const int n = (lane >> 3) + 8 * j; const LAS float* s = scr + (8 * c) * 33 + n;
        v4u o; o.x = pk2(s[0 * 33], s[1 * 33]); o.y = pk2(s[2 * 33], s[3 * 33]); o.z = pk2(s[4 * 33], s[5 * 33]); o.w = pk2(s[6 * 33], s[7 * 33]);
        *(GAS v4u*)(WT + (size_t)(dst_row0 + n) * K + k0 + 8 * c) = o; }
    LDS_WAIT(); asm volatile("" ::: "memory");
}
__device__ __forceinline__ void p0_prologue(const Args& a, LAS unsigned char* lds, int lane, int wave, int vcu, int G) {
    LAS float* scr = (LAS float*)(lds + wave * 16384);
    const int gw = vcu * NWAVES + wave, NGW = G * NWAVES;
    bf16* WIN = (bf16*)(a.ws + WS_WIN); bf16* WOUT = (bf16*)(a.ws + WS_WOUT); bf16* WUP = (bf16*)(a.ws + WS_WUP); bf16* WDN = (bf16*)(a.ws + WS_WDN);
    constexpr int N1 = 16 * 112, N2 = 16 * 32, N3 = 16 * 176, N4 = 44 * 32;
    for (int it = gw; it < N1 + N2 + N3 + N4; it += NGW) {
        int r = it;
        if (r < N1) { const int kb = r / 112, nb = r % 112, tile = nb >> 3, wi = nb & 7, bj = wi >> 2, wc = wi & 3, nl = 256 * tile + 64 * wc + 32 * bj, src = nl < 2048 ? nl : nl + 8;
            p0_item(a.in[I_WIN], INC, src, WIN, 1024, 32 * nb, 64 * kb, nullptr, scr, lane); continue; } r -= N1;
        if (r < N2) { const int kb = r / 32, nb = r % 32; p0_item(a.in[I_WOUT], 1024, 32 * nb, WOUT, 1024, 32 * nb, 64 * kb, nullptr, scr, lane); continue; } r -= N2;
        if (r < N3) { const int kb = r / 176, nb = r % 176, tile = nb >> 3, wi = nb & 7, bj = wi >> 2, r32 = wi & 3, src = bj * FF + 128 * tile + 32 * r32;
            p0_item(a.in[I_WUP], FF2, src, WUP, 1024, 32 * nb, 64 * kb, a.in[I_FNG], scr, lane); continue; } r -= N3;
        { const int kb = r / 32, nb = r % 32; p0_item(a.in[I_WDN], 1024, 32 * nb, WDN, FF, 32 * nb, 64 * kb, nullptr, scr, lane); }
    }
    { const float* fcw = a.in[I_FCW]; const float* fcb = a.in[I_FCB]; float* CWP = (float*)(a.ws + WS_CWP);
      for (int c = gw * 64 + lane; c < FF; c += NGW * 64) {
          *(f32x4*)(CWP + (size_t)c * 8) = (f32x4){fcw[c], fcw[FF2 + c], fcw[2 * FF2 + c], fcb[c]};
          *(f32x4*)(CWP + (size_t)c * 8 + 4) = (f32x4){fcw[FF + c], fcw[FF2 + FF + c], fcw[2 * FF2 + FF + c], fcb[FF + c]}; } }
    float wl[16][8], gl[16];
    const float* win = a.in[I_WIN]; const float* ang = a.in[I_ANG];
#pragma unroll
    for (int j = 0; j < 4; ++j)
#pragma unroll
        for (int e = 0; e < 4; ++e) { const int k = 256 * j + 4 * lane + e; const float* wp = win + (size_t)k * INC + 2048; const f32x4 w0 = *(const f32x4*)wp, w1 = *(const f32x4*)(wp + 4);
            wl[4 * j + e][0] = w0[0]; wl[4 * j + e][1] = w0[1]; wl[4 * j + e][2] = w0[2]; wl[4 * j + e][3] = w0[3]; wl[4 * j + e][4] = w1[0]; wl[4 * j + e][5] = w1[1]; wl[4 * j + e][6] = w1[2]; wl[4 * j + e][7] = w1[3];
            gl[4 * j + e] = ang[k]; }
    bf16* XN = (bf16*)(a.ws + WS_XN); float* BA = (float*)(a.ws + WS_BA);
    for (int row = gw; row < MT; row += NGW) {
        const float* xr = row < TP ? a.in[I_XP] + (size_t)row * 1024 : a.in[I_XS] + (size_t)(row - TP) * 1024;
        f32x4 v[4]; float ss = 0.f;
#pragma unroll
        for (int j = 0; j < 4; ++j) { v[j] = *(const f32x4*)(xr + 256 * j + 4 * lane); ss += (v[j][0] * v[j][0] + v[j][1] * v[j][1]) + (v[j][2] * v[j][2] + v[j][3] * v[j][3]); }
        const float rstd = 1.0f / sqrtf(wave_sum(ss) * (1.0f / 1024.0f) + EPS);
        float lg[8] = {0.f, 0.f, 0.f, 0.f, 0.f, 0.f, 0.f, 0.f};
#pragma unroll
        for (int j = 0; j < 4; ++j) { f32x4 xn;
#pragma unroll
            for (int e = 0; e < 4; ++e) { xn[e] = v[j][e] * rstd * gl[4 * j + e];
#pragma unroll
                for (int q = 0; q < 8; ++q) lg[q] += xn[e] * wl[4 * j + e][q]; }
            v2u o; o.x = pk2(xn[0], xn[1]); o.y = pk2(xn[2], xn[3]); *(GAS v2u*)(XN + (size_t)row * 1024 + 256 * j + 4 * lane) = o; }
#pragma unroll
        for (int q = 0; q < 8; ++q) lg[q] = wave_sum(lg[q]);
        if (lane == 0) { *(f32x4*)(BA + (size_t)row * 8) = (f32x4){lg[0], lg[1], lg[2], lg[3]}; *(f32x4*)(BA + (size_t)row * 8 + 4) = (f32x4){lg[4], lg[5], lg[6], lg[7]}; }
    }
}

__device__ __forceinline__ void conv_chan64(const bf16* ub  , int c, const float* cw, int col, bool has_prev, float (&o)[64]) {
    const float w0 = cw[col], w1 = cw[1536 + col], w2 = cw[3072 + col], w3 = cw[4608 + col];
    float x0 = 0.f, x1 = 0.f, x2 = 0.f;
    if (has_prev) { x0 = bf2f((ub - 3 * 1536)[c]); x1 = bf2f((ub - 2 * 1536)[c]); x2 = bf2f((ub - 1536)[c]); }
#pragma unroll
    for (int i = 0; i < 64; ++i) { const float x3 = bf2f((ub + (size_t)i * 1536)[c]); const float y = w0 * x0 + w1 * x1 + w2 * x2 + w3 * x3; o[i] = y / (1.0f + __expf(-y)); x0 = x1; x1 = x2; x2 = x3; }
}
#define FRESH(v_, expr_) int v_ = (expr_); asm volatile("" : "+v"(v_))
__device__ __forceinline__ void gdn_prep(const Args& a, LAS unsigned char* lds, int tid, int wave, int vcu, int G) {
    const int half = wave >> 2, hw = wave & 3;
    LAS unsigned char* hp = lds + half * 57344;
    LAS bf16* q_s = (LAS bf16*)hp; LAS bf16* k_s = (LAS bf16*)(hp + 17408); LAS float* M_s = (LAS float*)(hp + 34816);
    LAS float* part_s = (LAS float*)(hp + 52224); LAS float* beta_s = (LAS float*)(hp + 53248); LAS float* gcum_s = (LAS float*)(hp + 53504);
    const bf16* GQKV = (const bf16*)(a.ws + WS_GQKV); const float* BA = (const float*)(a.ws + WS_BA); const float* cw = a.in[I_GCW];
    const bool roleA = hw < 2;
    for (int pair = vcu; pair < 512; pair += G) {
        const int chunk = 2 * pair + half, bh = chunk >> 6, ci = chunk & 63, b = bh >> 2, h = bh & 3;
        const size_t rb = (size_t)b * 4096 + 64 * ci;
        unsigned char* rec = a.ws + WS_GCH + (size_t)chunk * GCH_STRIDE;
        float xa[64], xb[64];
        {   FRESH(t1, tid); const int lane = t1 & 63, c = t1 & 127;
            float mine;
            if (roleA) { conv_chan64(GQKV + rb * 1536 + 128 * h, c, cw, 128 * h + c, ci > 0, xb);
                { float sq[64];
#pragma unroll
                  for (int i = 0; i < 64; ++i) sq[i] = xb[i] * xb[i];
                  mine = tred<64>(sq, lane); }
                asm volatile("" ::: "memory");
                conv_chan64(GQKV + rb * 1536 + 1024 + 128 * h, c, cw, 1024 + 128 * h + c, ci > 0, xa);
            } else { conv_chan64(GQKV + rb * 1536 + 512 + 128 * h, c, cw, 512 + 128 * h + c, ci > 0, xa);
                float sq[64];
#pragma unroll
                for (int i = 0; i < 64; ++i) sq[i] = xa[i] * xa[i];
                mine = tred<64>(sq, lane);
            }
            part_s[hw * 64 + lane] = mine;
            if (hw == 0) { const float* bap = BA + (rb + lane) * 8; const float bl = bap[h], al = bap[4 + h];
                const float beta = 1.0f / (1.0f + __expf(-bl));
                const float xs = al + a.in[I_DTB][h]; const float sp = fmaxf(xs, 0.f) + log1pf(__expf(-fabsf(xs)));
                float cs = -__expf(a.in[I_ALOG][h]) * sp;
#pragma unroll
                for (int o = 1; o < 64; o <<= 1) { const float t = __shfl_up(cs, o); if (lane >= o) cs += t; }
                beta_s[lane] = beta; gcum_s[lane] = cs; }
        }
        __syncthreads();
        {   FRESH(t2, tid); const int c = t2 & 127;
            if (roleA) {
#pragma unroll
                for (int i = 0; i < 64; ++i) { const float r = (1.0f / sqrtf(part_s[i] + part_s[64 + i] + EPS)) * 0.08838834764831845f; xb[i] *= r; q_s[i * 136 + c] = (bf16)f2bf(xb[i]); }
            } else {
#pragma unroll
                for (int i = 0; i < 64; ++i) { const float r = 1.0f / sqrtf(part_s[128 + i] + part_s[192 + i] + EPS); xa[i] *= r; k_s[i * 136 + c] = (bf16)f2bf(xa[i]); }
            }
        }
        __syncthreads();
        {
            FRESH(t3, tid); const int n = t3 & 15, kg = (t3 >> 4) & 3, ti = hw;
            bf16* INTRA = (bf16*)(rec + 81920);
#pragma unroll
            for (int tj = 0; tj < 4; ++tj) {
                f32x4 aK = (f32x4){0.f, 0.f, 0.f, 0.f}, aQ = aK;
                if (tj <= ti) {
#pragma unroll
                    for (int ks = 0; ks < 4; ++ks) {
                        const bf16x8 ak = *(const LAS bf16x8*)(k_s + (16 * ti + n) * 136 + 32 * ks + 8 * kg), aq = *(const LAS bf16x8*)(q_s + (16 * ti + n) * 136 + 32 * ks + 8 * kg);
                        const bf16x8 bk = *(const LAS bf16x8*)(k_s + (16 * tj + n) * 136 + 32 * ks + 8 * kg);
                        aK = MFMA16(ak, bk, aK); aQ = MFMA16(aq, bk, aQ); }
                }
#pragma unroll
                for (int j = 0; j < 4; ++j) { const int i = 16 * ti + 4 * kg + j, jp = 16 * tj + n;
                    const float dec = (i >= jp) ? __expf(fminf(gcum_s[i] - gcum_s[jp], 0.f)) : 0.f;
                    if (tj <= ti) M_s[i * 68 + jp] = (i > jp) ? beta_s[i] * aK[j] * dec : 0.f;
                    INTRA[((ti * 2 + (tj >> 1)) * 64 + (4 * kg + j) + 16 * (n >> 2)) * 8 + 4 * (tj & 1) + (n & 3)] = (bf16)f2bf(aQ[j] * dec); }
            }
        }
        __syncthreads();
        {   FRESH(t4, tid); const int c = t4 & 127;
            if (roleA) {
#pragma unroll
                for (int i = 0; i < 64; ++i) { q_s[i * 136 + c] = (bf16)f2bf(xb[i] * __expf(gcum_s[i])); xa[i] *= beta_s[i]; }
            } else {
                const float gl = gcum_s[63]; const int dt = c >> 4, m = c & 15;
                unsigned char* KDT = rec + 65536;
#pragma unroll
                for (int ks2 = 0; ks2 < 2; ++ks2)
#pragma unroll
                    for (int kgi = 0; kgi < 4; ++kgi)
#pragma unroll
                        for (int hh = 0; hh < 2; ++hh) { const int t0 = 32 * ks2 + 16 * hh + 4 * kgi;
                            v2u w; w.x = pk2(xa[t0] * __expf(gl - gcum_s[t0]), xa[t0 + 1] * __expf(gl - gcum_s[t0 + 1])); w.y = pk2(xa[t0 + 2] * __expf(gl - gcum_s[t0 + 2]), xa[t0 + 3] * __expf(gl - gcum_s[t0 + 3]));
                            *(GAS v2u*)(KDT + ((dt * 2 + ks2) * 64 + m + 16 * kgi) * 16 + hh * 8) = w; }
                if (c == 0) *(float*)(rec + 90112) = __expf(gl);
#pragma unroll
                for (int i = 0; i < 64; ++i) xa[i] *= beta_s[i] * __expf(gcum_s[i]);
            }
        }
#pragma unroll
        for (int i = 1; i < 64; ++i) { float acc = xa[i];
#pragma unroll
            for (int j4 = 0; j4 <= (i - 1) / 4; ++j4) { const f32x4 mr = *(const LAS f32x4*)(M_s + i * 68 + 4 * j4);
                acc -= mr[0] * xa[4 * j4]; if (4 * j4 + 1 < i) acc -= mr[1] * xa[4 * j4 + 1]; if (4 * j4 + 2 < i) acc -= mr[2] * xa[4 * j4 + 2]; if (4 * j4 + 3 < i) acc -= mr[3] * xa[4 * j4 + 3]; }
            xa[i] = acc; }
        {   FRESH(t5, tid); const int c = t5 & 127;
            if (roleA) { float* U = (float*)rec; const int s = c >> 4, n = c & 15;
#pragma unroll
                for (int mt = 0; mt < 4; ++mt)
#pragma unroll
                    for (int kgi = 0; kgi < 4; ++kgi) *(f32x4*)(U + (((s * 4 + mt) * 64 + n + 16 * kgi) * 4)) = (f32x4){xa[16 * mt + 4 * kgi], xa[16 * mt + 4 * kgi + 1], xa[16 * mt + 4 * kgi + 2], xa[16 * mt + 4 * kgi + 3]};
            } else {
#pragma unroll
                for (int i = 0; i < 64; ++i) k_s[i * 136 + c] = (bf16)f2bf(-xa[i]);
            }
        }
        __syncthreads();
        {   FRESH(t6, tid); const int ht = t6 & 255;
#pragma unroll
            for (int rep = 0; rep < 4; ++rep) { const int idx = ht + 256 * rep, mt = idx >> 8, ks = (idx >> 6) & 3, l = idx & 63, m = l & 15, kgi = l >> 4, row = 16 * mt + m;
                const v2u wlo = *(const LAS v2u*)(k_s + row * 136 + 32 * ks + 4 * kgi), whi = *(const LAS v2u*)(k_s + row * 136 + 32 * ks + 16 + 4 * kgi);
                *(GAS v4u*)(rec + 32768 + (size_t)idx * 16) = (v4u){wlo.x, wlo.y, whi.x, whi.y};
                const v2u qlo = *(const LAS v2u*)(q_s + row * 136 + 32 * ks + 4 * kgi), qhi = *(const LAS v2u*)(q_s + row * 136 + 32 * ks + 16 + 4 * kgi);
                *(GAS v4u*)(rec + 49152 + (size_t)idx * 16) = (v4u){qlo.x, qlo.y, qhi.x, qhi.y}; }
        }
    }
    __syncthreads();
}
#undef FRESH
__device__ __forceinline__ void gdn_chain(const Args& a, LAS unsigned char* lds, int lane, int wave, int bh) {
    const int b = bh >> 2, h = bh & 3, s = wave, n = lane & 15, kg = lane >> 4;
    const unsigned char* rec0 = a.ws + WS_GCH + (size_t)(bh * 64) * GCH_STRIDE;
    float* OG = (float*)(a.ws + WS_OG);
    f32x4 S[8];
#pragma unroll
    for (int dt = 0; dt < 8; ++dt) S[dt] = (f32x4){0.f, 0.f, 0.f, 0.f};
#define CH_DMA(ci_, bi_) do { const unsigned char* src_ = rec0 + (size_t)(ci_) * GCH_STRIDE + 32768; _Pragma("unroll") for (int r_ = 0; r_ < 7; ++r_) \
        __builtin_amdgcn_global_load_lds((const unsigned*)(src_ + (r_ * 8 + wave) * 1024 + lane * 16), (LAS unsigned*)(lds + (bi_) * 57344 + (r_ * 8 + wave) * 1024), 16, 0, 0); } while (0)
    f32x4 u[4], un[4]; float egl, egn;
    CH_DMA(0, 0);
#pragma unroll
    for (int mt = 0; mt < 4; ++mt) u[mt] = *(const f32x4*)(rec0 + (size_t)((s * 4 + mt) * 64 + lane) * 16);
    egl = *(const float*)(rec0 + 90112);
    for (int ci = 0; ci < 64; ++ci) {
        VM_WAIT(); __syncthreads();
        if (ci + 1 < 64) { CH_DMA(ci + 1, (ci + 1) & 1); const unsigned char* rn = rec0 + (size_t)(ci + 1) * GCH_STRIDE;
#pragma unroll
            for (int mt = 0; mt < 4; ++mt) un[mt] = *(const f32x4*)(rn + (size_t)((s * 4 + mt) * 64 + lane) * 16);
            egn = *(const float*)(rn + 90112); }
        const LAS unsigned char* bp = lds + (ci & 1) * 57344 + lane * 16;
        bf16x8 Sb[4];
#pragma unroll
        for (int ks = 0; ks < 4; ++ks) Sb[ks] = pack8(S[2 * ks], S[2 * ks + 1]);
        f32x4 vn[4], o[4];
#pragma unroll
        for (int mt = 0; mt < 4; ++mt) { vn[mt] = u[mt]; o[mt] = (f32x4){0.f, 0.f, 0.f, 0.f};
#pragma unroll
            for (int ks = 0; ks < 4; ++ks) { vn[mt] = MFMA16(*(const LAS bf16x8*)(bp + (mt * 4 + ks) * 1024), Sb[ks], vn[mt]); o[mt] = MFMA16(*(const LAS bf16x8*)(bp + 16384 + (mt * 4 + ks) * 1024), Sb[ks], o[mt]); } }
        bf16x8 Vb[2];
        Vb[0] = pack8(vn[0], vn[1]); Vb[1] = pack8(vn[2], vn[3]);
#pragma unroll
        for (int mt = 0; mt < 4; ++mt)
#pragma unroll
            for (int k2 = 0; k2 < 2; ++k2) o[mt] = MFMA16(*(const LAS bf16x8*)(bp + 49152 + (mt * 2 + k2) * 1024), Vb[k2], o[mt]);
#pragma unroll
        for (int dt = 0; dt < 8; ++dt) { S[dt] = S[dt] * egl;
#pragma unroll
            for (int k2 = 0; k2 < 2; ++k2) S[dt] = MFMA16(*(const LAS bf16x8*)(bp + 32768 + (dt * 2 + k2) * 1024), Vb[k2], S[dt]); }
        float* op = OG + ((size_t)b * 4096 + 64 * ci + 4 * kg) * 512 + 128 * h + 16 * s + n;
#pragma unroll
        for (int mt = 0; mt < 4; ++mt)
#pragma unroll
            for (int j = 0; j < 4; ++j) op[(size_t)(16 * mt + j) * 512] = o[mt][j];
#pragma unroll
        for (int mt = 0; mt < 4; ++mt) u[mt] = un[mt];
        egl = egn;
    }
#undef CH_DMA
    float* sp = a.out + O_SP + ((size_t)bh * 128 + 4 * kg) * 128 + 16 * s + n;
#pragma unroll
    for (int dt = 0; dt < 8; ++dt)
#pragma unroll
        for (int j = 0; j < 4; ++j) sp[(size_t)(16 * dt + j) * 128] = S[dt][j];
}

__device__ __forceinline__ void gdn_sample2(const Args& a, LAS unsigned char* lds, int tid, int lane, int wave, int pairitem) {
    const int half = wave >> 2, hw = wave & 3, ht = tid & 255, item = 2 * pairitem + half;
    const int bd = item >> 2, h = item & 3;
    LAS float* raw = (LAS float*)(lds + half * 16384);
    LAS float* nrm = raw + 1536;
    LAS float* gbv = nrm + 16;
    LAS float* red = gbv + 16;
    LAS float* red2 = red + 512;
    const size_t row0 = (size_t)TP + 4 * bd;
    const int rbk = lane >> 5, c4 = lane & 31, r0 = 32 * hw + 16 * rbk;
    f32x4 S[16];
    const float* s0 = a.in[I_GS] + ((size_t)item * 128 + r0) * 128 + 4 * c4;
#pragma unroll
    for (int i = 0; i < 16; ++i) S[i] = *(const f32x4*)(s0 + (size_t)i * 128);
    {   const float* cw = a.in[I_GCW]; const bf16* gqb = (const bf16*)(a.ws + WS_GQKV) + row0 * 1536; const float* stb = a.in[I_GCONV] + (size_t)bd * 3 * 1536;
#pragma unroll
        for (int pp = 0; pp < 2; ++pp) {
            if (pp == 1 && ht >= 128) break;
            const int part = (pp == 0) ? (ht >> 7) : 2, c = ht & 127, col = 512 * part + 128 * h + c;
            const float w0 = cw[col], w1 = cw[1536 + col], w2 = cw[3072 + col], w3 = cw[4608 + col];
            float xp[7]; xp[0] = stb[col]; xp[1] = stb[1536 + col]; xp[2] = stb[3072 + col];
#pragma unroll
            for (int t = 0; t < 4; ++t) xp[3 + t] = bf2f(gqb[(size_t)t * 1536 + col]);
#pragma unroll
            for (int t = 0; t < 4; ++t) { const float y = w0 * xp[t] + w1 * xp[t + 1] + w2 * xp[t + 2] + w3 * xp[t + 3]; const float v = y * __builtin_amdgcn_rcpf(1.0f + __expf(-y)); raw[(part * 4 + t) * 128 + c] = v;
                if (pp == 0) { const float sq = wave_sum(v * v); if (lane == 0) nrm[hw * 4 + t] = sq; } }
        }
        if (ht < 4) { const int t = ht; const float* bap = (const float*)(a.ws + WS_BA) + (row0 + t) * 8; const float bl = bap[h], al = bap[4 + h];
            const float xs = al + a.in[I_DTB][h]; const float sp = fmaxf(xs, 0.f) + log1pf(__expf(-fabsf(xs)));
            gbv[t] = 1.0f / (1.0f + __expf(-bl)); gbv[4 + t] = __expf(-__expf(a.in[I_ALOG][h]) * sp); }
    }
    __syncthreads();
    float* OG = (float*)(a.ws + WS_OG);
    for (int t = 0; t < 4; ++t) {
        const float rq = (1.0f / sqrtf(nrm[t] + nrm[4 + t] + EPS)) * 0.08838834764831845f, rk = 1.0f / sqrtf(nrm[8 + t] + nrm[12 + t] + EPS);
        const float eg = gbv[4 + t], bt = gbv[t];
        const f32x4 v4 = *(const LAS f32x4*)(raw + (8 + t) * 128 + 4 * c4);
        f32x4 p = (f32x4){0.f, 0.f, 0.f, 0.f};
#pragma unroll
        for (int i = 0; i < 16; ++i) p += S[i] * (raw[(4 + t) * 128 + r0 + i] * rk);
#pragma unroll
        for (int e = 0; e < 4; ++e) p[e] += __shfl_xor(p[e], 32);
        if (lane < 32) *(LAS f32x4*)(red + hw * 128 + 4 * c4) = p;
        __syncthreads();
        f32x4 ks = (f32x4){0.f, 0.f, 0.f, 0.f};
#pragma unroll
        for (int w = 0; w < 4; ++w) ks += *(const LAS f32x4*)(red + w * 128 + 4 * c4);
        const f32x4 delta = (v4 - ks * eg) * bt;
        p = (f32x4){0.f, 0.f, 0.f, 0.f};
#pragma unroll
        for (int i = 0; i < 16; ++i) { S[i] = S[i] * eg + delta * (raw[(4 + t) * 128 + r0 + i] * rk); p += S[i] * (raw[t * 128 + r0 + i] * rq); }
#pragma unroll
        for (int e = 0; e < 4; ++e) p[e] += __shfl_xor(p[e], 32);
        if (lane < 32) *(LAS f32x4*)(red2 + hw * 128 + 4 * c4) = p;
        __syncthreads();
        if (hw == 0 && lane < 32) { f32x4 o = (f32x4){0.f, 0.f, 0.f, 0.f};
#pragma unroll
            for (int w = 0; w < 4; ++w) o += *(const LAS f32x4*)(red2 + w * 128 + 4 * c4);
            *(f32x4*)(OG + (row0 + t) * 512 + 128 * h + 4 * c4) = o; }
    }
    float* so = a.out + O_SS + ((size_t)item * 128 + r0) * 128 + 4 * c4;
#pragma unroll
    for (int i = 0; i < 16; ++i) *(f32x4*)(so + (size_t)i * 128) = S[i];
}

__device__ __forceinline__ void attn_sample(const Args& a, LAS unsigned char* lds, int tid, int lane, int wave, int item) {
    const int bd = item >> 2, h = item & 3;
    const int n = lane & 15, kg = lane >> 4, ksl = lane >> 5, c4 = lane & 31;
    const size_t row0 = (size_t)TP + 4 * bd;
    const bf16* DQ = (const bf16*)(a.ws + WS_DQ); const bf16* DK = (const bf16*)(a.ws + WS_DK); const bf16* DV = (const bf16*)(a.ws + WS_DV);
    bf16x8 qf[4];
#pragma unroll
    for (int ks = 0; ks < 4; ++ks) { v4u w = (v4u){0u, 0u, 0u, 0u};
        if (n < 8 && (ks >> 1) == (n >> 2)) { const bf16* qp = DQ + (row0 + (n & 3)) * 512 + 128 * h + 32 * ks + 4 * kg; const v2u lo = *(const v2u*)qp, hi = *(const v2u*)(qp + 16); w = (v4u){lo.x, lo.y, hi.x, hi.y}; }
        qf[ks] = __builtin_bit_cast(bf16x8, w); }
    LAS unsigned char* ps = lds + wave * 1024;
    const float NEG_INF = -__builtin_inff();
    f32x4 mrun = (f32x4){NEG_INF, NEG_INF, NEG_INF, NEG_INF}, lrun = (f32x4){0.f, 0.f, 0.f, 0.f};
    f32x4 O1[4], O2[4];
#pragma unroll
    for (int t = 0; t < 4; ++t) { O1[t] = (f32x4){0.f, 0.f, 0.f, 0.f}; O2[t] = O1[t]; }
    const float* CK = a.in[I_CK]; const float* CV = a.in[I_CV];
    f32x4 kN[8], vN[8], vC[8];
#define AS_LOAD(K_, V_, blk_) do { const int pg_ = a.pt[bd * 16 + 2 * wave + ((blk_) >> 3)]; const size_t kb_ = ((size_t)pg_ * 128 + ((blk_) & 7) * 16) * 512 + 128 * h; \
        const float* kp_ = CK + kb_ + (size_t)n * 512 + 4 * kg; const float* vp_ = CV + kb_ + (size_t)ksl * 512 + 4 * c4; \
        _Pragma("unroll") for (int ks_ = 0; ks_ < 4; ++ks_) { K_[2 * ks_] = __builtin_nontemporal_load((const f32x4*)(kp_ + 32 * ks_)); K_[2 * ks_ + 1] = __builtin_nontemporal_load((const f32x4*)(kp_ + 32 * ks_ + 16)); } \
        _Pragma("unroll") for (int kp2_ = 0; kp2_ < 8; ++kp2_) V_[kp2_] = __builtin_nontemporal_load((const f32x4*)(vp_ + (size_t)kp2_ * 1024)); } while (0)
#define AS_BLOCK(kf_, V_, NEWK) do { \
        f32x4 sc_ = (f32x4){0.f, 0.f, 0.f, 0.f}; \
        _Pragma("unroll") for (int ks_ = 0; ks_ < 4; ++ks_) sc_ = MFMA16(qf[ks_], kf_[ks_], sc_); \
        if (NEWK) { _Pragma("unroll") for (int j_ = 0; j_ < 4; ++j_) if (n > j_) sc_[j_] = NEG_INF; } \
        f32x4 mn_, al_, p_; \
        _Pragma("unroll") for (int j_ = 0; j_ < 4; ++j_) { mn_[j_] = fmaxf(mrun[j_], row16_max(sc_[j_])); al_[j_] = __builtin_amdgcn_exp2f(mrun[j_] - mn_[j_]); p_[j_] = __builtin_amdgcn_exp2f(sc_[j_] - mn_[j_]); \
            lrun[j_] = lrun[j_] * al_[j_] + p_[j_]; mrun[j_] = mn_[j_]; } \
        if (kg < 2) { *(LAS f32x4*)(ps + (n * 2 + kg) * 16) = p_; if (n == 0) *(LAS f32x4*)(ps + 512 + kg * 16) = al_; } \
        LDS_WAIT(); \
        { const f32x4 a1_ = *(const LAS f32x4*)(ps + 512), a2_ = *(const LAS f32x4*)(ps + 528); \
          _Pragma("unroll") for (int t_ = 0; t_ < 4; ++t_) { O1[t_] = O1[t_] * a1_[t_]; O2[t_] = O2[t_] * a2_[t_]; } } \
        _Pragma("unroll") for (int kp_ = 0; kp_ < 8; ++kp_) { const f32x4 p1_ = *(const LAS f32x4*)(ps + ((2 * kp_ + ksl) * 2) * 16), p2_ = *(const LAS f32x4*)(ps + ((2 * kp_ + ksl) * 2 + 1) * 16); \
            _Pragma("unroll") for (int t_ = 0; t_ < 4; ++t_) { O1[t_] += V_[kp_] * p1_[t_]; O2[t_] += V_[kp_] * p2_[t_]; } \
            if (kp_ & 1) asm volatile("" ::: "memory"); } \
        LDS_WAIT(); } while (0)
    AS_LOAD(kN, vN, 0);
    for (int blk = 0; blk < 16; ++blk) {
        bf16x8 kf[4];
#pragma unroll
        for (int ks = 0; ks < 4; ++ks) kf[ks] = pack8(kN[2 * ks], kN[2 * ks + 1]);
#pragma unroll
        for (int kp = 0; kp < 8; ++kp) vC[kp] = vN[kp];
        if (blk + 1 < 16) AS_LOAD(kN, vN, blk + 1);
        AS_BLOCK(kf, vC, false);
    }
    if (wave == 0) {
        bf16x8 kf[4];
#pragma unroll
        for (int ks = 0; ks < 4; ++ks) { v4u w = (v4u){0u, 0u, 0u, 0u};
            if (n < 4) { const bf16* kp = DK + (row0 + n) * 512 + 128 * h + 32 * ks + 4 * kg; const v2u lo = *(const v2u*)kp, hi = *(const v2u*)(kp + 16); w = (v4u){lo.x, lo.y, hi.x, hi.y}; }
            kf[ks] = __builtin_bit_cast(bf16x8, w); }
#pragma unroll
        for (int kp = 0; kp < 8; ++kp) { vC[kp] = (f32x4){0.f, 0.f, 0.f, 0.f};
            if (kp < 2) { const v2u w = *(const v2u*)(DV + (row0 + 2 * kp + ksl) * 512 + 128 * h + 4 * c4); vC[kp] = (f32x4){bflo(w.x), bfhi(w.x), bflo(w.y), bfhi(w.y)}; } }
        AS_BLOCK(kf, vC, true);
    }
#undef AS_LOAD
#undef AS_BLOCK
    LAS float* st = (LAS float*)(lds + 8192) + wave * 16;
    f32x4 ls;
#pragma unroll
    for (int j = 0; j < 4; ++j) ls[j] = row16_sum(lrun[j]);
    if (kg < 2 && n == 0) { *(LAS f32x4*)(st + kg * 4) = mrun; *(LAS f32x4*)(st + 8 + kg * 4) = ls; }
    LAS float* ob = (LAS float*)(lds + 16384) + (size_t)(wave * 2 + ksl) * 1024;
#pragma unroll
    for (int t = 0; t < 4; ++t) { *(LAS f32x4*)(ob + t * 128 + 4 * c4) = O1[t]; *(LAS f32x4*)(ob + (4 + t) * 128 + 4 * c4) = O2[t]; }
    __syncthreads();
    { const int ct = tid >> 6, col = 2 * (tid & 63); const LAS float* sta = (const LAS float*)(lds + 8192);
        float M = NEG_INF;
#pragma unroll
        for (int w = 0; w < 8; ++w) M = fmaxf(M, sta[w * 16 + ct]);
        float L = 0.f, x0 = 0.f, x1 = 0.f;
#pragma unroll
        for (int w = 0; w < 8; ++w) { const float f = __builtin_amdgcn_exp2f(sta[w * 16 + ct] - M); L += sta[w * 16 + 8 + ct] * f;
            const LAS float* o0 = (const LAS float*)(lds + 16384) + (size_t)(w * 2) * 1024 + ct * 128 + col;
            x0 += f * (o0[0] + o0[1024]); x1 += f * (o0[1] + o0[1025]); }
        const float inv = 1.0f / L;
        bf16* dst = (bf16*)(a.ws + ((ct >> 2) ? WS_O2 : WS_O1)) + (row0 + (ct & 3)) * 512 + 128 * h + col;
        *(unsigned*)dst = pk2(x0 * inv, x1 * inv); }
}
__device__ __forceinline__ void p4_combine(const Args& a, int lane, int wave, int vcu, int G) {
    const int gw = vcu * NWAVES + wave, NGW = G * NWAVES;
    const float s1 = wave_sum(a.in[I_LQ1][lane] * a.in[I_LK1][lane]), s2 = wave_sum(a.in[I_LQ2][lane] * a.in[I_LK2][lane]);
    const float lam = __expf(s1) - __expf(s2) + 0.2f;
    const int hc = (8 * lane) & 127;
    const f32x4 gn0 = *(const f32x4*)(a.in[I_GNG] + hc), gn1 = *(const f32x4*)(a.in[I_GNG] + hc + 4), sg0 = *(const f32x4*)(a.in[I_SUBG] + hc), sg1 = *(const f32x4*)(a.in[I_SUBG] + hc + 4);
    const float* OG = (const float*)(a.ws + WS_OG); const bf16* ZB = (const bf16*)(a.ws + WS_ZB); const bf16* O1 = (const bf16*)(a.ws + WS_O1); const bf16* O2 = (const bf16*)(a.ws + WS_O2);
    bf16* AO = (bf16*)(a.ws + WS_AO);
    for (int row = gw; row < MT; row += NGW) {
        const f32x4 g0 = *(const f32x4*)(OG + (size_t)row * 512 + 8 * lane), g1 = *(const f32x4*)(OG + (size_t)row * 512 + 8 * lane + 4);
        const v4u zw = *(const v4u*)(ZB + (size_t)row * 512 + 8 * lane), w1 = *(const v4u*)(O1 + (size_t)row * 512 + 8 * lane), w2 = *(const v4u*)(O2 + (size_t)row * 512 + 8 * lane);
        float ss = (g0[0] * g0[0] + g0[1] * g0[1]) + (g0[2] * g0[2] + g0[3] * g0[3]) + (g1[0] * g1[0] + g1[1] * g1[1]) + (g1[2] * g1[2] + g1[3] * g1[3]);
        ss = row16_sum(ss);
        const float rs = 1.0f / sqrtf(ss * (1.0f / 128.0f) + EPS);
        const float z[8] = {bflo(zw.x), bfhi(zw.x), bflo(zw.y), bfhi(zw.y), bflo(zw.z), bfhi(zw.z), bflo(zw.w), bfhi(zw.w)};
        float og[8];
#pragma unroll
        for (int e = 0; e < 4; ++e) { og[e] = g0[e] * rs * gn0[e]; og[4 + e] = g1[e] * rs * gn1[e]; }
#pragma unroll
        for (int e = 0; e < 8; ++e) og[e] *= z[e] / (1.0f + __expf(-z[e]));
        *(GAS v4u*)(AO + (size_t)row * 1024 + 8 * lane) = (v4u){pk2(og[0], og[1]), pk2(og[2], og[3]), pk2(og[4], og[5]), pk2(og[6], og[7])};
        const float p1[8] = {bflo(w1.x), bfhi(w1.x), bflo(w1.y), bfhi(w1.y), bflo(w1.z), bfhi(w1.z), bflo(w1.w), bfhi(w1.w)};
        const float p2[8] = {bflo(w2.x), bfhi(w2.x), bflo(w2.y), bfhi(w2.y), bflo(w2.z), bfhi(w2.z), bflo(w2.w), bfhi(w2.w)};
        float d[8]; float sd = 0.f;
#pragma unroll
        for (int e = 0; e < 8; ++e) { d[e] = p1[e] - lam * p2[e]; sd += d[e] * d[e]; }
        sd = row16_sum(sd);
        const float rd = (1.0f / sqrtf(sd * (1.0f / 128.0f) + EPS)) * 0.8f;
#pragma unroll
        for (int e = 0; e < 4; ++e) { d[e] *= rd * sg0[e]; d[4 + e] *= rd * sg1[e]; }
        *(GAS v4u*)(AO + (size_t)row * 1024 + 512 + 8 * lane) = (v4u){pk2(d[0], d[1]), pk2(d[2], d[3]), pk2(d[4], d[5]), pk2(d[6], d[7])};
    }
}

__device__ __forceinline__ float gate_mix(float yg, float yv) { return yg / (1.0f + __expf(-yg)) * yv; }
__device__ __forceinline__ void p7_fixup(const Args& a, int tid, int vcu, int G) {
    const float* cw = a.in[I_FCW]; const float* cb = a.in[I_FCB];
    const float* BND = (const float*)(a.ws + WS_BND); const float* US = (const float*)(a.ws + WS_US); bf16* A2 = (bf16*)(a.ws + WS_A2);
    const size_t gt = (size_t)vcu * 512 + tid, NT = (size_t)G * 512;
    for (size_t i = gt; i < (size_t)256 * FF; i += NT) { const int blk = (int)(i / FF), c = (int)(i % FF);
        float ug[4], uv[4];
        const bool first = (blk & 63) == 0;
        ug[0] = first ? 0.f : BND[((size_t)(blk - 1) * 4 + 2) * FF2 + c]; ug[1] = first ? 0.f : BND[((size_t)(blk - 1) * 4 + 3) * FF2 + c];
        uv[0] = first ? 0.f : BND[((size_t)(blk - 1) * 4 + 2) * FF2 + FF + c]; uv[1] = first ? 0.f : BND[((size_t)(blk - 1) * 4 + 3) * FF2 + FF + c];
        ug[2] = BND[((size_t)blk * 4 + 0) * FF2 + c]; ug[3] = BND[((size_t)blk * 4 + 1) * FF2 + c]; uv[2] = BND[((size_t)blk * 4 + 0) * FF2 + FF + c]; uv[3] = BND[((size_t)blk * 4 + 1) * FF2 + FF + c];
        const float g0 = cw[c], g1 = cw[FF2 + c], g2 = cw[2 * FF2 + c], gb = cb[c], v0 = cw[FF + c], v1 = cw[FF2 + FF + c], v2 = cw[2 * FF2 + FF + c], vb = cb[FF + c];
#pragma unroll
        for (int r = 0; r < 2; ++r) { const float yg = g0 * ug[r] + g1 * ug[r + 1] + g2 * ug[r + 2] + gb, yv = v0 * uv[r] + v1 * uv[r + 1] + v2 * uv[r + 2] + vb;
            A2[((size_t)blk * 64 + r) * FF + c] = (bf16)f2bf(gate_mix(yg, yv)); } }
    const float* stf = a.in[I_FCONV];
    for (size_t i = gt; i < (size_t)128 * FF; i += NT) { const int bd = (int)(i / FF), c = (int)(i % FF);
        float ug[6], uv[6];
        ug[0] = stf[((size_t)bd * 2 + 0) * FF2 + c]; ug[1] = stf[((size_t)bd * 2 + 1) * FF2 + c]; uv[0] = stf[((size_t)bd * 2 + 0) * FF2 + FF + c]; uv[1] = stf[((size_t)bd * 2 + 1) * FF2 + FF + c];
#pragma unroll
        for (int t = 0; t < 4; ++t) { ug[2 + t] = US[((size_t)bd * 4 + t) * FF2 + c]; uv[2 + t] = US[((size_t)bd * 4 + t) * FF2 + FF + c]; }
        const float g0 = cw[c], g1 = cw[FF2 + c], g2 = cw[2 * FF2 + c], gb = cb[c], v0 = cw[FF + c], v1 = cw[FF2 + FF + c], v2 = cw[2 * FF2 + FF + c], vb = cb[FF + c];
#pragma unroll
        for (int t = 0; t < 4; ++t) { const float yg = g0 * ug[t] + g1 * ug[t + 1] + g2 * ug[t + 2] + gb, yv = v0 * uv[t] + v1 * uv[t + 1] + v2 * uv[t + 2] + vb;
            A2[((size_t)TP + bd * 4 + t) * FF + c] = (bf16)f2bf(gate_mix(yg, yv)); } }
    for (size_t i = gt; i < (size_t)4 * 2 * FF2; i += NT) { const int b = (int)(i / (2 * FF2)), j = (int)((i / FF2) & 1), c = (int)(i % FF2);
        a.out[O_FCP + i] = BND[((size_t)(64 * b + 63) * 4 + 2 + j) * FF2 + c]; }
    for (size_t i = gt; i < (size_t)128 * 2 * FF2; i += NT) { const int bd = (int)(i / (2 * FF2)), j = (int)((i / FF2) & 1), c = (int)(i % FF2);
        a.out[O_FCS + i] = US[((size_t)bd * 4 + 2 + j) * FF2 + c]; }
}
constexpr int N_PHASES = 10;
constexpr int Q_CHAIN = 16, Q_GS = 256, Q_AS = 512, Q_AP = 1024, Q_TOTAL = Q_CHAIN + Q_GS + Q_AS + Q_AP;
__global__ void __launch_bounds__(NWAVES * 64, 2) mega_fwd(Args args) {
    extern __shared__ __attribute__((aligned(16))) unsigned char lds_raw[];
    LAS unsigned char* lds = (LAS unsigned char*)lds_raw;
    volatile LAS unsigned* MISC = (volatile LAS unsigned*)(lds + MISC_OFF);
    const int tid = threadIdx.x, lane = tid & 63, wave = __builtin_amdgcn_readfirstlane(tid >> 6);
    const int G = gridDim.x; const int bx = blockIdx.x; const int vcu = (G % 8 == 0) ? (bx % 8) * (G / 8) + bx / 8 : bx;
    gu32* ctl = (gu32*)(args.ws + WS_CTL);
    for (int u = tid; u < (LDS_BYTES - LDSCTL_OFF) / 4; u += NWAVES * 64) ((LAS unsigned*)(lds + LDSCTL_OFF))[u] = 0u;
    __syncthreads();
    XcdBarrier bar; bar.bar = (unsigned*)(ctl + CW_BAR); bar.x = 0; bar.st = nullptr;
    if (args.use_bar) bar = xcd_barrier_post((unsigned*)(ctl + CW_BAR), MISC + 8);
    const int lo = args.ph_lo, hi = args.ph_hi;
#ifdef ONLY_PHASE
#define IN(k) ((k) == ONLY_PHASE && lo <= (k) && (k) < hi)
#else
#define IN(k) (lo <= (k) && (k) < hi)
#endif
#define SEAM(k) do { if (IN(k) && IN((k) + 1)) xcd_barrier(bar); } while (0)
#ifndef PROBE_REPEAT
#define PROBE_REPEAT -1
#endif
#define NREP(k) ((PROBE_REPEAT == (k)) ? 2 : 1)

    if (IN(0)) { for (int rep = 0; rep < NREP(0); ++rep) { p0_prologue(args, lds, lane, wave, vcu, G); if (rep + 1 < NREP(0)) xcd_barrier(bar); } }
    SEAM(0);
    if (IN(1)) {
        pg8::Gemm g{(const bf16*)(args.ws + WS_XN), (const bf16*)(args.ws + WS_WIN), MT, NIN, 1024, 1024, 1024}; pg8::StaticOrder S; S.init(MT, NIN, G, bx);
        pg8::EpiIn E{args.ws, args.out, args.in[I_QNG], (long)(args.in[I_KNG] - args.in[I_QNG])};
        for (int rep = 0; rep < NREP(1); ++rep) { pg8::gemm_phase<pg8::EpiIn, pg8::StaticOrder, true, true>(lds, g, S, E); if (rep + 1 < NREP(1)) xcd_barrier(bar); }
    }
    SEAM(1);
    if (IN(2)) { for (int rep = 0; rep < NREP(2); ++rep) { gdn_prep(args, lds, tid, wave, vcu, G); if (rep + 1 < NREP(2)) xcd_barrier(bar); } }
    SEAM(2);
    if (IN(3)) {
      for (int rep = 0; rep < NREP(3); ++rep) {
        for (;;) {
            if (tid == 0) MISC[0] = __hip_atomic_fetch_add((unsigned*)(ctl + CW_Q + 64 * rep), 1u, __ATOMIC_RELAXED, __HIP_MEMORY_SCOPE_AGENT);
            __syncthreads();
            const int item = (int)MISC[0];
            __syncthreads();
            if (item >= Q_TOTAL) break;
            int tq = threadIdx.x; asm volatile("" : "+v"(tq));
            const int lq = tq & 63;
#ifndef ONLY_ITEM
#define ONLY_ITEM -1
#endif
#ifndef PROBE_P3_ONLY
#define PROBE_P3_ONLY -1
#endif
            const int i2 = item - (Q_CHAIN + Q_GS);
            const int ity = item < Q_CHAIN ? 0 : item < Q_CHAIN + Q_GS ? 1 : (i2 < 1024 && (i2 & 1) == 0) ? 2 : 3;
            if (PROBE_P3_ONLY >= 0 && rep == 0 && ity != PROBE_P3_ONLY) continue;
            if (ity == 0) { if (ONLY_ITEM < 0 || ONLY_ITEM == 0) gdn_chain(args, lds, lq, wave, item); }
            else if (ity == 1) { if (ONLY_ITEM < 0 || ONLY_ITEM == 1) gdn_sample2(args, lds, tq, lq, wave, item - Q_CHAIN); }
            else { if (ity == 2) { if (ONLY_ITEM < 0 || ONLY_ITEM == 2) attn_sample(args, lds, tq, lq, wave, i2 >> 1); }
                else if (ONLY_ITEM < 0 || ONLY_ITEM == 3) { const int j = (i2 < 1024) ? (i2 >> 1) : i2 - 512, qb = 15 - (j >> 6), r = j & 63, b = r >> 4, hh = (r >> 2) & 3, c = (r >> 1) & 1, vh = r & 1;
                    const size_t base = (size_t)b * 4096 * 512 + hh * 128;
                    const attn_body::bf16* Qb = (const attn_body::bf16*)(args.ws + WS_DQ) + base + c * 64; const attn_body::bf16* Kh = (const attn_body::bf16*)(args.ws + WS_DK) + base + c * 64;
                    const attn_body::bf16* Vh = (const attn_body::bf16*)(args.ws + WS_DV) + base + vh * 64; attn_body::bf16* Ob = (attn_body::bf16*)(args.ws + (c ? WS_O2 : WS_O1)) + base + vh * 64;
                    attn_body::attn_unit<8>(tq, qb, Qb, Kh, Vh, Ob, (char*)lds_raw); } }
            VM_WAIT();
        }
        if (rep + 1 < NREP(3)) xcd_barrier(bar);
      }
    }
    SEAM(3);
    if (IN(4)) { for (int rep = 0; rep < NREP(4); ++rep) { p4_combine(args, lane, wave, vcu, G); if (rep + 1 < NREP(4)) xcd_barrier(bar); } }
    SEAM(4);
    if (IN(5)) {
        pg8::Gemm g{(const bf16*)(args.ws + WS_AO), (const bf16*)(args.ws + WS_WOUT), MT, 1024, 1024, 1024, 1024}; pg8::StaticOrder S; S.init(MT, 1024, G, bx);
        if (NREP(5) > 1) { pg8::EpiOut E0{args.in[I_XP], args.in[I_XS], args.out + O_Y, (bf16*)(args.ws + WS_HB), (float*)(args.ws + WS_BND)};
            pg8::gemm_phase<pg8::EpiOut, pg8::StaticOrder, true, true>(lds, g, S, E0); xcd_barrier(bar); }
        pg8::EpiOut E{args.in[I_XP], args.in[I_XS], args.out + O_Y, (bf16*)(args.ws + WS_HB), (float*)(ctl + CW_ROWSS)};
        pg8::gemm_phase<pg8::EpiOut, pg8::StaticOrder, true, true>(lds, g, S, E);
    }
    SEAM(5);
    if (IN(6)) {
        pg8::Gemm g{(const bf16*)(args.ws + WS_HB), (const bf16*)(args.ws + WS_WUP), MT, FF2, 1024, 1024, 1024}; pg8::StaticOrder S; S.init(MT, FF2, G, bx);
        pg8::EpiUp E{(bf16*)(args.ws + WS_A2), (float*)(args.ws + WS_BND), (float*)(args.ws + WS_US), (const float*)(ctl + CW_ROWSS), (const float*)(args.ws + WS_CWP)};
        for (int rep = 0; rep < NREP(6); ++rep) { pg8::gemm_phase<pg8::EpiUp, pg8::StaticOrder, true, true>(lds, g, S, E); if (rep + 1 < NREP(6)) xcd_barrier(bar); }
    }
    SEAM(6);
    if (IN(7)) { for (int rep = 0; rep < NREP(7); ++rep) { p7_fixup(args, tid, vcu, G); if (rep + 1 < NREP(7)) xcd_barrier(bar); } }
    SEAM(7);
    if (IN(8)) {
        pg8::Gemm g{(const bf16*)(args.ws + WS_A2), (const bf16*)(args.ws + WS_WDN), MT, 1024, FF, FF, FF}; pg8::DownOrder S; S.init(TP, 1024, G, bx, FF);
        if (NREP(8) > 1) { pg8::EpiDown2 E0{args.out + O_Y, (float*)(args.ws + WS_GCH + 32 * MiB), (float*)(args.ws + WS_GCH)};
            pg8::gemm_phase<pg8::EpiDown2, pg8::DownOrder, true, true>(lds, g, S, E0); xcd_barrier(bar); }
        pg8::EpiDown2 E{args.out + O_Y, args.out + O_Y, (float*)(args.ws + WS_GCH)};
        pg8::gemm_phase<pg8::EpiDown2, pg8::DownOrder, true, true>(lds, g, S, E);
    }
    SEAM(8);
    if (IN(9)) { const float* part = (const float*)(args.ws + WS_GCH); float* ys = args.out + O_Y + (size_t)TP * 1024;
        for (size_t i = (size_t)vcu * 512 + tid; i < (size_t)TSM * 256; i += (size_t)G * 512) { f32x4 v = *(const f32x4*)(ys + 4 * i);
#pragma unroll
            for (int ks = 0; ks < 11; ++ks) v += *(const f32x4*)(part + (size_t)ks * TSM * 1024 + 4 * i);
            *(f32x4*)(ys + 4 * i) = v; } }
#undef IN
#undef SEAM
}

#ifndef MK_N_LAUNCHES
#define MK_N_LAUNCHES 1
#endif
extern "C" void kernel_launch(void* const* d_in, const int* in_sizes, int n_in, void* d_out, int out_size, void* d_ws, size_t ws_size, hipStream_t stream) {
    static int grid = 0;
    if (grid == 0) {
        if (n_in != 27 || out_size != (int)O_END || ws_size < WS_END) { fprintf(stderr, "kernel_launch: unexpected shapes (n_in %d, out %d, ws %zu); nothing launched\n", n_in, out_size, ws_size); grid = -1; return; }
        int dev = 0, cus = 0, per_cu = 0;
        if (hipGetDevice(&dev) != hipSuccess || hipDeviceGetAttribute(&cus, hipDeviceAttributeMultiprocessorCount, dev) != hipSuccess) { grid = -1; return; }
        if (hipFuncSetAttribute((const void*)mega_fwd, hipFuncAttributeMaxDynamicSharedMemorySize, LDS_BYTES) != hipSuccess) { fprintf(stderr, "kernel_launch: hipFuncSetAttribute failed\n"); grid = -1; return; }
        if (hipOccupancyMaxActiveBlocksPerMultiprocessor(&per_cu, (const void*)mega_fwd, NWAVES * 64, LDS_BYTES) != hipSuccess || per_cu < 1) { fprintf(stderr, "kernel_launch: occupancy query says %d blocks per CU\n", per_cu); }
        (void)hipGetLastError();
        grid = cus;
    }
    if (grid < 0) return;
    if (hipMemsetAsync((char*)d_ws + WS_CTL, 0, CTL_ZERO_BYTES, stream) != hipSuccess) return;
    Args a{};
    for (int i = 0; i < 27; ++i) a.in[i] = (const float*)d_in[i];
    a.pt = (const int*)d_in[I_PT]; a.out = (float*)d_out; a.ws = (unsigned char*)d_ws;
    constexpr int NL = MK_N_LAUNCHES;
    for (int li = 0; li < NL; ++li) {
        a.ph_lo = (NL == 1) ? 0 : li; a.ph_hi = (NL == 1) ? N_PHASES : li + 1; a.use_bar = (NL == 1) ? 1 : 0; a.pad = 0;
        hipLaunchKernelGGL(mega_fwd, dim3(grid), dim3(NWAVES * 64), LDS_BYTES, stream, a);
    }
}
```

```cpp
#include <hip/hip_runtime.h>
#include <cstdio>
#include <cstdint>
constexpr int DMODEL = 1024;
constexpr int TP = 16384, TSM = 512, MT = TP + TSM;
constexpr int NIN = 3584, INC = 3592, FF = 2816, FF2 = 5632;
constexpr float EPS = 1e-6f;
constexpr float C2 = 0.125f * 1.4426950408889634f;
constexpr size_t O_Y = 0, O_GCP = 17301504, O_SP = 17319936, O_KP = 17582080, O_VP = 25970688, O_FCP = 34359296, O_GCS = 34404352, O_SS = 34994176, O_KS = 43382784, O_VS = 43644928, O_FCS = 43907072, O_END = 45348864;
constexpr size_t MiB = 1u << 20;
constexpr size_t WS_CTL = 0, CTL_ZERO_BYTES = 1 * MiB;
constexpr size_t WS_WIN = 2 * MiB, WS_WOUT = 10 * MiB, WS_WUP = 12 * MiB, WS_WDN = 24 * MiB;
constexpr size_t WS_CWP = 30 * MiB;
constexpr size_t WS_XN = 32 * MiB, WS_GQKV = 66 * MiB, WS_ZB = 116 * MiB, WS_DQ = 134 * MiB, WS_DK = 151 * MiB, WS_DV = 168 * MiB, WS_BA = 186 * MiB;
constexpr size_t WS_O1 = 188 * MiB, WS_O2 = 205 * MiB, WS_OG = 222 * MiB, WS_AO = 256 * MiB, WS_HB = 290 * MiB, WS_A2 = 324 * MiB, WS_BND = 416 * MiB, WS_US = 440 * MiB, WS_GCH = 452 * MiB, WS_END = 548 * MiB;
constexpr size_t GCH_STRIDE = 98304;
constexpr int CW_TMO = 0, CW_CODE = 1, CW_Q = 64, CW_BAR = 4096, CW_ROWSS = 32768;
namespace pg8 {
#define PG8_LAS __attribute__((address_space(3)))
typedef unsigned short bf16_t;
typedef short bf16x8 __attribute__((ext_vector_type(8)));
typedef float f32x4 __attribute__((ext_vector_type(4)));
typedef unsigned u32x4 __attribute__((ext_vector_type(4)));
constexpr int BM = 256, BK = 64, HALF = 128, HTB = HALF * BK * 2  , STAGE_BYTES = 8 * HTB, NXCD = 8, WGM = 8;

__host__ __device__ __forceinline__ int lds_byte(int r, int c) { const int st = (r >> 4) * 2 + (c >> 5), rr = r & 15, cc = c & 31, ob = rr * 64 + cc * 2; return st * 1024 + (ob ^ (((ob >> 9) & 1) << 5)); }
__host__ __device__ __forceinline__ void stage_rc(int b, int& R, int& C) { const int st = b / 1024, sb = b % 1024, swz = sb ^ (((sb >> 9) & 1) << 5); R = (st >> 1) * 16 + swz / 64; C = (st & 1) * 32 + (swz % 64) / 2; }
__host__ __device__ __forceinline__ int perm32(int rho) { const int n = rho >> 4, i = rho & 15; return 8 * (i >> 2) + 4 * n + (i & 3); }

struct Unit { int pm, pn, koff, nt; };
struct Gemm { const bf16_t* A; const bf16_t* Bt; int M, N, K, lda, ldb; };

struct StaticOrder {
    int nM, nN, nwg, G, c, ntk;
    __host__ __device__ void init(int M, int N, int G_, int c_, int K_ = 1024) { nM = M / BM; nN = N / BM; nwg = nM * nN; G = G_; c = c_; ntk = K_ / BK; }
    __host__ __device__ bool next(int i, Unit& u) const {
        const long L = (long)i * G + c; if (L >= nwg) return false;
        int wgid = (int)L; { const int q = nwg / NXCD, r = nwg % NXCD, xcd = wgid % NXCD, off = wgid / NXCD; wgid = (xcd < r ? xcd * (q + 1) : r * (q + 1) + (xcd - r) * q) + off; }
        const int nig = WGM * nN, gid = wgid / nig, fm = gid * WGM, gsz = (nM - fm) < WGM ? (nM - fm) : WGM;
        u.pm = fm + ((wgid % nig) % gsz); u.pn = (wgid % nig) / gsz; u.koff = 0; u.nt = ntk; return true;
    }
    __device__ __forceinline__ void a_ready(const Unit&) const {}
    __device__ __forceinline__ void done(const Unit&) const {}
};
__device__ __forceinline__ unsigned cvt_pk_bf16(float lo, float hi) { unsigned r; asm volatile("v_cvt_pk_bf16_f32 %0, %1, %2" : "=v"(r) : "v"(lo), "v"(hi)); return r; }
typedef float f32x2 __attribute__((ext_vector_type(2)));
typedef unsigned u32x2 __attribute__((ext_vector_type(2)));
template <int SHR, int ROR> __device__ __forceinline__ float shr_prev(float cur, float prev) {
    const int o = __builtin_amdgcn_mov_dpp(__builtin_bit_cast(int, prev), ROR, 0xf, 0xf, true);
    return __builtin_bit_cast(float, __builtin_amdgcn_update_dpp(o, __builtin_bit_cast(int, cur), SHR, 0xf, 0xf, false)); }
template <int CTRL> __device__ __forceinline__ float dppf(float x) { return __builtin_bit_cast(float, __builtin_amdgcn_mov_dpp(__builtin_bit_cast(int, x), CTRL, 0xf, 0xf, true)); }

struct EpiIn {
    static constexpr bool PERM = true, AFTER_DRAIN = false;
    unsigned char* ws; float* out; const float* gq; long gk_off;
    __device__ __forceinline__ void operator()(const f32x4 (&acc)[2][2][4][2], const Unit& u, int wr, int wc, int fr0, int fq0) const {
        int fr = fr0, fq = fq0; asm volatile("" : "+v"(fr), "+v"(fq));
        const int type = u.pn >> 1, cb = (u.pn & 1) * 256 + 64 * wc + 8 * fq;
        const int row0 = u.pm * BM + wr * 64 + fr;
        const bool samp = u.pm >= 64;
        if (type <= 3) {
            bf16_t* dst = (bf16_t*)(ws + ((type == 3) ? WS_ZB : WS_GQKV + 1024 * (size_t)type)); const int ld = (type == 3) ? 512 : 1536;
#pragma unroll
            for (int ai = 0; ai < 2; ++ai)
#pragma unroll
                for (int m = 0; m < 4; ++m) { const int row = row0 + ai * HALF + m * 16;
#pragma unroll
                    for (int bj = 0; bj < 2; ++bj) { const f32x4 v0 = acc[ai][bj][m][0], v1 = acc[ai][bj][m][1];
                        u32x4 w; w.x = cvt_pk_bf16(v0[0], v0[1]); w.y = cvt_pk_bf16(v0[2], v0[3]); w.z = cvt_pk_bf16(v1[0], v1[1]); w.w = cvt_pk_bf16(v1[2], v1[3]);
                        *(u32x4*)(dst + (size_t)row * ld + cb + 32 * bj) = w;
                        if (type < 3) {
                            float* cs = nullptr;
                            if (samp) { const int r = row - TP, t = r & 3; if (t >= 1) cs = out + O_GCS + ((size_t)(r >> 2) * 3 + (t - 1)) * 1536; }
                            else { const int t = row & 4095; if (t >= 4093) cs = out + O_GCP + ((size_t)(row >> 12) * 3 + (t - 4093)) * 1536; }
                            if (cs) { float* p = cs + 512 * type + cb + 32 * bj; *(f32x4*)p = v0; *(f32x4*)(p + 4) = v1; }
                        } } }
            return;
        }
        const size_t ooff = (type == 5) ? (samp ? O_KS - (size_t)TP * 512 : O_KP) : (samp ? O_VS - (size_t)TP * 512 : O_VP);
        float* ob = (type == 4) ? nullptr : out + ooff;
        bf16_t* bd = (bf16_t*)(ws + WS_DQ + (size_t)(type - 4) * (WS_DK - WS_DQ));
        f32x4 gv[2][2];
#pragma unroll
        for (int bj = 0; bj < 2; ++bj)
#pragma unroll
            for (int n = 0; n < 2; ++n) { const float* gp = gq + ((type == 5) ? gk_off : 0); gv[bj][n] = (type == 6) ? (f32x4){1.f, 1.f, 1.f, 1.f} : *(const f32x4*)(gp + 32 * bj + 8 * fq + 4 * n); }
#pragma unroll
        for (int ai = 0; ai < 2; ++ai)
#pragma unroll
            for (int m = 0; m < 4; ++m) { const int row = row0 + ai * HALF + m * 16;
                float rs = 1.f;
                if (type != 6) { float ss = 0.f;
#pragma unroll
                    for (int bj = 0; bj < 2; ++bj)
#pragma unroll
                        for (int n = 0; n < 2; ++n) { const f32x4 x = acc[ai][bj][m][n]; ss += (x[0] * x[0] + x[1] * x[1]) + (x[2] * x[2] + x[3] * x[3]); }
                    ss += __shfl_xor(ss, 16); ss += __shfl_xor(ss, 32);
                    rs = 1.0f / sqrtf(ss * (1.0f / 64.0f) + EPS); if (type == 4) rs *= C2; }
#pragma unroll
                for (int bj = 0; bj < 2; ++bj) { const f32x4 v0 = acc[ai][bj][m][0] * rs * gv[bj][0], v1 = acc[ai][bj][m][1] * rs * gv[bj][1];
                    u32x4 w; w.x = cvt_pk_bf16(v0[0], v0[1]); w.y = cvt_pk_bf16(v0[2], v0[3]); w.z = cvt_pk_bf16(v1[0], v1[1]); w.w = cvt_pk_bf16(v1[2], v1[3]);
                    *(u32x4*)(bd + (size_t)row * 512 + cb + 32 * bj) = w;
                    if (ob) { float* p = ob + (size_t)row * 512 + cb + 32 * bj; *(f32x4*)p = v0; *(f32x4*)(p + 4) = v1; } } }
    }
};

struct EpiOut {
    static constexpr bool PERM = true, AFTER_DRAIN = false;
    const float* xp; const float* xs; float* y; bf16_t* hb; float* rowss;
    __device__ __forceinline__ void operator()(const f32x4 (&acc)[2][2][4][2], const Unit& u, int wr, int wc, int fr0, int fq0) const {
        int fr = fr0, fq = fq0; asm volatile("" : "+v"(fr), "+v"(fq));
        const int row0 = u.pm * BM + wr * 64 + fr, col0 = u.pn * BM + wc * 32 + 8 * fq;
        const float* xb = (u.pm >= 64) ? xs - (size_t)TP * 1024 : xp;
#pragma unroll
        for (int ai = 0; ai < 2; ++ai)
#pragma unroll
            for (int m = 0; m < 4; ++m) { const int row = row0 + ai * HALF + m * 16; const size_t off = (size_t)row * 1024 + col0; float ss = 0.f;
#pragma unroll
                for (int bj = 0; bj < 2; ++bj) { const f32x4 x0 = *(const f32x4*)(xb + off + bj * HALF), x1 = *(const f32x4*)(xb + off + bj * HALF + 4);
                    const f32x4 v0 = acc[ai][bj][m][0] + x0, v1 = acc[ai][bj][m][1] + x1;
                    *(f32x4*)(y + off + bj * HALF) = v0; *(f32x4*)(y + off + bj * HALF + 4) = v1;
                    u32x4 w; w.x = cvt_pk_bf16(v0[0], v0[1]); w.y = cvt_pk_bf16(v0[2], v0[3]); w.z = cvt_pk_bf16(v1[0], v1[1]); w.w = cvt_pk_bf16(v1[2], v1[3]);
                    *(u32x4*)(hb + off + bj * HALF) = w;
                    ss += (v0[0] * v0[0] + v0[1] * v0[1]) + (v0[2] * v0[2] + v0[3] * v0[3]) + (v1[0] * v1[0] + v1[1] * v1[1]) + (v1[2] * v1[2] + v1[3] * v1[3]); }
                ss += __shfl_xor(ss, 16); ss += __shfl_xor(ss, 32);
                if (fq == 0) atomicAdd(rowss + row, ss); }
    }
};

struct EpiUp {
    static constexpr bool PERM = true, AFTER_DRAIN = false;
    bf16_t* a2; float* bnd; float* us; const float* rowss; const float* cwp;
    __device__ __forceinline__ void operator()(const f32x4 (&acc)[2][2][4][2], const Unit& u, int wr, int wc, int fr0, int fq0) const {
        int fr = fr0, fq = fq0; asm volatile("" : "+v"(fr), "+v"(fq));
        const int gc0 = 128 * u.pn + 32 * wc + 8 * fq;
        if (u.pm >= 64) {
#pragma unroll
            for (int ai = 0; ai < 2; ++ai)
#pragma unroll
                for (int m = 0; m < 4; ++m) { const int row = u.pm * BM + ai * HALF + wr * 64 + m * 16 + fr; const float rs = 1.0f / sqrtf(rowss[row] * (1.0f / 1024.0f) + EPS);
                    float* dst = us + (size_t)(row - TP) * FF2 + gc0;
#pragma unroll
                    for (int bj = 0; bj < 2; ++bj)
#pragma unroll
                        for (int n = 0; n < 2; ++n) *(f32x4*)(dst + bj * FF + 4 * n) = acc[ai][bj][m][n] * rs; }
            return;
        }
#pragma unroll
        for (int ai = 0; ai < 2; ++ai) {
            const int rowb = u.pm * BM + ai * HALF + wr * 64, blk = rowb >> 6;
            float rs[4];
#pragma unroll
            for (int m = 0; m < 4; ++m) rs[m] = 1.0f / sqrtf(rowss[rowb + 16 * m + fr] * (1.0f / 1024.0f) + EPS);
            if (fr < 2) {
#pragma unroll
                for (int n = 0; n < 2; ++n) { float* p = bnd + ((size_t)blk * 4 + fr) * FF2 + gc0 + 4 * n; *(f32x4*)p = acc[ai][0][0][n] * rs[0]; *(f32x4*)(p + FF) = acc[ai][1][0][n] * rs[0]; } }
            if (fr >= 14) {
#pragma unroll
                for (int n = 0; n < 2; ++n) { float* p = bnd + ((size_t)blk * 4 + 2 + (fr - 14)) * FF2 + gc0 + 4 * n; *(f32x4*)p = acc[ai][0][3][n] * rs[3]; *(f32x4*)(p + FF) = acc[ai][1][3][n] * rs[3]; } }
            float res[4][8];
#pragma unroll
            for (int n = 0; n < 2; ++n)
#pragma unroll
                for (int eh = 0; eh < 2; ++eh) {
                    const float* wp = cwp + (size_t)gc0 * 8 + (4 * n + 2 * eh) * 8;
                    const f32x4 wa0 = *(const f32x4*)wp, wa1 = *(const f32x4*)(wp + 4), wb0 = *(const f32x4*)(wp + 8), wb1 = *(const f32x4*)(wp + 12);
                    const float g0[2] = {wa0[0], wb0[0]}, g1[2] = {wa0[1], wb0[1]}, g2[2] = {wa0[2], wb0[2]}, gb[2] = {wa0[3], wb0[3]};
                    const float v0[2] = {wa1[0], wb1[0]}, v1[2] = {wa1[1], wb1[1]}, v2[2] = {wa1[2], wb1[2]}, vb[2] = {wa1[3], wb1[3]};
                    const f32x2 g0v = {g0[0], g0[1]}, g1v = {g1[0], g1[1]}, g2v = {g2[0], g2[1]}, gbv = {gb[0], gb[1]}, v0v = {v0[0], v0[1]}, v1v = {v1[0], v1[1]}, v2v = {v2[0], v2[1]}, vbv = {vb[0], vb[1]};
                    f32x2 pg = {0.f, 0.f}, pv = {0.f, 0.f};
#pragma unroll
                    for (int m = 0; m < 4; ++m) {
                        const f32x2 ug = (f32x2){acc[ai][0][m][n][2 * eh], acc[ai][0][m][n][2 * eh + 1]} * rs[m], uv = (f32x2){acc[ai][1][m][n][2 * eh], acc[ai][1][m][n][2 * eh + 1]} * rs[m];
                        f32x2 g1s, g2s, v1s, v2s;
#pragma unroll
                        for (int e = 0; e < 2; ++e) { g1s[e] = shr_prev<0x111, 0x121>(ug[e], pg[e]); g2s[e] = shr_prev<0x112, 0x122>(ug[e], pg[e]); v1s[e] = shr_prev<0x111, 0x121>(uv[e], pv[e]); v2s[e] = shr_prev<0x112, 0x122>(uv[e], pv[e]); }
                        const f32x2 yg = g0v * g2s + g1v * g1s + g2v * ug + gbv, yv = v0v * v2s + v1v * v1s + v2v * uv + vbv;
#pragma unroll
                        for (int e = 0; e < 2; ++e) { float rr = yg[e] * __builtin_amdgcn_rcpf(1.0f + __expf(-yg[e])) * yv[e]; asm volatile("" : "+v"(rr));
                            res[m][4 * n + 2 * eh + e] = rr; }
                        pg = ug; pv = uv; }
                }
#pragma unroll
            for (int m = 0; m < 4; ++m) if (!(m == 0 && fr < 2)) {
                u32x4 w; w.x = cvt_pk_bf16(res[m][0], res[m][1]); w.y = cvt_pk_bf16(res[m][2], res[m][3]); w.z = cvt_pk_bf16(res[m][4], res[m][5]); w.w = cvt_pk_bf16(res[m][6], res[m][7]);
                *(u32x4*)(a2 + (size_t)(rowb + 16 * m + fr) * FF + gc0) = w; }
            __builtin_amdgcn_sched_barrier(0);
        }
    }
};

struct EpiDown {
    static constexpr bool PERM = true, AFTER_DRAIN = false;
    const float* yin; float* y;
    __device__ __forceinline__ void operator()(const f32x4 (&acc)[2][2][4][2], const Unit& u, int wr, int wc, int fr0, int fq0) const {
        int fr = fr0, fq = fq0; asm volatile("" : "+v"(fr), "+v"(fq));
        const int row0 = u.pm * BM + wr * 64 + fr, col0 = u.pn * BM + wc * 32 + 8 * fq;
#pragma unroll
        for (int ai = 0; ai < 2; ++ai)
#pragma unroll
            for (int m = 0; m < 4; ++m) { const size_t ro = (size_t)(row0 + ai * HALF + m * 16) * 1024 + col0;
#pragma unroll
                for (int bj = 0; bj < 2; ++bj)
#pragma unroll
                    for (int n = 0; n < 2; ++n) { const size_t o = ro + bj * HALF + 4 * n; *(f32x4*)(y + o) = *(const f32x4*)(yin + o) + acc[ai][bj][m][n]; } }
    }
};

struct DownOrder : StaticOrder {
    __device__ __forceinline__ bool next(int i, Unit& u) const { const long L = (long)i * G + c; if (L < nwg) return StaticOrder::next(i, u);
        const int l = (int)(L - nwg); if (l >= 88) return false; u.pm = 64 + l / 44; u.pn = (l / 11) & 3; u.koff = (l % 11) * 256; u.nt = 4; return true; }
};
struct EpiDown2 {
    static constexpr bool PERM = true, AFTER_DRAIN = false;
    const float* yin; float* y; float* part;
    __device__ __forceinline__ void operator()(const f32x4 (&acc)[2][2][4][2], const Unit& u, int wr, int wc, int fr0, int fq0) const {
        int fr = fr0, fq = fq0; asm volatile("" : "+v"(fr), "+v"(fq));
        const int row0 = u.pm * BM + wr * 64 + fr, col0 = u.pn * BM + wc * 32 + 8 * fq;
        const bool samp = u.pm >= 64;
        const float* src = samp ? nullptr : yin;
        float* dst = samp ? part + (size_t)(u.koff >> 8) * 512 * 1024 : y; const size_t adj = samp ? (size_t)TP * 1024 : 0;
#pragma unroll
        for (int ai = 0; ai < 2; ++ai)
#pragma unroll
            for (int m = 0; m < 4; ++m) { const size_t ro = (size_t)(row0 + ai * HALF + m * 16) * 1024 + col0;
#pragma unroll
                for (int bj = 0; bj < 2; ++bj)
#pragma unroll
                    for (int n = 0; n < 2; ++n) { const size_t o = ro + bj * HALF + 4 * n; f32x4 v = acc[ai][bj][m][n]; if (src) v += *(const f32x4*)(src + o); *(f32x4*)(dst + (o - adj)) = v; } }
    }
};

struct SampleOrder {
    int c;
    __device__ __forceinline__ bool next(int i, Unit& u) const { if (i > 0 || c >= 8) return false; u.pm = 64 + (c >> 2); u.pn = c & 3; u.koff = 0; u.nt = 16; return true; }
    __device__ __forceinline__ void a_ready(const Unit&) const {}
    __device__ __forceinline__ void done(const Unit&) const {}
};

template <class Epi, class Sched, bool ALIGN_EPI = false, bool SP2 = false>
__device__ __forceinline__ void gemm_phase(PG8_LAS unsigned char* lds, const Gemm g, const Sched& S, const Epi& E) {
    const int tid = threadIdx.x, wid = __builtin_amdgcn_readfirstlane(tid >> 6), lane = tid & 63, wr = wid >> 2, wc = wid & 3, fr = lane & 15, fq = lane >> 4;
    const int K = g.K, nt = K / BK;
    unsigned voffA[2], voffB[2];
#pragma unroll
    for (int i = 0; i < 2; ++i) { int R, C; stage_rc(tid * 16 + i * 8192, R, C); const int Rb = Epi::PERM ? ((R & ~31) + perm32(R & 31)) : R;
        voffA[i] = (unsigned)(R * g.lda + C) * 2u; voffB[i] = (unsigned)(Rb * g.ldb + C) * 2u; }
    const size_t kstep = (size_t)(BK * 2);
    const size_t hstepA = (size_t)HALF * g.lda * 2, hstepB = (size_t)HALF * g.ldb * 2;
    const size_t tstepA = 2 * hstepA, tstepB = 2 * hstepB;
    const unsigned ldsw = (unsigned)wid * 1024u;
    const int aoff = lds_byte(wr * 64 + fr, fq * 8), boff = lds_byte(wc * 32 + fr, fq * 8);
#define PG8_SA(b, h) (((b) * 2 + (h)) * HTB)
#define PG8_SB(b, h) ((4 + (b) * 2 + (h)) * HTB)
#define PG8_STAGE(bufoff, gbase, voff) do { _Pragma("unroll") for (int _i = 0; _i < 2; ++_i) \
        __builtin_amdgcn_global_load_lds((const unsigned*)((const char*)(gbase) + (voff)[_i]), (PG8_LAS unsigned*)(lds + (bufoff) + ldsw + _i * 8192), 16, 0, 0); } while (0)
#define PG8_LDA(dst, b, h) do { _Pragma("unroll") for (int m = 0; m < 4; ++m) _Pragma("unroll") for (int k = 0; k < 2; ++k) dst[m][k] = *(const PG8_LAS bf16x8*)(lds + PG8_SA(b, h) + aoff + m * 2048 + k * 1024); } while (0)
#define PG8_LDB(dst, b, h) do { _Pragma("unroll") for (int n = 0; n < 2; ++n) _Pragma("unroll") for (int k = 0; k < 2; ++k) dst[n][k] = *(const PG8_LAS bf16x8*)(lds + PG8_SB(b, h) + boff + n * 2048 + k * 1024); } while (0)
#define PG8_MMA(ai, bj, At, Bt) do { __builtin_amdgcn_s_setprio(1); _Pragma("unroll") for (int m = 0; m < 4; ++m) _Pragma("unroll") for (int n = 0; n < 2; ++n) _Pragma("unroll") for (int k = 0; k < 2; ++k) \
        acc[ai][bj][m][n] = __builtin_amdgcn_mfma_f32_16x16x32_bf16(Bt[n][k], At[m][k], acc[ai][bj][m][n], 0, 0, 0); __builtin_amdgcn_s_setprio(0); } while (0)
#define PG8_WAIT_V(n) asm volatile("s_waitcnt vmcnt(" #n ")" ::: "memory")
#define PG8_WAIT_L(n) asm volatile("s_waitcnt lgkmcnt(" #n ")" ::: "memory")
#define PG8_BAR __builtin_amdgcn_s_barrier()
#define PG8_SCHED __builtin_amdgcn_sched_barrier(0)
    Unit cur, nxt; int ui = 0;
    if (!S.next(0, cur)) return;
    f32x4 acc[2][2][4][2];
#pragma unroll
    for (int a = 0; a < 2; ++a)
#pragma unroll
        for (int b = 0; b < 2; ++b)
#pragma unroll
            for (int m = 0; m < 4; ++m)
#pragma unroll
                for (int n = 0; n < 2; ++n) acc[a][b][m][n] = (f32x4){0.f, 0.f, 0.f, 0.f};
    bf16x8 At[4][2], B0[2][2], B1[2][2];
    const char* cA = (const char*)g.A + (size_t)cur.pm * tstepA + (size_t)cur.koff * 2; const char* cB = (const char*)g.Bt + (size_t)cur.pn * tstepB + (size_t)cur.koff * 2;
    S.a_ready(cur);
    if constexpr (SP2) {
        PG8_STAGE(PG8_SB(0, 0), cB, voffB); PG8_STAGE(PG8_SB(0, 1), cB + hstepB, voffB); PG8_STAGE(PG8_SA(0, 0), cA, voffA); PG8_STAGE(PG8_SA(0, 1), cA + hstepA, voffA);
        if (wr == 1) PG8_BAR;
        PG8_WAIT_V(2); PG8_BAR;
        PG8_STAGE(PG8_SB(1, 0), cB + kstep, voffB); PG8_STAGE(PG8_SA(1, 0), cA + kstep, voffA); PG8_STAGE(PG8_SB(1, 1), cB + hstepB + kstep, voffB);
        PG8_WAIT_V(6); PG8_BAR;
    } else {
        PG8_STAGE(PG8_SB(0, 0), cB, voffB); PG8_STAGE(PG8_SA(0, 0), cA, voffA); PG8_STAGE(PG8_SB(0, 1), cB + hstepB, voffB); PG8_STAGE(PG8_SA(0, 1), cA + hstepA, voffA);
        if (wr == 1) PG8_BAR;
        PG8_WAIT_V(4); PG8_BAR;
        PG8_STAGE(PG8_SB(1, 0), cB + kstep, voffB); PG8_STAGE(PG8_SA(1, 0), cA + kstep, voffA); PG8_STAGE(PG8_SB(1, 1), cB + hstepB + kstep, voffB);
        PG8_WAIT_V(6); PG8_BAR;
    }
    for (;;) {
        const bool has_next = S.next(ui + 1, nxt);
        const char* nA = has_next ? (const char*)g.A + (size_t)nxt.pm * tstepA + (size_t)nxt.koff * 2 : cA; const char* nB = has_next ? (const char*)g.Bt + (size_t)nxt.pn * tstepB + (size_t)nxt.koff * 2 : cB;
        const int ntc = cur.nt;
        for (int t = 0; t < ntc; t += 2) {
            const bool last = (t == ntc - 2);
            const char* a1 = cA + (size_t)(t + 1) * kstep;
            const char* a2 = last ? nA : cA + (size_t)(t + 2) * kstep; const char* b2 = last ? nB : cB + (size_t)(t + 2) * kstep;
            const char* a3 = a2 + kstep; const char* b3 = b2 + kstep;
            if (last && has_next) S.a_ready(nxt);
            if constexpr (SP2) {
            PG8_LDB(B0, 0, 0); PG8_LDB(B1, 0, 1); PG8_SCHED; PG8_LDA(At, 0, 0); PG8_STAGE(PG8_SA(1, 1), a1 + hstepA, voffA);
            PG8_WAIT_V(8); PG8_WAIT_L(0); PG8_BAR; PG8_MMA(0, 0, At, B0); PG8_MMA(0, 1, At, B1); PG8_BAR; PG8_SCHED;
            PG8_LDA(At, 0, 1); PG8_STAGE(PG8_SB(0, 0), b2, voffB); PG8_STAGE(PG8_SB(0, 1), b2 + hstepB, voffB); PG8_STAGE(PG8_SA(0, 0), a2, voffA);
            PG8_WAIT_V(8); PG8_WAIT_L(0); PG8_BAR; PG8_MMA(1, 0, At, B0); PG8_MMA(1, 1, At, B1); PG8_BAR; PG8_SCHED;
            PG8_LDB(B0, 1, 0); PG8_LDB(B1, 1, 1); PG8_SCHED; PG8_LDA(At, 1, 0); PG8_STAGE(PG8_SA(0, 1), a2 + hstepA, voffA);
            PG8_WAIT_V(8); PG8_WAIT_L(0); PG8_BAR; PG8_MMA(0, 0, At, B0); PG8_MMA(0, 1, At, B1); PG8_BAR; PG8_SCHED;
            PG8_LDA(At, 1, 1); PG8_STAGE(PG8_SB(1, 0), b3, voffB); PG8_STAGE(PG8_SB(1, 1), b3 + hstepB, voffB); PG8_STAGE(PG8_SA(1, 0), a3, voffA);
            PG8_WAIT_V(8); PG8_WAIT_L(0); PG8_BAR; PG8_MMA(1, 0, At, B0); PG8_MMA(1, 1, At, B1); PG8_BAR; PG8_SCHED;
            } else {
            PG8_LDB(B0, 0, 0); PG8_SCHED; PG8_LDA(At, 0, 0); PG8_STAGE(PG8_SA(1, 1), a1 + hstepA, voffA);
            PG8_WAIT_L(8); PG8_BAR; PG8_WAIT_L(0); PG8_MMA(0, 0, At, B0); PG8_BAR; PG8_SCHED;
            PG8_LDB(B1, 0, 1); PG8_STAGE(PG8_SB(0, 0), b2, voffB);
            PG8_BAR; PG8_WAIT_L(0); PG8_MMA(0, 1, At, B1); PG8_BAR;
            PG8_LDA(At, 0, 1); PG8_STAGE(PG8_SA(0, 0), a2, voffA);
            PG8_BAR; PG8_WAIT_L(0); PG8_MMA(1, 0, At, B0); PG8_BAR; PG8_SCHED;
            PG8_STAGE(PG8_SB(0, 1), b2 + hstepB, voffB);
            PG8_WAIT_V(6); PG8_BAR; PG8_MMA(1, 1, At, B1); PG8_BAR;
            PG8_LDB(B0, 1, 0); PG8_SCHED; PG8_LDA(At, 1, 0); PG8_STAGE(PG8_SA(0, 1), a2 + hstepA, voffA);
            PG8_WAIT_L(8); PG8_BAR; PG8_WAIT_L(0); PG8_MMA(0, 0, At, B0); PG8_BAR; PG8_SCHED;
            PG8_LDB(B1, 1, 1); PG8_STAGE(PG8_SB(1, 0), b3, voffB);
            PG8_BAR; PG8_WAIT_L(0); PG8_MMA(0, 1, At, B1); PG8_BAR;
            PG8_LDA(At, 1, 1); PG8_STAGE(PG8_SA(1, 0), a3, voffA);
            PG8_BAR; PG8_WAIT_L(0); PG8_MMA(1, 0, At, B0); PG8_BAR; PG8_SCHED;
            PG8_STAGE(PG8_SB(1, 1), b3 + hstepB, voffB);
            PG8_WAIT_V(6); PG8_BAR; PG8_MMA(1, 1, At, B1); PG8_BAR;
            }
        }
        if constexpr (ALIGN_EPI) { if (wr == 0) PG8_BAR; }
        if constexpr (!Epi::AFTER_DRAIN) { E(acc, cur, wr, wc, fr, fq); S.done(cur); }
        if (!has_next) break;
#pragma unroll
        for (int a = 0; a < 2; ++a)
#pragma unroll
            for (int b = 0; b < 2; ++b)
#pragma unroll
                for (int m = 0; m < 4; ++m)
#pragma unroll
                    for (int n = 0; n < 2; ++n) acc[a][b][m][n] = (f32x4){0.f, 0.f, 0.f, 0.f};
        cur = nxt; cA = nA; cB = nB; ++ui;
        if constexpr (ALIGN_EPI) { if (wr == 1) PG8_BAR; }
    }
    PG8_WAIT_V(0);
    if constexpr (!ALIGN_EPI) { if (wr == 0) PG8_BAR; }
    PG8_BAR;
    if constexpr (Epi::AFTER_DRAIN) { E.fused(acc, cur, wr, wc, fr, fq, lds, wid, lane); S.done(cur); }
#undef PG8_SA
#undef PG8_SB
#undef PG8_STAGE
#undef PG8_LDA
#undef PG8_LDB
#undef PG8_MMA
#undef PG8_WAIT_V
#undef PG8_WAIT_L
#undef PG8_BAR
#undef PG8_SCHED
}
}
#include <hip/hip_bf16.h>
#include <cmath>
namespace attn_body {
using bf16=__hip_bfloat16;
using bf16x8=__attribute__((ext_vector_type(8)))short;
using s16x4=__attribute__((ext_vector_type(4)))short;
using f32x16=__attribute__((ext_vector_type(16)))float;
using u32x4=__attribute__((ext_vector_type(4)))unsigned;
constexpr int D=64,DM=512;
constexpr int NW=8,QBLK=32,QB=QBLK*NW,KVBLK=64;
constexpr int ATTN_PITCH=DM, ATTN_UNIT_ROWS=QB;
__device__ __forceinline__ int crow(int r,int hi){return (r&3)+8*(r>>2)+4*hi;}
#define SBAR() __builtin_amdgcn_sched_barrier(0)
__device__ __forceinline__ void cmask(f32x16&p0,f32x16&p1,int jb,int qrel,int hi){
  const float NEG=-INFINITY; int kb=64*jb+4*hi;
  #pragma unroll
  for(int r=0;r<16;++r){int kv=kb+(r&3)+8*(r>>2); if(kv>qrel)p0[r]=NEG; if(kv+32>qrel)p1[r]=NEG;}
}

constexpr int NSLOT=3, SLOTB=8192;
constexpr int LDS_K=0, LDS_V=NSLOT*SLOTB, LDS_WS=2*NSLOT*SLOTB, LDS_OST=LDS_WS+NW*64*4, LDS_BYTES=LDS_OST+NW*4096;
constexpr float C2=0.125f*1.4426950408889634f;
__device__ __forceinline__ void glds16(const void*gsrc,unsigned lds_dst){unsigned keep;
  asm volatile("s_mov_b32 %0, m0\n\ts_mov_b32 m0, %2\n\ts_nop 0\n\tglobal_load_lds_dwordx4 %1, off\n\ts_mov_b32 m0, %0":"=&s"(keep):"v"(gsrc),"s"(lds_dst):"memory");}
__device__ __forceinline__ float max3f(float a,float b,float c){float r;asm("v_max3_f32 %0, %1, %2, %3":"=v"(r):"v"(a),"v"(b),"v"(c));return r;}
__device__ __forceinline__ float max2f(float a,float b){float r;asm("v_max_f32_e32 %0, %1, %2":"=v"(r):"v"(a),"v"(b));return r;}
__device__ __forceinline__ float fadd_s(float a,float b){float r;asm("v_add_f32_e32 %0, %1, %2":"=v"(r):"v"(a),"v"(b));return r;}
__device__ __forceinline__ float fsub_s(float a,float b){float r;asm("v_sub_f32_e32 %0, %1, %2":"=v"(r):"v"(a),"v"(b));return r;}
typedef float f32x2_t __attribute__((ext_vector_type(2))); typedef __bf16 bf16x2_t __attribute__((ext_vector_type(2)));
__device__ __forceinline__ unsigned cvtpk_s(float lo,float hi){f32x2_t v={lo,hi};bf16x2_t b=__builtin_convertvector(v,bf16x2_t);return __builtin_bit_cast(unsigned,b);}
#define WAIT_BAR(N) asm volatile("s_waitcnt vmcnt(" #N ") lgkmcnt(0)\n\ts_barrier":::"memory")

__device__ __forceinline__ void qkt(f32x16&p0,f32x16&p1,const char*Kslot,const bf16x8*qr,const f32x16&negm,int r32,int hi){
  const char*kb=Kslot+hi*1024+r32*16;
  #pragma unroll
  for(int d0=0;d0<4;++d0){
    const bf16x8 b0=*reinterpret_cast<const bf16x8*>(kb+d0*2048);
    const bf16x8 b1=*reinterpret_cast<const bf16x8*>(kb+d0*2048+512);
    if(d0==0){p0=__builtin_amdgcn_mfma_f32_32x32x16_bf16(b0,qr[0],negm,0,0,0);p1=__builtin_amdgcn_mfma_f32_32x32x16_bf16(b1,qr[0],negm,0,0,0);}
    else{p0=__builtin_amdgcn_mfma_f32_32x32x16_bf16(b0,qr[d0],p0,0,0,0);p1=__builtin_amdgcn_mfma_f32_32x32x16_bf16(b1,qr[d0],p1,0,0,0);}}
}
typedef __attribute__((address_space(3))) const char* lds_cptr;
typedef short v4i16_t __attribute__((ext_vector_type(4)));
__device__ __forceinline__ void kload8(bf16x8*kf,lds_cptr kp){
  kf[0]=*(const __attribute__((address_space(3))) bf16x8*)(kp);      kf[1]=*(const __attribute__((address_space(3))) bf16x8*)(kp+512);
  kf[2]=*(const __attribute__((address_space(3))) bf16x8*)(kp+2048); kf[3]=*(const __attribute__((address_space(3))) bf16x8*)(kp+2560);
  kf[4]=*(const __attribute__((address_space(3))) bf16x8*)(kp+4096); kf[5]=*(const __attribute__((address_space(3))) bf16x8*)(kp+4608);
  kf[6]=*(const __attribute__((address_space(3))) bf16x8*)(kp+6144); kf[7]=*(const __attribute__((address_space(3))) bf16x8*)(kp+6656);
}
__device__ __forceinline__ void kload2(bf16x8*kf,lds_cptr kp,int j){ kf[2*j]=*(const __attribute__((address_space(3))) bf16x8*)(kp+j*2048); kf[2*j+1]=*(const __attribute__((address_space(3))) bf16x8*)(kp+j*2048+512); }
__device__ __forceinline__ s16x4 vtr(lds_cptr p){ return __builtin_bit_cast(s16x4,__builtin_amdgcn_ds_read_tr16_b64_v4i16((__attribute__((address_space(3))) v4i16_t*)p)); }
__device__ __forceinline__ float rowmax(const f32x16&p0,const f32x16&p1){
  float a=max3f(p0[0],p0[1],p1[0]),b=max3f(p0[2],p0[3],p1[1]);a=max3f(a,p1[2],p1[3]);
  #pragma unroll
  for(int r=4;r<16;r+=4){a=max3f(a,p0[r],p0[r+1]);b=max3f(b,p0[r+2],p0[r+3]);a=max3f(a,p1[r],p1[r+1]);b=max3f(b,p1[r+2],p1[r+3]);}
  const float m=max2f(a,b);
  auto rr=__builtin_amdgcn_permlane32_swap(__float_as_uint(m),__float_as_uint(m),false,false);
  return max2f(__uint_as_float(rr[0]),__uint_as_float(rr[1]));
}
__device__ __forceinline__ void pv(f32x16*o,int vb,bf16x8 pa0,bf16x8 pa1,bf16x8 pa2,bf16x8 pa3){
  #pragma unroll
  for(int d0=0;d0<2;++d0){s16x4 lo[4],hi[4];
    #pragma unroll
    for(int ks=0;ks<4;++ks){
      asm volatile("ds_read_b64_tr_b16 %0,%1 offset:%c2":"=&v"(lo[ks]):"v"(vb),"i"(d0*4096+ks*1024):"memory");
      asm volatile("ds_read_b64_tr_b16 %0,%1 offset:%c2":"=&v"(hi[ks]):"v"(vb),"i"(d0*4096+ks*1024+512):"memory");}
    asm volatile("s_waitcnt lgkmcnt(0)":::"memory");SBAR();
    #define PK(k) (bf16x8){lo[k][0],lo[k][1],lo[k][2],lo[k][3],hi[k][0],hi[k][1],hi[k][2],hi[k][3]}
    o[d0]=__builtin_amdgcn_mfma_f32_32x32x16_bf16(pa0,PK(0),o[d0],0,0,0);
    o[d0]=__builtin_amdgcn_mfma_f32_32x32x16_bf16(pa1,PK(1),o[d0],0,0,0);
    o[d0]=__builtin_amdgcn_mfma_f32_32x32x16_bf16(pa2,PK(2),o[d0],0,0,0);
    o[d0]=__builtin_amdgcn_mfma_f32_32x32x16_bf16(pa3,PK(3),o[d0],0,0,0);
    #undef PK
  }
}

#ifndef ATTN_STORE16
#define ATTN_STORE16(p,v) (*(u32x4*)(p)=(v))
#endif
template<int THRL> __device__ __forceinline__ void attn_unit(int tid_in,int qb,const bf16*Qb,const bf16*__restrict__ Kh,const bf16*__restrict__ Vh,bf16*Ob,char*shm){
  const int tid=tid_in,lane=tid&63,r32=lane&31,hi=lane>>5; const int wid=__builtin_amdgcn_readfirstlane(tid>>6);
  const int q0=qb*QB;
  const bf16*Qw=Qb+(long)(q0+wid*QBLK)*DM;
  const unsigned lds0=(unsigned)(uintptr_t)shm;
  float*wsf=(float*)(shm+LDS_WS)+wid*64;
  const bf16*ksrc=Kh+(long)lane*DM+wid*8;
  const bf16*vsrc=Vh+(long)(16*(wid&3)+(lane>>2))*DM+(wid>>2)*32+(lane&3)*8;
  const unsigned kdst=lds0+LDS_K+wid*1024, vdst=lds0+LDS_V+wid*1024;
  #define DMA_K(t,slot) glds16(ksrc+(long)(t)*KVBLK*DM,(unsigned)__builtin_amdgcn_readfirstlane(kdst+(slot)))
  #define DMA_V(t,slot) glds16(vsrc+(long)(t)*KVBLK*DM,(unsigned)__builtin_amdgcn_readfirstlane(vdst+(slot)))
  const int vb0=(int)(lds0+LDS_V)+((lane>>4)&1)*32+(lane&3)*8+(4*hi+((lane&15)>>2))*64;
  const char*Kbase=shm+LDS_K; bf16x8 kf[8];
  const lds_cptr shm3=(lds_cptr)shm; const lds_cptr kp0=shm3+LDS_K+hi*1024+r32*16; const lds_cptr vp0=shm3+LDS_V+((lane>>4)&1)*32+(lane&3)*8+(4*hi+((lane&15)>>2))*64;
  const int NT=(q0+QB)/KVBLK;
  DMA_K(0,0);DMA_V(0,0);DMA_K(1,SLOTB);
  bf16x8 qr[4];
  #pragma unroll
  for(int d0=0;d0<4;++d0)qr[d0]=*reinterpret_cast<const bf16x8*>(&Qw[(long)r32*DM+d0*16+hi*8]);
  float mhat=0.f,l_reg=0.f;f32x16 o[2];o[0]=f32x16{};o[1]=f32x16{};f32x16 negm=f32x16{};asm volatile("":"+v"(negm));
  const int qrel=wid*QBLK+r32;
  #define CMASK(P0,P1,t) do{int jb_=(t)-(NT-4); if(jb_>=0)cmask(P0,P1,jb_,qrel,hi);}while(0)
  bool resc=false;
  #define START(P0,P1) do{ const float rm=rowmax(P0,P1); resc=false; \
    { const float dl=rm; mhat=fadd_s(mhat,dl); \
      _Pragma("unroll") for(int r=0;r<16;++r){P0[r]=fsub_s(P0[r],dl);P1[r]=fsub_s(P1[r],dl);} \
      _Pragma("unroll") for(int r=0;r<16;++r)negm[r]=-mhat; asm volatile("":"+v"(negm)); } \
    _Pragma("unroll") for(int r=0;r<16;++r)P0[r]=__builtin_amdgcn_exp2f(P0[r]); }while(0)
  #define RESC() do{ if(resc){ asm volatile("s_waitcnt lgkmcnt(0)":::"memory"); \
      _Pragma("unroll") for(int d_=0;d_<2;++d_) _Pragma("unroll") for(int r=0;r<16;++r)o[d_][r]*=wsf[crow(r,hi)]; } }while(0)
  f32x16 pA0,pA1,pB0,pB1;
  int sl_prev=0,sl_cur=0,sl_next=SLOTB;
  #define ROT() do{sl_prev=sl_cur;sl_cur=sl_next;sl_next=(sl_next==(NSLOT-1)*SLOTB)?0:sl_next+SLOTB;}while(0)
  DMA_K(2,2*SLOTB);
  WAIT_BAR(3);
  qkt(pA0,pA1,Kbase,qr,negm,r32,hi);asm volatile("s_nop 15\n\ts_nop 7":"+v"(pA0),"+v"(pA1));CMASK(pA0,pA1,0);
  START(pA0,pA1);
  _Pragma("unroll") for(int r=0;r<16;++r)pA1[r]=__builtin_amdgcn_exp2f(pA1[r]);
  WAIT_BAR(0);
  DMA_K(3,0);DMA_V(1,SLOTB);
  ROT();
  kload8(kf,kp0+sl_cur);
  WAIT_BAR(2);
  s16x4 vlo[8],vhi[8]; u32x4 pw0,pw1,pw2,pw3;
  #define PKW(P,B) cvtpk_s(P[B],P[B+1])
  #define PAF(k) __builtin_bit_cast(bf16x8,pw##k)
  #define VFR(i) (bf16x8){vlo[i][0],vlo[i][1],vlo[i][2],vlo[i][3],vhi[i][0],vhi[i][1],vhi[i][2],vhi[i][3]}
  #define PIN(x) asm volatile("":"+v"(x))
  #define MX3(a,b,c) __builtin_fmaxf(__builtin_fmaxf((a),(b)),(c))
  #define GAPA(MF,A0,A1,A2,A3,W0,W1,PW) do{ MF; sacc+=A0; sacc+=A1; sacc+=A2; sacc+=A3; PIN(sacc); W0; W1; PIN(PW); SBAR(); }while(0)
  #define EX(v) __builtin_amdgcn_exp2f(v)
  #define GAPB(MF,X,B) do{ MF; X[B]=EX(X[B]); X[B+1]=EX(X[B+1]); X[B+2]=EX(X[B+2]); X[B+3]=EX(X[B+3]); PIN(X); SBAR(); }while(0)
  #define VRD(i) do{ vlo[i]=vtr(vp_+(((i)>>2)*4096+((i)&3)*1024)); vhi[i]=vtr(vp_+(((i)>>2)*4096+((i)&3)*1024+512)); }while(0)
  #define KRD(G,j) do{ if(G){ kload2(kf,kp0+sl_next,j); SBAR(); } }while(0)
  #define STEP(C0,C1,P0,P1,t,GK,GV,GL) do{ SBAR(); \
    const lds_cptr vp_=vp0+sl_prev; \
    VRD(0); SBAR(); float sacc=(P0[0]+P0[1]); \
    GAPA(C0=__builtin_amdgcn_mfma_f32_32x32x16_bf16(kf[0],qr[0],negm,0,0,0), P0[2],P0[3],P0[4],P0[5],     pw0[0]=PKW(P0,0), pw0[1]=PKW(P0,2), pw0); \
    VRD(4); SBAR(); GAPA(C1=__builtin_amdgcn_mfma_f32_32x32x16_bf16(kf[1],qr[0],negm,0,0,0), P0[6],P0[7],P0[8],P0[9],     pw0[2]=PKW(P0,4), pw0[3]=PKW(P0,6), pw0); \
    VRD(1); SBAR(); GAPA(C0=__builtin_amdgcn_mfma_f32_32x32x16_bf16(kf[2],qr[1],C0,0,0,0),   P0[10],P0[11],P0[12],P0[13], pw1[0]=PKW(P0,8), pw1[1]=PKW(P0,10), pw1); \
    VRD(5); SBAR(); GAPA(C1=__builtin_amdgcn_mfma_f32_32x32x16_bf16(kf[3],qr[1],C1,0,0,0),   P0[14],P0[15],P1[0],P1[1],   pw1[2]=PKW(P0,12),pw1[3]=PKW(P0,14), pw1); \
    VRD(2); SBAR(); GAPA(C0=__builtin_amdgcn_mfma_f32_32x32x16_bf16(kf[4],qr[2],C0,0,0,0),   P1[2],P1[3],P1[4],P1[5],     pw2[0]=PKW(P1,0), pw2[1]=PKW(P1,2), pw2); \
    VRD(6); SBAR(); GAPA(C1=__builtin_amdgcn_mfma_f32_32x32x16_bf16(kf[5],qr[2],C1,0,0,0),   P1[6],P1[7],P1[8],P1[9],     pw2[2]=PKW(P1,4), pw2[3]=PKW(P1,6), pw2); \
    VRD(3); SBAR(); GAPA(C0=__builtin_amdgcn_mfma_f32_32x32x16_bf16(kf[6],qr[3],C0,0,0,0),   P1[10],P1[11],P1[12],P1[13], pw3[0]=PKW(P1,8), pw3[1]=PKW(P1,10), pw3); \
    VRD(7); SBAR(); GAPA(C1=__builtin_amdgcn_mfma_f32_32x32x16_bf16(kf[7],qr[3],C1,0,0,0),   P1[14],P1[15],0.f,0.f,       pw3[2]=PKW(P1,12),pw3[3]=PKW(P1,14), pw3); \
    l_reg+=sacc; \
    if(GK){DMA_K((t)+3,sl_cur);} if(GV){DMA_V((t)+1,sl_next);} \
    CMASK(C0,C1,t); \
    { float a=MX3(C0[0],C0[1],C1[0]),b=MX3(C0[2],C0[3],C1[1]); a=MX3(a,C1[2],C1[3]); \
      _Pragma("unroll") for(int r=4;r<16;r+=4){a=MX3(a,C0[r],C0[r+1]);b=MX3(b,C0[r+2],C0[r+3]);a=MX3(a,C1[r],C1[r+1]);b=MX3(b,C1[r+2],C1[r+3]);} \
      float rm=__builtin_fmaxf(a,b); { auto rr=__builtin_amdgcn_permlane32_swap(__float_as_uint(rm),__float_as_uint(rm),false,false); rm=__builtin_fmaxf(__uint_as_float(rr[0]),__uint_as_float(rr[1])); } \
      resc=false; \
      if(__builtin_expect(__any(rm>(float)THRL),0)){ const float dl=__builtin_fmaxf(rm,0.f); mhat+=dl; \
        _Pragma("unroll") for(int r=0;r<16;++r){C0[r]-=dl;C1[r]-=dl;} \
        _Pragma("unroll") for(int r=0;r<16;++r)negm[r]=-mhat; asm volatile("":"+v"(negm)); \
        const float f=__builtin_amdgcn_exp2f(-dl); l_reg*=f; if(hi==0)wsf[r32]=f; resc=true; } } \
    SBAR(); \
    GAPB(o[0]=__builtin_amdgcn_mfma_f32_32x32x16_bf16(PAF(0),VFR(0),o[0],0,0,0), C0,0); \
    GAPB(o[1]=__builtin_amdgcn_mfma_f32_32x32x16_bf16(PAF(0),VFR(4),o[1],0,0,0), C0,4); \
    KRD(GL,0); GAPB(o[0]=__builtin_amdgcn_mfma_f32_32x32x16_bf16(PAF(1),VFR(1),o[0],0,0,0), C0,8); \
    KRD(GL,1); GAPB(o[1]=__builtin_amdgcn_mfma_f32_32x32x16_bf16(PAF(1),VFR(5),o[1],0,0,0), C0,12); \
    KRD(GL,2); GAPB(o[0]=__builtin_amdgcn_mfma_f32_32x32x16_bf16(PAF(2),VFR(2),o[0],0,0,0), C1,0); \
    KRD(GL,3); GAPB(o[1]=__builtin_amdgcn_mfma_f32_32x32x16_bf16(PAF(2),VFR(6),o[1],0,0,0), C1,4); \
    GAPB(o[0]=__builtin_amdgcn_mfma_f32_32x32x16_bf16(PAF(3),VFR(3),o[0],0,0,0), C1,8); \
    GAPB(o[1]=__builtin_amdgcn_mfma_f32_32x32x16_bf16(PAF(3),VFR(7),o[1],0,0,0), C1,12); \
    }while(0)
  int t=1;
  #undef CMASK
  #define CMASK(P0,P1,t) do{}while(0)
  for(;t+5<NT;t+=2){
    STEP(pB0,pB1,pA0,pA1,t,true,true,true);     WAIT_BAR(2); RESC(); ROT();
    STEP(pA0,pA1,pB0,pB1,t+1,true,true,true);   WAIT_BAR(2); RESC(); ROT();
  }
  #undef CMASK
  #define CMASK(P0,P1,t) do{int jb_=(t)-(NT-4); if(jb_>=0)cmask(P0,P1,jb_,qrel,hi);}while(0)
  #define ENDW(tt) do{ if((tt)+3<NT){WAIT_BAR(2);} else if((tt)+2<NT){WAIT_BAR(1);} else {WAIT_BAR(0);} }while(0)
  for(;t+1<NT;t+=2){
    STEP(pB0,pB1,pA0,pA1,t,(t+3<NT),(t+1<NT),(t+1<NT));       ENDW(t);   RESC(); ROT();
    STEP(pA0,pA1,pB0,pB1,t+1,(t+4<NT),(t+2<NT),(t+2<NT));     ENDW(t+1); RESC(); ROT();
  }
  STEP(pB0,pB1,pA0,pA1,NT-1,false,false,false); RESC();
  { float sacc=pB0[0]+pB0[1]; _Pragma("unroll") for(int r=2;r<16;++r)sacc+=pB0[r]; _Pragma("unroll") for(int r=0;r<16;++r)sacc+=pB1[r]; l_reg+=sacc;
    pw0=(u32x4){PKW(pB0,0),PKW(pB0,2),PKW(pB0,4),PKW(pB0,6)};pw1=(u32x4){PKW(pB0,8),PKW(pB0,10),PKW(pB0,12),PKW(pB0,14)};pw2=(u32x4){PKW(pB1,0),PKW(pB1,2),PKW(pB1,4),PKW(pB1,6)};pw3=(u32x4){PKW(pB1,8),PKW(pB1,10),PKW(pB1,12),PKW(pB1,14)};
    SBAR(); pv(o,vb0+sl_cur,PAF(0),PAF(1),PAF(2),PAF(3)); }
  #undef PKW
  #undef PAF
  #undef VFR
  #undef PIN
  #undef MX3
  #undef GAPA
  #undef GAPB
  #undef EX
  #undef VRD
  #undef KRD
  #undef STEP
  #undef ENDW
  {auto rr=__builtin_amdgcn_permlane32_swap(__float_as_uint(l_reg),__float_as_uint(l_reg),false,false);l_reg=__uint_as_float(rr[0])+__uint_as_float(rr[1]);}
  if(hi==0)wsf[32+r32]=l_reg;asm volatile("s_waitcnt lgkmcnt(0)":::"memory");
  float rli[16];
  #pragma unroll
  for(int r=0;r<16;++r)rli[r]=__builtin_amdgcn_rcpf(wsf[32+crow(r,hi)]);
  bf16*Ow=Ob+(long)(q0+wid*QBLK)*DM;
  { bf16*stg=(bf16*)(shm+LDS_OST)+wid*2048;
    #pragma unroll
    for(int r=0;r<16;++r){const int orow=crow(r,hi);
      #pragma unroll
      for(int d0=0;d0<2;++d0)stg[orow*64+d0*32+r32]=__float2bfloat16(o[d0][r]*rli[r]);}
    asm volatile("s_waitcnt lgkmcnt(0)":::"memory");
    #pragma unroll
    for(int i=0;i<4;++i){const int row=i*8+(lane>>3),ch=lane&7; const u32x4 v=*(const u32x4*)(stg+row*64+ch*8); ATTN_STORE16(Ow+(long)row*DM+ch*8,v);} }
  asm volatile("s_waitcnt lgkmcnt(0)\n\ts_barrier":::"memory");
  #undef DMA_K
  #undef DMA_V
  #undef CMASK
  #undef START
  #undef RESC
  #undef ROT
}

#undef SBAR
#undef WAIT_BAR
}
#define GAS __attribute__((address_space(1)))
#define LAS __attribute__((address_space(3)))
typedef unsigned short bf16;
typedef unsigned v4u __attribute__((ext_vector_type(4)));
typedef float f32x4 __attribute__((ext_vector_type(4)));
typedef short bf16x8 __attribute__((ext_vector_type(8)));
typedef GAS unsigned gu32;
typedef GAS unsigned long long gu64;
#define RLX_AGENT __ATOMIC_RELAXED, __HIP_MEMORY_SCOPE_AGENT
#define LDS_WAIT() asm volatile("s_waitcnt lgkmcnt(0)" ::: "memory")
#define VM_WAIT() asm volatile("s_waitcnt vmcnt(0)" ::: "memory")
__device__ __forceinline__ unsigned long long rt() { return __builtin_amdgcn_s_memrealtime(); }
__device__ __forceinline__ unsigned f2bf(float f) { unsigned u = __builtin_bit_cast(unsigned, f); return (u + 0x7fffu + ((u >> 16) & 1u)) >> 16; }
__device__ __forceinline__ unsigned pk2(float lo, float hi) { return f2bf(lo) | (f2bf(hi) << 16); }

#define XB_TMO      128
#define XB_XCNT(j)  (256  + 64 * (j))
#define XB_XSUB(j)  (1280 + 64 * (j))
#define XB_XGEN(j)  (2304 + 64 * (j))
#define XB_TOP      3328
#define XB_TOPGEN   3392
#define XCD_BAR_WORDS 3456
#define XB_SPIN_CAP (1u << 18)

__device__ __forceinline__ unsigned xb_ld(unsigned* p)              { return __hip_atomic_load(p, __ATOMIC_RELAXED, __HIP_MEMORY_SCOPE_AGENT); }
__device__ __forceinline__ unsigned xb_add(unsigned* p, unsigned v) { return __hip_atomic_fetch_add(p, v, __ATOMIC_RELAXED, __HIP_MEMORY_SCOPE_AGENT); }
__device__ __forceinline__ unsigned xb_xcc_id() { return (unsigned)__builtin_amdgcn_s_getreg((3 << 11) | 20) & 0xFu; }
#define XB_SPIN(cond, bar) do { unsigned _sp = 0; while (cond) { __builtin_amdgcn_s_sleep(1); \
    if ((++_sp & 255u) == 0u) { if (xb_ld(&(bar)[XB_TMO])) break; if (_sp > XB_SPIN_CAP) { atomicAdd(&(bar)[XB_TMO], 1u); break; } } } } while (0)

struct XcdBarrier {
    unsigned* bar; unsigned x;
    volatile LAS unsigned* st;
};

__device__ __forceinline__ XcdBarrier xcd_barrier_post(unsigned* bar, volatile LAS unsigned* st) {
    XcdBarrier b; b.bar = bar; b.x = xb_xcc_id(); b.st = st;
    if (threadIdx.x == 0) (void)xb_add(&bar[XB_XCNT(b.x)], 1u);
    return b;
}
__device__ __forceinline__ void xcd_barrier_complete(unsigned* bar, unsigned x, unsigned& nloc, unsigned& nx) {
    const unsigned G = gridDim.x * gridDim.y * gridDim.z;
    unsigned sum, cnt, mine, sp = 0u;
    for (;;) {
        sum = 0u; cnt = 0u; mine = 0u;
#pragma unroll
        for (unsigned j = 0; j < 16; ++j) { const unsigned c = xb_ld(&bar[XB_XCNT(j)]); sum += c; cnt += (c > 0u) ? 1u : 0u; mine = (j == x) ? c : mine; }
        if (sum == G) break;
        __builtin_amdgcn_s_sleep(1);
        if ((++sp & 255u) == 0u) { if (xb_ld(&bar[XB_TMO])) break; if (sp > XB_SPIN_CAP) { atomicAdd(&bar[XB_TMO], 1u); break; } }
    }
    nloc = mine > 0u ? mine : 1u; nx = cnt > 0u ? cnt : 1u;
}

__device__ __forceinline__ void xcd_barrier(const XcdBarrier& b) {
    asm volatile("s_waitcnt vmcnt(0)" ::: "memory");
    __syncthreads();
    if (threadIdx.x == 0) {
        unsigned* bar = b.bar;
        __builtin_amdgcn_s_waitcnt(0);
        unsigned nloc = b.st[0], nx = b.st[1];
        if (nloc == 0u) { xcd_barrier_complete(bar, b.x, nloc, nx); b.st[0] = nloc; b.st[1] = nx; }
        const unsigned old = xb_add(&bar[XB_XSUB(b.x)], 1u);
        const unsigned gen = old / nloc;
        if (old + 1u == (gen + 1u) * nloc) {
            __builtin_amdgcn_fence(__ATOMIC_RELEASE, "agent");
            asm volatile("s_waitcnt vmcnt(0)" ::: "memory");
            const unsigned og = xb_add(&bar[XB_TOP], 1u);
            const unsigned tg = og / nx;
            if (og + 1u == (tg + 1u) * nx) xb_add(&bar[XB_TOPGEN], 1u);
            else XB_SPIN(xb_ld(&bar[XB_TOPGEN]) == tg, bar);
            __builtin_amdgcn_fence(__ATOMIC_ACQUIRE, "agent");
            xb_add(&bar[XB_XGEN(b.x)], 1u);
            asm volatile("s_waitcnt vmcnt(0)" ::: "memory");
        } else {
            XB_SPIN(xb_ld(&bar[XB_XGEN(b.x)]) == gen, bar);
            __builtin_amdgcn_fence(__ATOMIC_ACQUIRE, "agent");
            asm volatile("s_waitcnt vmcnt(0)" ::: "memory");
        }
    }
    __syncthreads();
}
struct Args { const float* in[27]; const int* pt; float* out; unsigned char* ws; int ph_lo, ph_hi, use_bar, pad; };
enum { I_XP = 0, I_XS, I_GCONV, I_GS, I_CK, I_CV, I_PT, I_FCONV, I_ANG, I_WIN, I_GCW, I_ALOG, I_DTB, I_GNG, I_QNG, I_KNG, I_LQ1, I_LK1, I_LQ2, I_LK2, I_SUBG, I_WOUT, I_FNG, I_WUP, I_FCW, I_FCB, I_WDN };
constexpr int NWAVES = 8;
constexpr int RING_BYTES = 131072, LDSCTL_OFF = RING_BYTES, MISC_OFF = LDSCTL_OFF + 320, LDS_BYTES = 147456;
typedef unsigned v2u __attribute__((ext_vector_type(2)));
typedef float f32x2v __attribute__((ext_vector_type(2)));

__device__ __forceinline__ float wave_sum(float v) {
#pragma unroll
    for (int o = 1; o < 64; o <<= 1) v += __shfl_xor(v, o);
    return v;
}
__device__ __forceinline__ float frcp(float x) { return __builtin_amdgcn_rcpf(x); }
__device__ __forceinline__ float frsq(float x) { return __builtin_amdgcn_rsqf(x); }
__device__ __forceinline__ float bf2f(bf16 b) { return __uint_as_float(((unsigned)b) << 16); }
__device__ __forceinline__ float bflo(unsigned w) { return __uint_as_float(w << 16); }
__device__ __forceinline__ float bfhi(unsigned w) { return __uint_as_float(w & 0xffff0000u); }
typedef float f32x2_t __attribute__((ext_vector_type(2))); typedef __bf16 bf16x2_t __attribute__((ext_vector_type(2)));
__device__ __forceinline__ unsigned cvtpk(float lo, float hi) { f32x2_t v = {lo, hi}; bf16x2_t b = __builtin_convertvector(v, bf16x2_t); return __builtin_bit_cast(unsigned, b); }
__device__ __forceinline__ bf16 f2bf1(float x) { return (bf16)(cvtpk(x, 0.f) & 0xffffu); }
__device__ __forceinline__ bf16x8 pack8(const f32x4& a, const f32x4& b) { v4u w; w.x = cvtpk(a[0], a[1]); w.y = cvtpk(a[2], a[3]); w.z = cvtpk(b[0], b[1]); w.w = cvtpk(b[2], b[3]); return __builtin_bit_cast(bf16x8, w); }
#define MFMA16(a, b, c) __builtin_amdgcn_mfma_f32_16x16x32_bf16((a), (b), (c), 0, 0, 0)
template <int CTRL> __device__ __forceinline__ float dpp_(float x) { return __builtin_bit_cast(float, __builtin_amdgcn_mov_dpp(__builtin_bit_cast(int, x), CTRL, 0xf, 0xf, true)); }
__device__ __forceinline__ float row16_max(float v) { v = fmaxf(v, dpp_<0xB1>(v)); v = fmaxf(v, dpp_<0x4E>(v)); v = fmaxf(v, dpp_<0x124>(v)); v = fmaxf(v, dpp_<0x128>(v)); return v; }
__device__ __forceinline__ float row16_sum(float v) { v += dpp_<0xB1>(v); v += dpp_<0x4E>(v); v += dpp_<0x124>(v); v += dpp_<0x128>(v); return v; }
template <int N> __device__ __forceinline__ float tred(float (&x)[N], int lane) {
    if constexpr (N == 1) return x[0];
    else { float y[N / 2];
#pragma unroll
        for (int j = 0; j < N / 2; ++j) { const bool up = (lane & (N / 2)) != 0; const float keep = up ? x[j + N / 2] : x[j], send = up ? x[j] : x[j + N / 2]; y[j] = keep + __shfl_xor(send, N / 2); }
        return tred<N / 2>(y, lane); }
}

__device__ __forceinline__ void p0_item(const float* W, int ldw, int src_col0, bf16* WT, int K, int dst_row0, int k0, const float* ksc, LAS float* scr, int lane) {
    { const int r8 = lane >> 3, c4 = lane & 7; f32x4 w[8];
#pragma unroll
      for (int i = 0; i < 8; ++i) w[i] = *(const f32x4*)(W + (size_t)(k0 + 8 * i + r8) * ldw + src_col0 + 4 * c4);
#pragma unroll
      for (int i = 0; i < 8; ++i) { const int kk = 8 * i + r8; f32x4 v = w[i]; if (ksc) v = v * ksc[k0 + kk];
          scr[kk * 33 + 4 * c4] = v[0]; scr[kk * 33 + 4 * c4 + 1] = v[1]; scr[kk * 33 + 4 * c4 + 2] = v[2]; scr[kk * 33 + 4 * c4 + 3] = v[3]; } }
    LDS_WAIT(); asm volatile("" ::: "memory");
    const int c = lane & 7;
#pragma unroll
    for (int j = 0; j < 4; ++j) { const int n = (lane >> 3) + 8 * j; const LAS float* s = scr + (8 * c) * 33 + n;
        v4u o; o.x = cvtpk(s[0 * 33], s[1 * 33]); o.y = cvtpk(s[2 * 33], s[3 * 33]); o.z = cvtpk(s[4 * 33], s[5 * 33]); o.w = cvtpk(s[6 * 33], s[7 * 33]);
        *(GAS v4u*)(WT + (size_t)(dst_row0 + n) * K + k0 + 8 * c) = o; }
    LDS_WAIT(); asm volatile("" ::: "memory");
}
__device__ __forceinline__ void p0_prologue(const Args& a, LAS unsigned char* lds, int lane, int wave, int vcu, int G) {
    LAS float* scr = (LAS float*)(lds + wave * 16384);
    const int gw = vcu * NWAVES + wave, NGW = G * NWAVES;
    bf16* WIN = (bf16*)(a.ws + WS_WIN); bf16* WOUT = (bf16*)(a.ws + WS_WOUT); bf16* WUP = (bf16*)(a.ws + WS_WUP); bf16* WDN = (bf16*)(a.ws + WS_WDN);
    constexpr int N1 = 16 * 112, N2 = 16 * 32, N3 = 16 * 176, N4 = 44 * 32;
    for (int it = gw; it < N1 + N2 + N3 + N4; it += NGW) {
        int r = it;
        if (r < N1) { const int kb = r / 112, nb = r % 112, tile = nb >> 3, wi = nb & 7, bj = wi >> 2, wc = wi & 3, nl = 256 * tile + 64 * wc + 32 * bj, src = nl < 2048 ? nl : nl + 8;
            p0_item(a.in[I_WIN], INC, src, WIN, 1024, 32 * nb, 64 * kb, nullptr, scr, lane); continue; } r -= N1;
        if (r < N2) { const int kb = r / 32, nb = r % 32; p0_item(a.in[I_WOUT], 1024, 32 * nb, WOUT, 1024, 32 * nb, 64 * kb, nullptr, scr, lane); continue; } r -= N2;
        if (r < N3) { const int kb = r / 176, nb = r % 176, tile = nb >> 3, wi = nb & 7, bj = wi >> 2, r32 = wi & 3, src = bj * FF + 128 * tile + 32 * r32;
            p0_item(a.in[I_WUP], FF2, src, WUP, 1024, 32 * nb, 64 * kb, a.in[I_FNG], scr, lane); continue; } r -= N3;
        { const int kb = r / 32, nb = r % 32; p0_item(a.in[I_WDN], 1024, 32 * nb, WDN, FF, 32 * nb, 64 * kb, nullptr, scr, lane); }
    }
    { const float* fcw = a.in[I_FCW]; const float* fcb = a.in[I_FCB]; float* CWP = (float*)(a.ws + WS_CWP);
      for (int c = gw * 64 + lane; c < FF; c += NGW * 64) {
          *(f32x4*)(CWP + (size_t)c * 8) = (f32x4){fcw[c], fcw[FF2 + c], fcw[2 * FF2 + c], fcb[c]};
          *(f32x4*)(CWP + (size_t)c * 8 + 4) = (f32x4){fcw[FF + c], fcw[FF2 + FF + c], fcw[2 * FF2 + FF + c], fcb[FF + c]}; } }
    float wl[16][8], gl[16];
    const float* win = a.in[I_WIN]; const float* ang = a.in[I_ANG];
#pragma unroll
    for (int j = 0; j < 4; ++j)
#pragma unroll
        for (int e = 0; e < 4; ++e) { const int k = 256 * j + 4 * lane + e; const float* wp = win + (size_t)k * INC + 2048; const f32x4 w0 = *(const f32x4*)wp, w1 = *(const f32x4*)(wp + 4);
            wl[4 * j + e][0] = w0[0]; wl[4 * j + e][1] = w0[1]; wl[4 * j + e][2] = w0[2]; wl[4 * j + e][3] = w0[3]; wl[4 * j + e][4] = w1[0]; wl[4 * j + e][5] = w1[1]; wl[4 * j + e][6] = w1[2]; wl[4 * j + e][7] = w1[3];
            gl[4 * j + e] = ang[k]; }
    bf16* XN = (bf16*)(a.ws + WS_XN); float* BA = (float*)(a.ws + WS_BA);
    for (int row = gw; row < MT; row += NGW) {
        const float* xr = row < TP ? a.in[I_XP] + (size_t)row * 1024 : a.in[I_XS] + (size_t)(row - TP) * 1024;
        f32x4 v[4]; float ss = 0.f;
#pragma unroll
        for (int j = 0; j < 4; ++j) { v[j] = *(const f32x4*)(xr + 256 * j + 4 * lane); ss += (v[j][0] * v[j][0] + v[j][1] * v[j][1]) + (v[j][2] * v[j][2] + v[j][3] * v[j][3]); }
        const float rstd = 1.0f / sqrtf(wave_sum(ss) * (1.0f / 1024.0f) + EPS);
        float lg[8] = {0.f, 0.f, 0.f, 0.f, 0.f, 0.f, 0.f, 0.f};
#pragma unroll
        for (int j = 0; j < 4; ++j) { f32x4 xn;
#pragma unroll
            for (int e = 0; e < 4; ++e) { xn[e] = v[j][e] * rstd * gl[4 * j + e];
#pragma unroll
                for (int q = 0; q < 8; ++q) lg[q] += xn[e] * wl[4 * j + e][q]; }
            v2u o; o.x = cvtpk(xn[0], xn[1]); o.y = cvtpk(xn[2], xn[3]); *(GAS v2u*)(XN + (size_t)row * 1024 + 256 * j + 4 * lane) = o; }
        {
            float y4[4], y2[2], y1;
#pragma unroll
            for (int j = 0; j < 4; ++j) { const bool up = (lane & 32) != 0; const float keep = up ? lg[j + 4] : lg[j], send = up ? lg[j] : lg[j + 4]; y4[j] = keep + __shfl_xor(send, 32); }
#pragma unroll
            for (int j = 0; j < 2; ++j) { const bool up = (lane & 16) != 0; const float keep = up ? y4[j + 2] : y4[j], send = up ? y4[j] : y4[j + 2]; y2[j] = keep + __shfl_xor(send, 16); }
            { const bool up = (lane & 8) != 0; const float keep = up ? y2[1] : y2[0], send = up ? y2[0] : y2[1]; y1 = keep + __shfl_xor(send, 8); }
            y1 += __shfl_xor(y1, 4); y1 += __shfl_xor(y1, 2); y1 += __shfl_xor(y1, 1);
            if ((lane & 7) == 0) BA[(size_t)row * 8 + ((lane >> 5) & 1) * 4 + ((lane >> 4) & 1) * 2 + ((lane >> 3) & 1)] = y1; }
    }
}

__device__ __forceinline__ void conv_chan64(const bf16* ub  , int c, const float* cw, int col, bool has_prev, float (&o)[64]) {
    const float w0 = cw[col], w1 = cw[1536 + col], w2 = cw[3072 + col], w3 = cw[4608 + col];
    float x0 = 0.f, x1 = 0.f, x2 = 0.f;
    if (has_prev) { x0 = bf2f((ub - 3 * 1536)[c]); x1 = bf2f((ub - 2 * 1536)[c]); x2 = bf2f((ub - 1536)[c]); }
#pragma unroll
    for (int i = 0; i < 64; ++i) { const float x3 = bf2f((ub + (size_t)i * 1536)[c]); const float y = w0 * x0 + w1 * x1 + w2 * x2 + w3 * x3; o[i] = y * frcp(1.0f + __expf(-y)); x0 = x1; x1 = x2; x2 = x3; }
}
#define FRESH(v_, expr_) int v_ = (expr_); asm volatile("" : "+v"(v_))
__device__ __forceinline__ void gdn_prep(const Args& a, LAS unsigned char* lds, int tid, int wave, int vcu, int G) {
    const int half = wave >> 2, hw = wave & 3;
    LAS unsigned char* hp = lds + half * 57344;
    LAS bf16* q_s = (LAS bf16*)hp; LAS bf16* k_s = (LAS bf16*)(hp + 17408); LAS float* M_s = (LAS float*)(hp + 34816);
    LAS float* part_s = (LAS float*)(hp + 52224); LAS float* beta_s = (LAS float*)(hp + 53248); LAS float* gcum_s = (LAS float*)(hp + 53504);
    const bf16* GQKV = (const bf16*)(a.ws + WS_GQKV); const float* BA = (const float*)(a.ws + WS_BA); const float* cw = a.in[I_GCW];
    const bool roleA = hw < 2;
    for (int pair = vcu; pair < 512; pair += G) {
        const int chunk = 2 * pair + half, bh = chunk >> 6, ci = chunk & 63, b = bh >> 2, h = bh & 3;
        const size_t rb = (size_t)b * 4096 + 64 * ci;
        unsigned char* rec = a.ws + WS_GCH + (size_t)chunk * GCH_STRIDE;
        float xa[64], xb[64];
        {   FRESH(t1, tid); const int lane = t1 & 63, c = t1 & 127;
            float mine;
            if (roleA) { conv_chan64(GQKV + rb * 1536 + 128 * h, c, cw, 128 * h + c, ci > 0, xb);
                { float sq[64];
#pragma unroll
                  for (int i = 0; i < 64; ++i) sq[i] = xb[i] * xb[i];
                  mine = tred<64>(sq, lane); }
                asm volatile("" ::: "memory");
                conv_chan64(GQKV + rb * 1536 + 1024 + 128 * h, c, cw, 1024 + 128 * h + c, ci > 0, xa);
            } else { conv_chan64(GQKV + rb * 1536 + 512 + 128 * h, c, cw, 512 + 128 * h + c, ci > 0, xa);
                float sq[64];
#pragma unroll
                for (int i = 0; i < 64; ++i) sq[i] = xa[i] * xa[i];
                mine = tred<64>(sq, lane);
            }
            part_s[hw * 64 + lane] = mine;
            if (hw == 0) { const float* bap = BA + (rb + lane) * 8; const float bl = bap[h], al = bap[4 + h];
                const float beta = frcp(1.0f + __expf(-bl));
                const float xs = al + a.in[I_DTB][h]; const float sp = fmaxf(xs, 0.f) + log1pf(__expf(-fabsf(xs)));
                float cs = -__expf(a.in[I_ALOG][h]) * sp;
#pragma unroll
                for (int o = 1; o < 64; o <<= 1) { const float t = __shfl_up(cs, o); if (lane >= o) cs += t; }
                beta_s[lane] = beta; gcum_s[lane] = cs; }
        }
        __syncthreads();
        {   FRESH(t2, tid); const int c = t2 & 127;
            if (roleA) {
#pragma unroll
                for (int i = 0; i < 64; ++i) { const float r = frsq(part_s[i] + part_s[64 + i] + EPS) * 0.08838834764831845f; xb[i] *= r; q_s[i * 136 + c] = f2bf1(xb[i]); }
            } else {
#pragma unroll
                for (int i = 0; i < 64; ++i) { const float r = frsq(part_s[128 + i] + part_s[192 + i] + EPS); xa[i] *= r; k_s[i * 136 + c] = f2bf1(xa[i]); }
            }
        }
        __syncthreads();
        {
            FRESH(t3, tid); const int n = t3 & 15, kg = (t3 >> 4) & 3, ti = hw;
            bf16* INTRA = (bf16*)(rec + 81920);
#pragma unroll
            for (int tj = 0; tj < 4; ++tj) {
                f32x4 aK = (f32x4){0.f, 0.f, 0.f, 0.f}, aQ = aK;
                if (tj <= ti) {
#pragma unroll
                    for (int ks = 0; ks < 4; ++ks) {
                        const bf16x8 ak = *(const LAS bf16x8*)(k_s + (16 * ti + n) * 136 + 32 * ks + 8 * kg), aq = *(const LAS bf16x8*)(q_s + (16 * ti + n) * 136 + 32 * ks + 8 * kg);
                        const bf16x8 bk = *(const LAS bf16x8*)(k_s + (16 * tj + n) * 136 + 32 * ks + 8 * kg);
                        aK = MFMA16(ak, bk, aK); aQ = MFMA16(aq, bk, aQ); }
                }
#pragma unroll
                for (int j = 0; j < 4; ++j) { const int i = 16 * ti + 4 * kg + j, jp = 16 * tj + n;
                    const float dec = (i >= jp) ? __expf(fminf(gcum_s[i] - gcum_s[jp], 0.f)) : 0.f;
                    if (tj <= ti) M_s[i * 68 + jp] = (i > jp) ? beta_s[i] * aK[j] * dec : 0.f;
                    INTRA[((ti * 2 + (tj >> 1)) * 64 + (4 * kg + j) + 16 * (n >> 2)) * 8 + 4 * (tj & 1) + (n & 3)] = f2bf1(aQ[j] * dec); }
            }
        }
        __syncthreads();
        {   FRESH(t4, tid); const int c = t4 & 127;
            if (roleA) {
#pragma unroll
                for (int i = 0; i < 64; ++i) { q_s[i * 136 + c] = f2bf1(xb[i] * __expf(gcum_s[i])); xa[i] *= beta_s[i]; }
            } else {
                const float gl = gcum_s[63]; const int dt = c >> 4, m = c & 15;
                unsigned char* KDT = rec + 65536;
#pragma unroll
                for (int ks2 = 0; ks2 < 2; ++ks2)
#pragma unroll
                    for (int kgi = 0; kgi < 4; ++kgi)
#pragma unroll
                        for (int hh = 0; hh < 2; ++hh) { const int t0 = 32 * ks2 + 16 * hh + 4 * kgi;
                            v2u w; w.x = cvtpk(xa[t0] * __expf(gl - gcum_s[t0]), xa[t0 + 1] * __expf(gl - gcum_s[t0 + 1])); w.y = cvtpk(xa[t0 + 2] * __expf(gl - gcum_s[t0 + 2]), xa[t0 + 3] * __expf(gl - gcum_s[t0 + 3]));
                            *(GAS v2u*)(KDT + ((dt * 2 + ks2) * 64 + m + 16 * kgi) * 16 + hh * 8) = w; }
                if (c == 0) *(float*)(rec + 90112) = __expf(gl);
#pragma unroll
                for (int i = 0; i < 64; ++i) xa[i] *= beta_s[i] * __expf(gcum_s[i]);
            }
        }
#pragma unroll
        for (int i = 1; i < 64; ++i) { float acc = xa[i];
#pragma unroll
            for (int j4 = 0; j4 <= (i - 1) / 4; ++j4) { const f32x4 mr = *(const LAS f32x4*)(M_s + i * 68 + 4 * j4);
                acc -= mr[0] * xa[4 * j4]; if (4 * j4 + 1 < i) acc -= mr[1] * xa[4 * j4 + 1]; if (4 * j4 + 2 < i) acc -= mr[2] * xa[4 * j4 + 2]; if (4 * j4 + 3 < i) acc -= mr[3] * xa[4 * j4 + 3]; }
            xa[i] = acc; }
        {   FRESH(t5, tid); const int c = t5 & 127;
            if (roleA) { float* U = (float*)rec; const int s = c >> 4, n = c & 15;
#pragma unroll
                for (int mt = 0; mt < 4; ++mt)
#pragma unroll
                    for (int kgi = 0; kgi < 4; ++kgi) *(f32x4*)(U + (((s * 4 + mt) * 64 + n + 16 * kgi) * 4)) = (f32x4){xa[16 * mt + 4 * kgi], xa[16 * mt + 4 * kgi + 1], xa[16 * mt + 4 * kgi + 2], xa[16 * mt + 4 * kgi + 3]};
            } else {
#pragma unroll
                for (int i = 0; i < 64; ++i) k_s[i * 136 + c] = f2bf1(-xa[i]);
            }
        }
        __syncthreads();
        {   FRESH(t6, tid); const int ht = t6 & 255;
#pragma unroll
            for (int rep = 0; rep < 4; ++rep) { const int idx = ht + 256 * rep, mt = idx >> 8, ks = (idx >> 6) & 3, l = idx & 63, m = l & 15, kgi = l >> 4, row = 16 * mt + m;
                const v2u wlo = *(const LAS v2u*)(k_s + row * 136 + 32 * ks + 4 * kgi), whi = *(const LAS v2u*)(k_s + row * 136 + 32 * ks + 16 + 4 * kgi);
                *(GAS v4u*)(rec + 32768 + (size_t)idx * 16) = (v4u){wlo.x, wlo.y, whi.x, whi.y};
                const v2u qlo = *(const LAS v2u*)(q_s + row * 136 + 32 * ks + 4 * kgi), qhi = *(const LAS v2u*)(q_s + row * 136 + 32 * ks + 16 + 4 * kgi);
                *(GAS v4u*)(rec + 49152 + (size_t)idx * 16) = (v4u){qlo.x, qlo.y, qhi.x, qhi.y}; }
        }
    }
    __syncthreads();
}
#undef FRESH
__device__ __forceinline__ void gdn_chain(const Args& a, LAS unsigned char* lds, int lane, int wave, int bh) {
    const int b = bh >> 2, h = bh & 3, s = wave, n = lane & 15, kg = lane >> 4;
    const unsigned char* rec0 = a.ws + WS_GCH + (size_t)(bh * 64) * GCH_STRIDE;
    float* OG = (float*)(a.ws + WS_OG);
    f32x4 S[8];
#pragma unroll
    for (int dt = 0; dt < 8; ++dt) S[dt] = (f32x4){0.f, 0.f, 0.f, 0.f};
#define CH_DMA(ci_, bi_) do { const unsigned char* src_ = rec0 + (size_t)(ci_) * GCH_STRIDE + 32768; _Pragma("unroll") for (int r_ = 0; r_ < 7; ++r_) \
        __builtin_amdgcn_global_load_lds((const unsigned*)(src_ + (r_ * 8 + wave) * 1024 + lane * 16), (LAS unsigned*)(lds + (bi_) * 57344 + (r_ * 8 + wave) * 1024), 16, 0, 0); } while (0)
    f32x4 u[4], un[4]; float egl, egn;
    CH_DMA(0, 0);
#pragma unroll
    for (int mt = 0; mt < 4; ++mt) u[mt] = *(const f32x4*)(rec0 + (size_t)((s * 4 + mt) * 64 + lane) * 16);
    egl = *(const float*)(rec0 + 90112);
    for (int ci = 0; ci < 64; ++ci) {
        VM_WAIT(); __syncthreads();
        if (ci + 1 < 64) { CH_DMA(ci + 1, (ci + 1) & 1); const unsigned char* rn = rec0 + (size_t)(ci + 1) * GCH_STRIDE;
#pragma unroll
            for (int mt = 0; mt < 4; ++mt) un[mt] = *(const f32x4*)(rn + (size_t)((s * 4 + mt) * 64 + lane) * 16);
            egn = *(const float*)(rn + 90112); }
        const LAS unsigned char* bp = lds + (ci & 1) * 57344 + lane * 16;
        bf16x8 Sb[4];
#pragma unroll
        for (int ks = 0; ks < 4; ++ks) Sb[ks] = pack8(S[2 * ks], S[2 * ks + 1]);
        f32x4 vn[4], o[4];
#pragma unroll
        for (int mt = 0; mt < 4; ++mt) { vn[mt] = u[mt]; o[mt] = (f32x4){0.f, 0.f, 0.f, 0.f};
#pragma unroll
            for (int ks = 0; ks < 4; ++ks) { vn[mt] = MFMA16(*(const LAS bf16x8*)(bp + (mt * 4 + ks) * 1024), Sb[ks], vn[mt]); o[mt] = MFMA16(*(const LAS bf16x8*)(bp + 16384 + (mt * 4 + ks) * 1024), Sb[ks], o[mt]); } }
        bf16x8 Vb[2];
        Vb[0] = pack8(vn[0], vn[1]); Vb[1] = pack8(vn[2], vn[3]);
#pragma unroll
        for (int mt = 0; mt < 4; ++mt)
#pragma unroll
            for (int k2 = 0; k2 < 2; ++k2) o[mt] = MFMA16(*(const LAS bf16x8*)(bp + 49152 + (mt * 2 + k2) * 1024), Vb[k2], o[mt]);
#pragma unroll
        for (int dt = 0; dt < 8; ++dt) { S[dt] = S[dt] * egl;
#pragma unroll
            for (int k2 = 0; k2 < 2; ++k2) S[dt] = MFMA16(*(const LAS bf16x8*)(bp + 32768 + (dt * 2 + k2) * 1024), Vb[k2], S[dt]); }
        float* op = OG + ((size_t)b * 4096 + 64 * ci + 4 * kg) * 512 + 128 * h + 16 * s + n;
#pragma unroll
        for (int mt = 0; mt < 4; ++mt)
#pragma unroll
            for (int j = 0; j < 4; ++j) op[(size_t)(16 * mt + j) * 512] = o[mt][j];
#pragma unroll
        for (int mt = 0; mt < 4; ++mt) u[mt] = un[mt];
        egl = egn;
    }
#undef CH_DMA
    float* sp = a.out + O_SP + ((size_t)bh * 128 + 4 * kg) * 128 + 16 * s + n;
#pragma unroll
    for (int dt = 0; dt < 8; ++dt)
#pragma unroll
        for (int j = 0; j < 4; ++j) sp[(size_t)(16 * dt + j) * 128] = S[dt][j];
}

__device__ __forceinline__ void gdn_sample2(const Args& a, LAS unsigned char* lds, int tid, int lane, int wave, int pairitem) {
    const int half = wave >> 2, hw = wave & 3, ht = tid & 255, item = 2 * pairitem + half;
    const int bd = item >> 2, h = item & 3;
    LAS float* raw = (LAS float*)(lds + half * 16384);
    LAS float* nrm = raw + 1536;
    LAS float* gbv = nrm + 16;
    LAS float* red = gbv + 16;
    LAS float* red2 = red + 512;
    const size_t row0 = (size_t)TP + 4 * bd;
    const int rbk = lane >> 5, c4 = lane & 31, r0 = 32 * hw + 16 * rbk;
    f32x4 S[16];
    const float* s0 = a.in[I_GS] + ((size_t)item * 128 + r0) * 128 + 4 * c4;
#pragma unroll
    for (int i = 0; i < 16; ++i) S[i] = *(const f32x4*)(s0 + (size_t)i * 128);
    {   const float* cw = a.in[I_GCW]; const bf16* gqb = (const bf16*)(a.ws + WS_GQKV) + row0 * 1536; const float* stb = a.in[I_GCONV] + (size_t)bd * 3 * 1536;
#pragma unroll
        for (int pp = 0; pp < 2; ++pp) {
            if (pp == 1 && ht >= 128) break;
            const int part = (pp == 0) ? (ht >> 7) : 2, c = ht & 127, col = 512 * part + 128 * h + c;
            const float w0 = cw[col], w1 = cw[1536 + col], w2 = cw[3072 + col], w3 = cw[4608 + col];
            float xp[7]; xp[0] = stb[col]; xp[1] = stb[1536 + col]; xp[2] = stb[3072 + col];
#pragma unroll
            for (int t = 0; t < 4; ++t) xp[3 + t] = bf2f(gqb[(size_t)t * 1536 + col]);
#pragma unroll
            for (int t = 0; t < 4; ++t) { const float y = w0 * xp[t] + w1 * xp[t + 1] + w2 * xp[t + 2] + w3 * xp[t + 3]; const float v = y * __builtin_amdgcn_rcpf(1.0f + __expf(-y)); raw[(part * 4 + t) * 128 + c] = v;
                if (pp == 0) { const float sq = wave_sum(v * v); if (lane == 0) nrm[hw * 4 + t] = sq; } }
        }
        if (ht < 4) { const int t = ht; const float* bap = (const float*)(a.ws + WS_BA) + (row0 + t) * 8; const float bl = bap[h], al = bap[4 + h];
            const float xs = al + a.in[I_DTB][h]; const float sp = fmaxf(xs, 0.f) + log1pf(__expf(-fabsf(xs)));
            gbv[t] = 1.0f / (1.0f + __expf(-bl)); gbv[4 + t] = __expf(-__expf(a.in[I_ALOG][h]) * sp); }
    }
    __syncthreads();
    float* OG = (float*)(a.ws + WS_OG);
    for (int t = 0; t < 4; ++t) {
        const float rq = (1.0f / sqrtf(nrm[t] + nrm[4 + t] + EPS)) * 0.08838834764831845f, rk = 1.0f / sqrtf(nrm[8 + t] + nrm[12 + t] + EPS);
        const float eg = gbv[4 + t], bt = gbv[t];
        const f32x4 v4 = *(const LAS f32x4*)(raw + (8 + t) * 128 + 4 * c4);
        f32x4 p = (f32x4){0.f, 0.f, 0.f, 0.f};
#pragma unroll
        for (int i = 0; i < 16; ++i) p += S[i] * (raw[(4 + t) * 128 + r0 + i] * rk);
#pragma unroll
        for (int e = 0; e < 4; ++e) p[e] += __shfl_xor(p[e], 32);
        if (lane < 32) *(LAS f32x4*)(red + hw * 128 + 4 * c4) = p;
        __syncthreads();
        f32x4 ks = (f32x4){0.f, 0.f, 0.f, 0.f};
#pragma unroll
        for (int w = 0; w < 4; ++w) ks += *(const LAS f32x4*)(red + w * 128 + 4 * c4);
        const f32x4 delta = (v4 - ks * eg) * bt;
        p = (f32x4){0.f, 0.f, 0.f, 0.f};
#pragma unroll
        for (int i = 0; i < 16; ++i) { S[i] = S[i] * eg + delta * (raw[(4 + t) * 128 + r0 + i] * rk); p += S[i] * (raw[t * 128 + r0 + i] * rq); }
#pragma unroll
        for (int e = 0; e < 4; ++e) p[e] += __shfl_xor(p[e], 32);
        if (lane < 32) *(LAS f32x4*)(red2 + hw * 128 + 4 * c4) = p;
        __syncthreads();
        if (hw == 0 && lane < 32) { f32x4 o = (f32x4){0.f, 0.f, 0.f, 0.f};
#pragma unroll
            for (int w = 0; w < 4; ++w) o += *(const LAS f32x4*)(red2 + w * 128 + 4 * c4);
            *(f32x4*)(OG + (row0 + t) * 512 + 128 * h + 4 * c4) = o; }
    }
    float* so = a.out + O_SS + ((size_t)item * 128 + r0) * 128 + 4 * c4;
#pragma unroll
    for (int i = 0; i < 16; ++i) *(f32x4*)(so + (size_t)i * 128) = S[i];
}

__device__ __forceinline__ void attn_sample(const Args& a, LAS unsigned char* lds, int tid, int lane, int wave, int item) {
    const int bd = item >> 2, h = item & 3;
    const int n = lane & 15, kg = lane >> 4, ksl = lane >> 5, c4 = lane & 31;
    const size_t row0 = (size_t)TP + 4 * bd;
    const bf16* DQ = (const bf16*)(a.ws + WS_DQ); const bf16* DK = (const bf16*)(a.ws + WS_DK); const bf16* DV = (const bf16*)(a.ws + WS_DV);
    bf16x8 qf[4];
#pragma unroll
    for (int ks = 0; ks < 4; ++ks) { v4u w = (v4u){0u, 0u, 0u, 0u};
        if (n < 8 && (ks >> 1) == (n >> 2)) { const bf16* qp = DQ + (row0 + (n & 3)) * 512 + 128 * h + 32 * ks + 4 * kg; const v2u lo = *(const v2u*)qp, hi = *(const v2u*)(qp + 16); w = (v4u){lo.x, lo.y, hi.x, hi.y}; }
        qf[ks] = __builtin_bit_cast(bf16x8, w); }
    LAS unsigned char* ps = lds + wave * 1024;
    const float NEG_INF = -__builtin_inff();
    f32x4 mrun = (f32x4){NEG_INF, NEG_INF, NEG_INF, NEG_INF}, lrun = (f32x4){0.f, 0.f, 0.f, 0.f};
    f32x4 O1[4], O2[4];
#pragma unroll
    for (int t = 0; t < 4; ++t) { O1[t] = (f32x4){0.f, 0.f, 0.f, 0.f}; O2[t] = O1[t]; }
    const float* CK = a.in[I_CK]; const float* CV = a.in[I_CV];
    f32x4 kN[8], vN[8], vC[8];
#define AS_LOAD(K_, V_, blk_) do { const int pg_ = a.pt[bd * 16 + 2 * wave + ((blk_) >> 3)]; const size_t kb_ = ((size_t)pg_ * 128 + ((blk_) & 7) * 16) * 512 + 128 * h; \
        const float* kp_ = CK + kb_ + (size_t)n * 512 + 4 * kg; const float* vp_ = CV + kb_ + (size_t)ksl * 512 + 4 * c4; \
        _Pragma("unroll") for (int ks_ = 0; ks_ < 4; ++ks_) { K_[2 * ks_] = __builtin_nontemporal_load((const f32x4*)(kp_ + 32 * ks_)); K_[2 * ks_ + 1] = __builtin_nontemporal_load((const f32x4*)(kp_ + 32 * ks_ + 16)); } \
        _Pragma("unroll") for (int kp2_ = 0; kp2_ < 8; ++kp2_) V_[kp2_] = __builtin_nontemporal_load((const f32x4*)(vp_ + (size_t)kp2_ * 1024)); } while (0)
#define AS_BLOCK(kf_, V_, NEWK) do { \
        f32x4 sc_ = (f32x4){0.f, 0.f, 0.f, 0.f}; \
        _Pragma("unroll") for (int ks_ = 0; ks_ < 4; ++ks_) sc_ = MFMA16(qf[ks_], kf_[ks_], sc_); \
        if (NEWK) { _Pragma("unroll") for (int j_ = 0; j_ < 4; ++j_) if (n > j_) sc_[j_] = NEG_INF; } \
        f32x4 mn_, al_, p_; \
        _Pragma("unroll") for (int j_ = 0; j_ < 4; ++j_) { mn_[j_] = fmaxf(mrun[j_], row16_max(sc_[j_])); al_[j_] = __builtin_amdgcn_exp2f(mrun[j_] - mn_[j_]); p_[j_] = __builtin_amdgcn_exp2f(sc_[j_] - mn_[j_]); \
            lrun[j_] = lrun[j_] * al_[j_] + p_[j_]; mrun[j_] = mn_[j_]; } \
        if (kg < 2) { *(LAS f32x4*)(ps + (n * 2 + kg) * 16) = p_; if (n == 0) *(LAS f32x4*)(ps + 512 + kg * 16) = al_; } \
        LDS_WAIT(); \
        { const f32x4 a1_ = *(const LAS f32x4*)(ps + 512), a2_ = *(const LAS f32x4*)(ps + 528); \
          _Pragma("unroll") for (int t_ = 0; t_ < 4; ++t_) { O1[t_] = O1[t_] * a1_[t_]; O2[t_] = O2[t_] * a2_[t_]; } } \
        _Pragma("unroll") for (int kp_ = 0; kp_ < 8; ++kp_) { const f32x4 p1_ = *(const LAS f32x4*)(ps + ((2 * kp_ + ksl) * 2) * 16), p2_ = *(const LAS f32x4*)(ps + ((2 * kp_ + ksl) * 2 + 1) * 16); \
            _Pragma("unroll") for (int t_ = 0; t_ < 4; ++t_) { O1[t_] += V_[kp_] * p1_[t_]; O2[t_] += V_[kp_] * p2_[t_]; } \
            if (kp_ & 1) asm volatile("" ::: "memory"); } \
        LDS_WAIT(); } while (0)
    AS_LOAD(kN, vN, 0);
    for (int blk = 0; blk < 16; ++blk) {
        bf16x8 kf[4];
#pragma unroll
        for (int ks = 0; ks < 4; ++ks) kf[ks] = pack8(kN[2 * ks], kN[2 * ks + 1]);
#pragma unroll
        for (int kp = 0; kp < 8; ++kp) vC[kp] = vN[kp];
        if (blk + 1 < 16) AS_LOAD(kN, vN, blk + 1);
        AS_BLOCK(kf, vC, false);
    }
    if (wave == 0) {
        bf16x8 kf[4];
#pragma unroll
        for (int ks = 0; ks < 4; ++ks) { v4u w = (v4u){0u, 0u, 0u, 0u};
            if (n < 4) { const bf16* kp = DK + (row0 + n) * 512 + 128 * h + 32 * ks + 4 * kg; const v2u lo = *(const v2u*)kp, hi = *(const v2u*)(kp + 16); w = (v4u){lo.x, lo.y, hi.x, hi.y}; }
            kf[ks] = __builtin_bit_cast(bf16x8, w); }
#pragma unroll
        for (int kp = 0; kp < 8; ++kp) { vC[kp] = (f32x4){0.f, 0.f, 0.f, 0.f};
            if (kp < 2) { const v2u w = *(const v2u*)(DV + (row0 + 2 * kp + ksl) * 512 + 128 * h + 4 * c4); vC[kp] = (f32x4){bflo(w.x), bfhi(w.x), bflo(w.y), bfhi(w.y)}; } }
        AS_BLOCK(kf, vC, true);
    }
#undef AS_LOAD
#undef AS_BLOCK
    LAS float* st = (LAS float*)(lds + 8192) + wave * 16;
    f32x4 ls;
#pragma unroll
    for (int j = 0; j < 4; ++j) ls[j] = row16_sum(lrun[j]);
    if (kg < 2 && n == 0) { *(LAS f32x4*)(st + kg * 4) = mrun; *(LAS f32x4*)(st + 8 + kg * 4) = ls; }
    LAS float* ob = (LAS float*)(lds + 16384) + (size_t)(wave * 2 + ksl) * 1024;
#pragma unroll
    for (int t = 0; t < 4; ++t) { *(LAS f32x4*)(ob + t * 128 + 4 * c4) = O1[t]; *(LAS f32x4*)(ob + (4 + t) * 128 + 4 * c4) = O2[t]; }
    __syncthreads();
    { const int ct = tid >> 6, col = 2 * (tid & 63); const LAS float* sta = (const LAS float*)(lds + 8192);
        float M = NEG_INF;
#pragma unroll
        for (int w = 0; w < 8; ++w) M = fmaxf(M, sta[w * 16 + ct]);
        float L = 0.f, x0 = 0.f, x1 = 0.f;
#pragma unroll
        for (int w = 0; w < 8; ++w) { const float f = __builtin_amdgcn_exp2f(sta[w * 16 + ct] - M); L += sta[w * 16 + 8 + ct] * f;
            const LAS float* o0 = (const LAS float*)(lds + 16384) + (size_t)(w * 2) * 1024 + ct * 128 + col;
            x0 += f * (o0[0] + o0[1024]); x1 += f * (o0[1] + o0[1025]); }
        const float inv = 1.0f / L;
        bf16* dst = (bf16*)(a.ws + ((ct >> 2) ? WS_O2 : WS_O1)) + (row0 + (ct & 3)) * 512 + 128 * h + col;
        *(unsigned*)dst = pk2(x0 * inv, x1 * inv); }
}
__device__ __forceinline__ void p4_row(const Args& a, int lane, int row, float lam, const f32x4& gn0, const f32x4& gn1, const f32x4& sg0, const f32x4& sg1) {
    const float* OG = (const float*)(a.ws + WS_OG); const bf16* ZB = (const bf16*)(a.ws + WS_ZB); const bf16* O1 = (const bf16*)(a.ws + WS_O1); const bf16* O2 = (const bf16*)(a.ws + WS_O2);
    bf16* AO = (bf16*)(a.ws + WS_AO);
    const f32x4 g0 = *(const f32x4*)(OG + (size_t)row * 512 + 8 * lane), g1 = *(const f32x4*)(OG + (size_t)row * 512 + 8 * lane + 4);
    const v4u zw = *(const v4u*)(ZB + (size_t)row * 512 + 8 * lane), w1 = *(const v4u*)(O1 + (size_t)row * 512 + 8 * lane), w2 = *(const v4u*)(O2 + (size_t)row * 512 + 8 * lane);
    float ss = (g0[0] * g0[0] + g0[1] * g0[1]) + (g0[2] * g0[2] + g0[3] * g0[3]) + (g1[0] * g1[0] + g1[1] * g1[1]) + (g1[2] * g1[2] + g1[3] * g1[3]);
    ss = row16_sum(ss);
    const float rs = frsq(ss * (1.0f / 128.0f) + EPS);
    const float z[8] = {bflo(zw.x), bfhi(zw.x), bflo(zw.y), bfhi(zw.y), bflo(zw.z), bfhi(zw.z), bflo(zw.w), bfhi(zw.w)};
    float og[8];
#pragma unroll
    for (int e = 0; e < 4; ++e) { og[e] = g0[e] * rs * gn0[e]; og[4 + e] = g1[e] * rs * gn1[e]; }
#pragma unroll
    for (int e = 0; e < 8; ++e) og[e] *= z[e] * frcp(1.0f + __expf(-z[e]));
    const v4u oa = (v4u){cvtpk(og[0], og[1]), cvtpk(og[2], og[3]), cvtpk(og[4], og[5]), cvtpk(og[6], og[7])};
    const float p1[8] = {bflo(w1.x), bfhi(w1.x), bflo(w1.y), bfhi(w1.y), bflo(w1.z), bfhi(w1.z), bflo(w1.w), bfhi(w1.w)};
    const float p2[8] = {bflo(w2.x), bfhi(w2.x), bflo(w2.y), bfhi(w2.y), bflo(w2.z), bfhi(w2.z), bflo(w2.w), bfhi(w2.w)};
    float d[8]; float sd = 0.f;
#pragma unroll
    for (int e = 0; e < 8; ++e) { d[e] = p1[e] - lam * p2[e]; sd += d[e] * d[e]; }
    sd = row16_sum(sd);
    const float rd = frsq(sd * (1.0f / 128.0f) + EPS) * 0.8f;
#pragma unroll
    for (int e = 0; e < 4; ++e) { d[e] *= rd * sg0[e]; d[4 + e] *= rd * sg1[e]; }
    const v4u ob = (v4u){cvtpk(d[0], d[1]), cvtpk(d[2], d[3]), cvtpk(d[4], d[5]), cvtpk(d[6], d[7])};
    *(GAS v4u*)(AO + (size_t)row * 1024 + 8 * lane) = oa; *(GAS v4u*)(AO + (size_t)row * 1024 + 512 + 8 * lane) = ob;
}
__device__ __forceinline__ void p4_combine(const Args& a, int lane, int row0, int row_end, int stride) {
    const float s1 = wave_sum(a.in[I_LQ1][lane] * a.in[I_LK1][lane]), s2 = wave_sum(a.in[I_LQ2][lane] * a.in[I_LK2][lane]);
    const float lam = __expf(s1) - __expf(s2) + 0.2f;
    const int hc = (8 * lane) & 127;
    const f32x4 gn0 = *(const f32x4*)(a.in[I_GNG] + hc), gn1 = *(const f32x4*)(a.in[I_GNG] + hc + 4), sg0 = *(const f32x4*)(a.in[I_SUBG] + hc), sg1 = *(const f32x4*)(a.in[I_SUBG] + hc + 4);
    for (int row = row0; row < row_end; row += stride) p4_row(a, lane, row, lam, gn0, gn1, sg0, sg1);
}

__device__ __forceinline__ float gate_mix(float yg, float yv) { return yg * frcp(1.0f + __expf(-yg)) * yv; }
__device__ __forceinline__ void p7_fixup(const Args& a, int tid, int vcu, int G) {
    const float* cw = a.in[I_FCW]; const float* cb = a.in[I_FCB];
    const float* BND = (const float*)(a.ws + WS_BND); const float* US = (const float*)(a.ws + WS_US); bf16* A2 = (bf16*)(a.ws + WS_A2);
    const size_t gt = (size_t)vcu * 512 + tid, NT = (size_t)G * 512;
    for (size_t i = gt; i < (size_t)256 * FF; i += NT) { const int blk = (int)(i / FF), c = (int)(i % FF);
        float ug[4], uv[4];
        const bool first = (blk & 63) == 0;
        ug[0] = first ? 0.f : BND[((size_t)(blk - 1) * 4 + 2) * FF2 + c]; ug[1] = first ? 0.f : BND[((size_t)(blk - 1) * 4 + 3) * FF2 + c];
        uv[0] = first ? 0.f : BND[((size_t)(blk - 1) * 4 + 2) * FF2 + FF + c]; uv[1] = first ? 0.f : BND[((size_t)(blk - 1) * 4 + 3) * FF2 + FF + c];
        ug[2] = BND[((size_t)blk * 4 + 0) * FF2 + c]; ug[3] = BND[((size_t)blk * 4 + 1) * FF2 + c]; uv[2] = BND[((size_t)blk * 4 + 0) * FF2 + FF + c]; uv[3] = BND[((size_t)blk * 4 + 1) * FF2 + FF + c];
        const float g0 = cw[c], g1 = cw[FF2 + c], g2 = cw[2 * FF2 + c], gb = cb[c], v0 = cw[FF + c], v1 = cw[FF2 + FF + c], v2 = cw[2 * FF2 + FF + c], vb = cb[FF + c];
#pragma unroll
        for (int r = 0; r < 2; ++r) { const float yg = g0 * ug[r] + g1 * ug[r + 1] + g2 * ug[r + 2] + gb, yv = v0 * uv[r] + v1 * uv[r + 1] + v2 * uv[r + 2] + vb;
            A2[((size_t)blk * 64 + r) * FF + c] = (bf16)f2bf(gate_mix(yg, yv)); } }
    const float* stf = a.in[I_FCONV];
    for (size_t i = gt; i < (size_t)128 * FF; i += NT) { const int bd = (int)(i / FF), c = (int)(i % FF);
        float ug[6], uv[6];
        ug[0] = stf[((size_t)bd * 2 + 0) * FF2 + c]; ug[1] = stf[((size_t)bd * 2 + 1) * FF2 + c]; uv[0] = stf[((size_t)bd * 2 + 0) * FF2 + FF + c]; uv[1] = stf[((size_t)bd * 2 + 1) * FF2 + FF + c];
#pragma unroll
        for (int t = 0; t < 4; ++t) { ug[2 + t] = US[((size_t)bd * 4 + t) * FF2 + c]; uv[2 + t] = US[((size_t)bd * 4 + t) * FF2 + FF + c]; }
        const float g0 = cw[c], g1 = cw[FF2 + c], g2 = cw[2 * FF2 + c], gb = cb[c], v0 = cw[FF + c], v1 = cw[FF2 + FF + c], v2 = cw[2 * FF2 + FF + c], vb = cb[FF + c];
#pragma unroll
        for (int t = 0; t < 4; ++t) { const float yg = g0 * ug[t] + g1 * ug[t + 1] + g2 * ug[t + 2] + gb, yv = v0 * uv[t] + v1 * uv[t + 1] + v2 * uv[t + 2] + vb;
            A2[((size_t)TP + bd * 4 + t) * FF + c] = (bf16)f2bf(gate_mix(yg, yv)); } }
    for (size_t i = gt; i < (size_t)4 * 2 * FF2; i += NT) { const int b = (int)(i / (2 * FF2)), j = (int)((i / FF2) & 1), c = (int)(i % FF2);
        a.out[O_FCP + i] = BND[((size_t)(64 * b + 63) * 4 + 2 + j) * FF2 + c]; }
    for (size_t i = gt; i < (size_t)128 * 2 * FF2; i += NT) { const int bd = (int)(i / (2 * FF2)), j = (int)((i / FF2) & 1), c = (int)(i % FF2);
        a.out[O_FCS + i] = US[((size_t)bd * 4 + 2 + j) * FF2 + c]; }
}
constexpr int N_PHASES = 10;
constexpr int Q_CHAIN = 16, Q_GS = 256, Q_AS = 512, Q_AP = 1024, Q_TOTAL = Q_CHAIN + Q_GS + Q_AS + Q_AP;
__global__ void __launch_bounds__(NWAVES * 64, 2) mega_fwd(Args args) {
    extern __shared__ __attribute__((aligned(16))) unsigned char lds_raw[];
    LAS unsigned char* lds = (LAS unsigned char*)lds_raw;
    volatile LAS unsigned* MISC = (volatile LAS unsigned*)(lds + MISC_OFF);
    const int tid = threadIdx.x, lane = tid & 63, wave = __builtin_amdgcn_readfirstlane(tid >> 6);
    const int G = gridDim.x; const int bx = blockIdx.x; const int vcu = (G % 8 == 0) ? (bx % 8) * (G / 8) + bx / 8 : bx;
    gu32* ctl = (gu32*)(args.ws + WS_CTL);
    for (int u = tid; u < (LDS_BYTES - LDSCTL_OFF) / 4; u += NWAVES * 64) ((LAS unsigned*)(lds + LDSCTL_OFF))[u] = 0u;
    __syncthreads();
    XcdBarrier bar; bar.bar = (unsigned*)(ctl + CW_BAR); bar.x = 0; bar.st = nullptr;
    if (args.use_bar) bar = xcd_barrier_post((unsigned*)(ctl + CW_BAR), MISC + 8);
    const int lo = args.ph_lo, hi = args.ph_hi;
#ifdef ONLY_PHASE
#define IN(k) ((k) == ONLY_PHASE && lo <= (k) && (k) < hi)
#else
#define IN(k) (lo <= (k) && (k) < hi)
#endif
#define SEAM(k) do { if (IN(k) && IN((k) + 1)) xcd_barrier(bar); } while (0)
#ifndef PROBE_REPEAT
#define PROBE_REPEAT -1
#endif
#define NREP(k) ((PROBE_REPEAT == (k)) ? 2 : 1)

    if (IN(0)) { for (int rep = 0; rep < NREP(0); ++rep) { p0_prologue(args, lds, lane, wave, vcu, G); if (rep + 1 < NREP(0)) xcd_barrier(bar); } }
    SEAM(0);
    if (IN(1)) {
        pg8::Gemm g{(const bf16*)(args.ws + WS_XN), (const bf16*)(args.ws + WS_WIN), MT, NIN, 1024, 1024, 1024}; pg8::StaticOrder S; S.init(MT, NIN, G, bx);
        pg8::EpiIn E{args.ws, args.out, args.in[I_QNG], (long)(args.in[I_KNG] - args.in[I_QNG])};
        for (int rep = 0; rep < NREP(1); ++rep) { pg8::gemm_phase<pg8::EpiIn, pg8::StaticOrder, true, true>(lds, g, S, E); if (rep + 1 < NREP(1)) xcd_barrier(bar); }
    }
    SEAM(1);
    if (IN(2)) { for (int rep = 0; rep < NREP(2); ++rep) { gdn_prep(args, lds, tid, wave, vcu, G); if (rep + 1 < NREP(2)) xcd_barrier(bar); } }
    SEAM(2);
    if (IN(3)) {
      for (int rep = 0; rep < NREP(3); ++rep) {
        for (;;) {
            if (tid == 0) MISC[0] = __hip_atomic_fetch_add((unsigned*)(ctl + CW_Q + 64 * rep), 1u, __ATOMIC_RELAXED, __HIP_MEMORY_SCOPE_AGENT);
            __syncthreads();
            const int item = (int)MISC[0];
            __syncthreads();
            if (item >= Q_TOTAL) break;
            int tq = threadIdx.x; asm volatile("" : "+v"(tq));
            const int lq = tq & 63;
#ifndef ONLY_ITEM
#define ONLY_ITEM -1
#endif
#ifndef PROBE_P3_ONLY
#define PROBE_P3_ONLY -1
#endif
            const int i2 = item - (Q_CHAIN + Q_GS);
            const bool isS = i2 < 1024 && (i2 & 1) == 0; const int sidx = i2 >> 1, pidx = (i2 < 1024) ? (i2 >> 1) : i2 - 512;
            const int ity = item < Q_CHAIN ? 0 : item < Q_CHAIN + Q_GS ? 1 : isS ? 2 : 3;
            if (PROBE_P3_ONLY >= 0 && rep == 0 && ity != PROBE_P3_ONLY) continue;
            if (ity == 0) { if (ONLY_ITEM < 0 || ONLY_ITEM == 0) gdn_chain(args, lds, lq, wave, item); }
            else if (ity == 1) { if (ONLY_ITEM < 0 || ONLY_ITEM == 1) gdn_sample2(args, lds, tq, lq, wave, item - Q_CHAIN); }
            else { if (ity == 2) { if (ONLY_ITEM < 0 || ONLY_ITEM == 2) attn_sample(args, lds, tq, lq, wave, sidx); }
                else if (ONLY_ITEM < 0 || ONLY_ITEM == 3) { const int j = pidx, qb = 15 - (j >> 6), r = j & 63, b = r >> 4, hh = (r >> 2) & 3, c = (r >> 1) & 1, vh = r & 1;
                    const size_t base = (size_t)b * 4096 * 512 + hh * 128;
                    const attn_body::bf16* Qb = (const attn_body::bf16*)(args.ws + WS_DQ) + base + c * 64; const attn_body::bf16* Kh = (const attn_body::bf16*)(args.ws + WS_DK) + base + c * 64;
                    const attn_body::bf16* Vh = (const attn_body::bf16*)(args.ws + WS_DV) + base + vh * 64; attn_body::bf16* Ob = (attn_body::bf16*)(args.ws + (c ? WS_O2 : WS_O1)) + base + vh * 64;
                    attn_body::attn_unit<8>(tq, qb, Qb, Kh, Vh, Ob, (char*)lds_raw); } }
            VM_WAIT();
        }
        if (rep + 1 < NREP(3)) xcd_barrier(bar);
      }
    }
    SEAM(3);
    if (IN(4)) { for (int rep = 0; rep < NREP(4); ++rep) { p4_combine(args, lane, vcu * NWAVES + wave, MT, G * NWAVES); if (rep + 1 < NREP(4)) xcd_barrier(bar); } }
    SEAM(4);
    if (IN(5)) {
        pg8::Gemm g{(const bf16*)(args.ws + WS_AO), (const bf16*)(args.ws + WS_WOUT), MT, 1024, 1024, 1024, 1024}; pg8::StaticOrder S; S.init(MT, 1024, G, bx);
        if (NREP(5) > 1) { pg8::EpiOut E0{args.in[I_XP], args.in[I_XS], args.out + O_Y, (bf16*)(args.ws + WS_HB), (float*)(args.ws + WS_BND)};
            pg8::gemm_phase<pg8::EpiOut, pg8::StaticOrder, true, true>(lds, g, S, E0); xcd_barrier(bar); }
        pg8::EpiOut E{args.in[I_XP], args.in[I_XS], args.out + O_Y, (bf16*)(args.ws + WS_HB), (float*)(ctl + CW_ROWSS)};
        pg8::gemm_phase<pg8::EpiOut, pg8::StaticOrder, true, true>(lds, g, S, E);
    }
    SEAM(5);
    if (IN(6)) {
        pg8::Gemm g{(const bf16*)(args.ws + WS_HB), (const bf16*)(args.ws + WS_WUP), MT, FF2, 1024, 1024, 1024}; pg8::StaticOrder S; S.init(MT, FF2, G, bx);
        pg8::EpiUp E{(bf16*)(args.ws + WS_A2), (float*)(args.ws + WS_BND), (float*)(args.ws + WS_US), (const float*)(ctl + CW_ROWSS), (const float*)(args.ws + WS_CWP)};
        for (int rep = 0; rep < NREP(6); ++rep) { pg8::gemm_phase<pg8::EpiUp, pg8::StaticOrder, true, true>(lds, g, S, E); if (rep + 1 < NREP(6)) xcd_barrier(bar); }
    }
    SEAM(6);
    if (IN(7)) { for (int rep = 0; rep < NREP(7); ++rep) { p7_fixup(args, tid, vcu, G); if (rep + 1 < NREP(7)) xcd_barrier(bar); } }
    SEAM(7);
    if (IN(8)) {
        pg8::Gemm g{(const bf16*)(args.ws + WS_A2), (const bf16*)(args.ws + WS_WDN), MT, 1024, FF, FF, FF}; pg8::DownOrder S; S.init(TP, 1024, G, bx, FF);
        if (NREP(8) > 1) { pg8::EpiDown2 E0{args.out + O_Y, (float*)(args.ws + WS_GCH + 32 * MiB), (float*)(args.ws + WS_GCH)};
            pg8::gemm_phase<pg8::EpiDown2, pg8::DownOrder, true, true>(lds, g, S, E0); xcd_barrier(bar); }
        pg8::EpiDown2 E{args.out + O_Y, args.out + O_Y, (float*)(args.ws + WS_GCH)};
        pg8::gemm_phase<pg8::EpiDown2, pg8::DownOrder, true, true>(lds, g, S, E);
    }
    SEAM(8);
    if (IN(9)) { const float* part = (const float*)(args.ws + WS_GCH); float* ys = args.out + O_Y + (size_t)TP * 1024;
        for (size_t i = (size_t)vcu * 512 + tid; i < (size_t)TSM * 256; i += (size_t)G * 512) { f32x4 v = *(const f32x4*)(ys + 4 * i);
#pragma unroll
            for (int ks = 0; ks < 11; ++ks) v += *(const f32x4*)(part + (size_t)ks * TSM * 1024 + 4 * i);
            *(f32x4*)(ys + 4 * i) = v; } }
#undef IN
#undef SEAM
}

#ifndef MK_N_LAUNCHES
#define MK_N_LAUNCHES 1
#endif
extern "C" void kernel_launch(void* const* d_in, const int* in_sizes, int n_in, void* d_out, int out_size, void* d_ws, size_t ws_size, hipStream_t stream) {
    static int grid = 0;
    if (grid == 0) {
        if (n_in != 27 || out_size != (int)O_END || ws_size < WS_END) { fprintf(stderr, "kernel_launch: unexpected shapes (n_in %d, out %d, ws %zu); nothing launched\n", n_in, out_size, ws_size); grid = -1; return; }
        int dev = 0, cus = 0, per_cu = 0;
        if (hipGetDevice(&dev) != hipSuccess || hipDeviceGetAttribute(&cus, hipDeviceAttributeMultiprocessorCount, dev) != hipSuccess) { grid = -1; return; }
        if (hipFuncSetAttribute((const void*)mega_fwd, hipFuncAttributeMaxDynamicSharedMemorySize, LDS_BYTES) != hipSuccess) { fprintf(stderr, "kernel_launch: hipFuncSetAttribute failed\n"); grid = -1; return; }
        if (hipOccupancyMaxActiveBlocksPerMultiprocessor(&per_cu, (const void*)mega_fwd, NWAVES * 64, LDS_BYTES) != hipSuccess || per_cu < 1) { fprintf(stderr, "kernel_launch: occupancy query says %d blocks per CU\n", per_cu); }
        (void)hipGetLastError();
        grid = cus;
    }
    if (grid < 0) return;
    if (hipMemsetAsync((char*)d_ws + WS_CTL, 0, CTL_ZERO_BYTES, stream) != hipSuccess) return;
    Args a{};
    for (int i = 0; i < 27; ++i) a.in[i] = (const float*)d_in[i];
    a.pt = (const int*)d_in[I_PT]; a.out = (float*)d_out; a.ws = (unsigned char*)d_ws;
    constexpr int NL = MK_N_LAUNCHES;
    for (int li = 0; li < NL; ++li) {
        a.ph_lo = (NL == 1) ? 0 : li; a.ph_hi = (NL == 1) ? N_PHASES : li + 1; a.use_bar = (NL == 1) ? 1 : 0; a.pad = 0;
        hipLaunchKernelGGL(mega_fwd, dim3(grid), dim3(NWAVES * 64), LDS_BYTES, stream, a);
    }
}
```
